# Optimizing an MI355X kernel written in HIP

```python
import math
import jax, jax.numpy as jnp
from jax import lax
import numpy as np

D_MODEL = 2048
BATCH = 4
SEQ = 4096
DEPTH = 2

N_EVEN = (DEPTH + 1) // 2
N_ODD = DEPTH // 2

A_HEADS = 8
A_DK = 128
A_DV = 128
B_HEADS = 4
B_DK = 128
B_DV = 256
B_GATE_RANK = 16
B_GATE_TAU = 16.0
C_HEADS = 8
C_DH = 128
C_DLAT = 256
IDX_HEADS = 16
IDX_DIM = 64
TOPK_MAX = 256
Q_BLOCK = 128
D_HEADS = 4
D_DK = 128
D_DV = 256
CONV_K = 4
CHUNK = 64
REL_BUCKETS = 32
REL_MAX_DIST = 128
N_EXPERTS = 16
N_GROUPS = 4
EXPERTS_PER_GROUP = N_EXPERTS // N_GROUPS
TOP_K = 2
D_EXPERT = 512
DN_ALPHA = (2 * DEPTH) ** 0.25
DN_BETA = (8 * DEPTH) ** -0.25
EPS = 1e-5

AB_SIZES = (A_HEADS * A_DK, A_HEADS * A_DK, A_HEADS * A_DV, A_HEADS * A_DV,
            B_HEADS * B_DK, B_HEADS * B_DK, B_HEADS * B_DV, B_HEADS * B_DV, B_GATE_RANK)
CD_SIZES = (C_HEADS * C_DH, C_DLAT, IDX_HEADS * IDX_DIM, IDX_DIM, IDX_HEADS,
            D_HEADS * D_DK, D_HEADS * D_DK, D_HEADS * D_DV, D_HEADS, D_HEADS, D_HEADS * D_DV)
P_AB = sum(AB_SIZES)
P_CD = sum(CD_SIZES)
MIX_AB = A_HEADS * A_DV + B_HEADS * B_DV
MIX_CD = C_HEADS * C_DH + D_HEADS * D_DV

kernel_name = "hybrid_hgrn2_gla_dsa_mlstm_moe_deepnorm"

F32 = jnp.float32


def split_cols(h, sizes):
    return jnp.split(h, [int(i) for i in np.cumsum(sizes)[:-1]], axis=-1)


def layer_norm(x, g, b):
    xf = x.astype(F32)
    mu = jnp.mean(xf, -1, keepdims=True)
    var = jnp.mean(jnp.square(xf - mu), -1, keepdims=True)
    return ((xf - mu) * lax.rsqrt(var + EPS) * g + b).astype(x.dtype)


def rms_norm(x, g):
    xf = x.astype(F32)
    return xf * lax.rsqrt(jnp.mean(jnp.square(xf), -1, keepdims=True) + EPS) * g


def to_chunks(t):
    b, s, h, d = t.shape
    return t.astype(F32).reshape(b, s // CHUNK, CHUNK, h, d).transpose(1, 0, 3, 2, 4)


def from_chunks(t):
    n, b, h, l, d = t.shape
    return t.transpose(1, 0, 3, 2, 4).reshape(b, n * l, h, d)


def gate_to_chunks(t):
    b, s, h = t.shape
    return t.astype(F32).reshape(b, s // CHUNK, CHUNK, h).transpose(1, 0, 3, 2)


def gated_linear_recurrence(q, k, v, log_a):
    b_, _, h_, dk = q.shape
    dv = v.shape[-1]
    causal = jnp.tril(jnp.ones((CHUNK, CHUNK), bool))[:, :, None]

    def step(state, inp):
        qc, kc, vc, la = inp
        bcum = jnp.cumsum(la, axis=2)
        o_inter = jnp.einsum('bhtd,bhde->bhte', qc * jnp.exp(bcum), state)
        diff = bcum[:, :, :, None, :] - bcum[:, :, None, :, :]
        dec = jnp.where(causal, jnp.exp(jnp.where(causal, diff, 0.0)), 0.0)
        attn = jnp.einsum('bhtd,bhsd,bhtsd->bhts', qc, kc, dec)
        o = o_inter + jnp.einsum('bhts,bhse->bhte', attn, vc)
        b_last = bcum[:, :, -1:, :]
        state = (jnp.exp(b_last)[:, :, 0, :, None] * state
                 + jnp.einsum('bhsd,bhse->bhde', kc * jnp.exp(b_last - bcum), vc))
        return state, o

    init = jnp.zeros((b_, h_, dk, dv), F32)
    _, oc = lax.scan(step, init, (to_chunks(q), to_chunks(k), to_chunks(v), to_chunks(log_a)))
    return from_chunks(oc)


def mlstm_chunkwise(q, k, v, ig, lf):
    b_, _, h_, dk = q.shape
    dv = v.shape[-1]
    causal = jnp.tril(jnp.ones((CHUNK, CHUNK), bool))

    def step(carry, inp):
        cmat, nvec, m = carry
        qc, kc, vc, igc, lfc = inp
        bcum = jnp.cumsum(lfc, -1)
        log_w = jnp.where(causal, bcum[..., :, None] - bcum[..., None, :] + igc[..., None, :], -jnp.inf)
        log_inter = bcum + m[..., None]
        m_t = jnp.maximum(log_w.max(-1), log_inter)
        s = jnp.einsum('bhtd,bhsd->bhts', qc, kc) * jnp.exp(log_w - m_t[..., None])
        w_inter = jnp.exp(log_inter - m_t)
        num = (jnp.einsum('bhts,bhse->bhte', s, vc)
               + w_inter[..., None] * jnp.einsum('bhtd,bhde->bhte', qc, cmat))
        qn = s.sum(-1) + w_inter * jnp.einsum('bhtd,bhd->bht', qc, nvec)
        h = num / jnp.maximum(jnp.abs(qn), jnp.exp(-m_t))[..., None]
        b_last = bcum[..., -1]
        log_u = b_last[..., None] - bcum + igc
        m_new = jnp.maximum(b_last + m, log_u.max(-1))
        u = jnp.exp(log_u - m_new[..., None])
        decay = jnp.exp(b_last + m - m_new)
        cmat = decay[..., None, None] * cmat + jnp.einsum('bhs,bhsd,bhse->bhde', u, kc, vc)
        nvec = decay[..., None] * nvec + jnp.einsum('bhs,bhsd->bhd', u, kc)
        return (cmat, nvec, m_new), h

    init = (jnp.zeros((b_, h_, dk, dv), F32), jnp.zeros((b_, h_, dk), F32), jnp.zeros((b_, h_), F32))
    _, hc = lax.scan(step, init, (to_chunks(q), to_chunks(k), to_chunks(v),
                                  gate_to_chunks(ig), gate_to_chunks(lf)))
    return from_chunks(hc)


def t5_bucket(rel):
    n = jnp.maximum(rel, 0)
    max_exact = REL_BUCKETS // 2
    large = max_exact + (jnp.log(jnp.maximum(n, 1).astype(F32) / max_exact)
                         / math.log(REL_MAX_DIST / max_exact)
                         * (REL_BUCKETS - max_exact)).astype(jnp.int32)
    large = jnp.minimum(large, REL_BUCKETS - 1)
    return jnp.where(n < max_exact, n, large)


def dsa_attention(q_lat, ckv, iq, ik, iw, rel_table):
    b_, s_, h_, _ = q_lat.shape
    k_sel = min(TOPK_MAX, s_ // 4)
    s_pos = jnp.arange(s_)

    def block(j):
        start = j * Q_BLOCK
        ql = lax.dynamic_slice_in_dim(q_lat, start, Q_BLOCK, axis=1)
        qi = lax.dynamic_slice_in_dim(iq, start, Q_BLOCK, axis=1)
        wi = lax.dynamic_slice_in_dim(iw, start, Q_BLOCK, axis=1)
        t = start + jnp.arange(Q_BLOCK)
        score = jnp.einsum('bqhs,bqh->bqs', jax.nn.relu(jnp.einsum('bqhd,bsd->bqhs', qi, ik)), wi)
        score = jnp.where(s_pos[None, None, :] <= t[None, :, None], score.astype(F32), -jnp.inf)
        _, idx = lax.top_k(score, k_sel)
        valid = idx <= t[None, :, None]
        kv = jax.vmap(lambda c, i: c[i])(ckv, idx)
        bias = rel_table[t5_bucket(t[None, :, None] - idx)]
        logits = jnp.einsum('bqhc,bqkc->bhqk', ql, kv).astype(F32) + bias.transpose(0, 3, 1, 2).astype(F32)
        logits = jnp.where(valid[:, None], logits, -jnp.inf)
        p = jax.nn.softmax(logits, axis=-1).astype(kv.dtype)
        return jnp.einsum('bhqk,bqkc->bqhc', p, kv)

    out = lax.map(block, jnp.arange(s_ // Q_BLOCK))
    return out.transpose(1, 0, 2, 3, 4).reshape(b_, s_, h_, -1)


def causal_depthwise_conv(x, w):
    kc, cc = w.shape
    return lax.conv_general_dilated(x, w[:, None, :].astype(x.dtype), window_strides=(1,),
                                    padding=[(kc - 1, 0)], dimension_numbers=('NWC', 'WIO', 'NWC'),
                                    feature_group_count=cc)


def mix_ab(x, w_in, lb_logits, li, a_norm_g, gla_wa2, gla_ba2, b_norm_g):
    b_, s_, _ = x.shape
    h = x @ w_in
    aq, af, ai, ag, bq, bk, bv, bg, ba = split_cols(h, AB_SIZES)
    lb = jnp.cumsum(jax.nn.softmax(lb_logits.astype(F32), axis=0), axis=0)[li]
    f = lb + (1.0 - lb) * jax.nn.sigmoid(af.astype(F32))
    hs = lambda t, n: t.reshape(b_, s_, n, -1)
    oa = gated_linear_recurrence(hs(jax.nn.silu(aq), A_HEADS), hs(1.0 - f, A_HEADS),
                                 hs(ai, A_HEADS), hs(jnp.log(f), A_HEADS))
    oa = rms_norm(oa, a_norm_g) * jax.nn.silu(hs(ag, A_HEADS).astype(F32))
    log_alpha = jax.nn.log_sigmoid((ba @ gla_wa2 + gla_ba2).astype(F32)) / B_GATE_TAU
    ob = gated_linear_recurrence(hs(bq * B_DK ** -0.5, B_HEADS), hs(bk, B_HEADS),
                                 hs(bv, B_HEADS), hs(log_alpha, B_HEADS))
    ob = rms_norm(ob, b_norm_g) * jax.nn.silu(hs(bg, B_HEADS).astype(F32))
    return jnp.concatenate([oa.reshape(b_, s_, -1), ob.reshape(b_, s_, -1)], -1).astype(x.dtype)


def mix_cd(x, w_in, rel_table, ckv_g, w_uk, w_uv, conv_w, gate_b, d_norm_g):
    b_, s_, _ = x.shape
    h = x @ w_in
    cq, ckv, iq, ik, iw, dq, dk, dv, di, df, dog = split_cols(h, CD_SIZES)
    ckv = rms_norm(ckv, ckv_g).astype(x.dtype)
    q_lat = jnp.einsum('bshd,chd->bshc', cq.reshape(b_, s_, C_HEADS, C_DH), w_uk) * C_DH ** -0.5
    o_lat = dsa_attention(q_lat, ckv, iq.reshape(b_, s_, IDX_HEADS, IDX_DIM) * IDX_DIM ** -0.5,
                          ik, iw * IDX_HEADS ** -0.5, rel_table)
    oc = jnp.einsum('bshc,chd->bshd', o_lat, w_uv).astype(F32)
    qk = jax.nn.silu(causal_depthwise_conv(jnp.concatenate([dq, dk], -1), conv_w))
    dq, dk = jnp.split(qk, 2, axis=-1)
    hs = lambda t, n: t.reshape(b_, s_, n, -1)
    ig = di + gate_b[0]
    lf = jax.nn.log_sigmoid((df + gate_b[1]).astype(F32))
    od = mlstm_chunkwise(hs(dq, D_HEADS), hs(dk * D_DK ** -0.5, D_HEADS), hs(dv, D_HEADS), ig, lf)
    od = rms_norm(od, d_norm_g) * jax.nn.sigmoid(hs(dog, D_HEADS).astype(F32))
    return jnp.concatenate([oc.reshape(b_, s_, -1), od.reshape(b_, s_, -1)], -1).astype(x.dtype)


def moe(x, w_router, b_router, w1, w3, w2):
    b_, s_, d_ = x.shape
    xt = x.reshape(-1, d_)
    aff = jax.nn.sigmoid((xt @ w_router).astype(F32))
    sel = aff + b_router.astype(F32)
    grp_score = lax.top_k(sel.reshape(-1, N_GROUPS, EXPERTS_PER_GROUP), TOP_K)[0].sum(-1)
    g_best = jnp.argmax(grp_score, -1)
    in_grp = (jnp.arange(N_EXPERTS) // EXPERTS_PER_GROUP)[None, :] == g_best[:, None]
    _, top_idx = lax.top_k(jnp.where(in_grp, sel, -jnp.inf), TOP_K)
    top_aff = jnp.take_along_axis(aff, top_idx, -1)
    top_w = top_aff / jnp.sum(top_aff, -1, keepdims=True)
    gates = jnp.sum(jax.nn.one_hot(top_idx, N_EXPERTS, dtype=F32) * top_w[..., None], axis=1)
    hid = jax.nn.silu(jnp.einsum('td,edf->tef', xt, w1)) * jnp.einsum('td,edf->tef', xt, w3)
    y = jnp.einsum('tef,efd->td', hid * gates[..., None].astype(hid.dtype), w2)
    return y.reshape(b_, s_, d_).astype(x.dtype)


def setup_inputs(seed: int = 0) -> dict:
    key = jax.random.key(seed)
    ks = jax.random.split(key, 26)
    nrm = lambda k, shape, scale: jax.random.normal(k, shape, F32) * scale
    forget_b = jnp.broadcast_to(jnp.linspace(3.0, 6.0, D_HEADS, dtype=F32), (N_ODD, D_HEADS)) + nrm(ks[14], (N_ODD, D_HEADS), 0.1)
    return {
        "x": nrm(ks[0], (BATCH, SEQ, D_MODEL), 1.0),
        "w_in_ab": nrm(ks[1], (N_EVEN, D_MODEL, P_AB), D_MODEL ** -0.5),
        "w_out_ab": nrm(ks[2], (N_EVEN, MIX_AB, D_MODEL), DN_BETA * MIX_AB ** -0.5),
        "hgrn_lb_logits": nrm(ks[3], (N_EVEN + 1, A_HEADS * A_DK), 0.5),
        "a_norm_g": 1.0 + nrm(ks[4], (N_EVEN, A_DV), 0.02),
        "gla_wa2": nrm(ks[5], (N_EVEN, B_GATE_RANK, B_HEADS * B_DK), B_GATE_RANK ** -0.5),
        "gla_ba2": nrm(ks[6], (N_EVEN, B_HEADS * B_DK), 0.1),
        "b_norm_g": 1.0 + nrm(ks[7], (N_EVEN, B_DV), 0.02),
        "w_in_cd": nrm(ks[8], (N_ODD, D_MODEL, P_CD), D_MODEL ** -0.5),
        "w_out_cd": nrm(ks[9], (N_ODD, MIX_CD, D_MODEL), DN_BETA * MIX_CD ** -0.5),
        "ckv_norm_g": 1.0 + nrm(ks[10], (N_ODD, C_DLAT), 0.02),
        "w_uk": nrm(ks[11], (N_ODD, C_DLAT, C_HEADS, C_DH), C_DLAT ** -0.5),
        "w_uv": nrm(ks[12], (N_ODD, C_DLAT, C_HEADS, C_DH), C_DLAT ** -0.5),
        "mlstm_conv_w": nrm(ks[13], (N_ODD, CONV_K, 2 * D_HEADS * D_DK), CONV_K ** -0.5),
        "mlstm_gate_b": jnp.stack([nrm(ks[15], (N_ODD, D_HEADS), 0.1), forget_b], axis=1),
        "d_norm_g": 1.0 + nrm(ks[16], (N_ODD, D_DV), 0.02),
        "rel_table": nrm(ks[17], (REL_BUCKETS, C_HEADS), 0.5),
        "w_router": nrm(ks[18], (D_MODEL, N_EXPERTS), D_MODEL ** -0.5),
        "b_router": nrm(ks[19], (N_EXPERTS,), 0.01),
        "moe_w1": nrm(ks[20], (DEPTH, N_EXPERTS, D_MODEL, D_EXPERT), D_MODEL ** -0.5),
        "moe_w3": nrm(ks[21], (DEPTH, N_EXPERTS, D_MODEL, D_EXPERT), D_MODEL ** -0.5),
        "moe_w2": nrm(ks[22], (DEPTH, N_EXPERTS, D_EXPERT, D_MODEL), DN_BETA * D_EXPERT ** -0.5),
        "ln_g": 1.0 + nrm(ks[23], (DEPTH, 2, D_MODEL), 0.02),
        "ln_b": nrm(ks[24], (DEPTH, 2, D_MODEL), 0.02),
    }


def reference(x, w_in_ab, w_out_ab, hgrn_lb_logits, a_norm_g, gla_wa2, gla_ba2, b_norm_g,
              w_in_cd, w_out_cd, ckv_norm_g, w_uk, w_uv, mlstm_conv_w, mlstm_gate_b, d_norm_g,
              rel_table, w_router, b_router, moe_w1, moe_w3, moe_w2, ln_g, ln_b):
    for layer in range(DEPTH):
        li = layer // 2
        if layer % 2 == 0:
            mixed = mix_ab(x, w_in_ab[li], hgrn_lb_logits, li, a_norm_g[li],
                           gla_wa2[li], gla_ba2[li], b_norm_g[li]) @ w_out_ab[li]
        else:
            mixed = mix_cd(x, w_in_cd[li], rel_table, ckv_norm_g[li], w_uk[li], w_uv[li],
                           mlstm_conv_w[li], mlstm_gate_b[li], d_norm_g[li]) @ w_out_cd[li]
        x = layer_norm(DN_ALPHA * x + mixed, ln_g[layer, 0], ln_b[layer, 0])
        ffn = moe(x, w_router, b_router, moe_w1[layer], moe_w3[layer], moe_w2[layer])
        x = layer_norm(DN_ALPHA * x + ffn, ln_g[layer, 1], ln_b[layer, 1])
    return x
```

```cpp
#include <hip/hip_runtime.h>
#include <cstdio>
#include <cstdint>

#define LAS __attribute__((address_space(3)))
#define GAS __attribute__((address_space(1)))
typedef unsigned short bf16;
typedef short bf16x8 __attribute__((ext_vector_type(8)));
typedef short s16x4 __attribute__((ext_vector_type(4)));
typedef float f32x4 __attribute__((ext_vector_type(4)));
typedef float f32x2 __attribute__((ext_vector_type(2)));
typedef unsigned u32x4 __attribute__((ext_vector_type(4)));
typedef unsigned u32x2 __attribute__((ext_vector_type(2)));
typedef GAS unsigned gu32;

constexpr int BATCH = 4, SEQ = 4096, T = BATCH * SEQ, D = 2048, NCH = SEQ / 64;
constexpr int N_AB = 7168, PSRC_AB = 7184;
constexpr int N_CD = 5632, PSRC_CD = 5464;
constexpr int NE = 16, DEXP = 512;
constexpr float DN_ALPHA = 1.4142135623730951f;
constexpr float EPS = 1e-5f;

constexpr size_t MiB = 1u << 20;
constexpr size_t WS_CTL = 0, CTL_ZERO_BYTES = 128 * 1024;
constexpr size_t WS_LB = 1 * MiB;
constexpr size_t WS_MLSC = 1 * MiB + 65536;
constexpr size_t WS_GA = 2 * MiB;
constexpr size_t WS_GB = 3 * MiB;
constexpr size_t WS_MLN = 4 * MiB;
constexpr size_t WS_LIST = 5 * MiB;
constexpr size_t WS_WL = 6 * MiB;
constexpr size_t WS_SMALL = 8 * MiB;
constexpr size_t WS_LAB = 16 * MiB;
constexpr size_t WS_STATS = WS_LAB;
constexpr size_t WS_IDX = 32 * MiB;
constexpr size_t WS_CKVN = 40 * MiB;
constexpr size_t WS_W = 48 * MiB;
constexpr size_t WS_WINAB = WS_W, WS_WOUTAB = WS_W + 28 * MiB, WS_WINCD = WS_W + 36 * MiB, WS_WOUTCD = WS_W + 58 * MiB, WS_WUK = WS_W + 66 * MiB, WS_WUV = WS_W + 67 * MiB;
constexpr size_t WS_XB = 116 * MiB;
constexpr size_t WS_MIX = 180 * MiB;
constexpr size_t WS_R1 = 244 * MiB;
constexpr size_t WS_TMP = WS_R1, WS_W13 = WS_R1 + 128 * MiB, WS_W2T = WS_R1 + 192 * MiB;
constexpr size_t WS_R2 = 468 * MiB;
constexpr size_t WS_END = 598 * MiB;
constexpr int CW_TMO = 0, CW_CODE = 1;
constexpr int CW_BAR = 4096;
constexpr int CW_CNT = 16384;
static_assert((CW_CNT + 2 * 16 * 64) * 4 <= (int)CTL_ZERO_BYTES && (CW_BAR + 3456) * 4 <= (int)CTL_ZERO_BYTES, "control words inside the cleared region");

constexpr int RING_BYTES = 131072;
constexpr int LDSCTL_OFF = RING_BYTES, MISC_OFF = LDSCTL_OFF + 320;
constexpr int LDS_BYTES = 147456;

#define RLX_AGENT __ATOMIC_RELAXED, __HIP_MEMORY_SCOPE_AGENT
#define LDS_WAIT() asm volatile("s_waitcnt lgkmcnt(0)" ::: "memory")
#define VM_WAIT() asm volatile("s_waitcnt vmcnt(0)" ::: "memory")
__device__ __forceinline__ unsigned f2bf(float f) { unsigned u = __builtin_bit_cast(unsigned, f); return (u + 0x7fffu + ((u >> 16) & 1u)) >> 16; }
__device__ __forceinline__ unsigned pk2(float lo, float hi) { return f2bf(lo) | (f2bf(hi) << 16); }
__device__ __forceinline__ float bf2f(unsigned b) { return __builtin_bit_cast(float, b << 16); }
__device__ __forceinline__ float bflo(unsigned w) { return __builtin_bit_cast(float, w << 16); }
__device__ __forceinline__ float bfhi(unsigned w) { return __builtin_bit_cast(float, w & 0xffff0000u); }
__device__ __forceinline__ unsigned cvt_pk_bf16(float lo, float hi) { unsigned r; asm volatile("v_cvt_pk_bf16_f32 %0, %1, %2" : "=v"(r) : "v"(lo), "v"(hi)); return r; }
__device__ __forceinline__ float sigmoidf_(float v) { return __builtin_amdgcn_rcpf(1.0f + __expf(-v)); }
__device__ __forceinline__ float siluf_(float v) { return v * __builtin_amdgcn_rcpf(1.0f + __expf(-v)); }
__device__ __forceinline__ float wave_sum(float v) {
#pragma unroll
    for (int o = 1; o < 64; o <<= 1) v += __shfl_xor(v, o);
    return v;
}
__device__ __forceinline__ float wave_max(float v) {
#pragma unroll
    for (int o = 1; o < 64; o <<= 1) v = fmaxf(v, __shfl_xor(v, o));
    return v;
}
namespace pg8 {
constexpr int BM = 256, BK = 64, HALF = 128, HTB = HALF * BK * 2, STAGE_BYTES = 8 * HTB, NXCD = 8, WGM = 8;
__host__ __device__ __forceinline__ int lds_byte(int r, int c) { const int st = (r >> 4) * 2 + (c >> 5), rr = r & 15, cc = c & 31, ob = rr * 64 + cc * 2; return st * 1024 + (ob ^ (((ob >> 9) & 1) << 5)); }
__host__ __device__ __forceinline__ void stage_rc(int b, int& R, int& C) { const int st = b / 1024, sb = b % 1024, swz = sb ^ (((sb >> 9) & 1) << 5); R = (st >> 1) * 16 + swz / 64; C = (st & 1) * 32 + (swz % 64) / 2; }
__host__ __device__ __forceinline__ int perm32(int rho) { const int n = rho >> 4, i = rho & 15; return 8 * (i >> 2) + 4 * n + (i & 3); }

struct Unit { int pm, pn, ex; };

struct StaticOrder {
    const char* A; const char* Bt; int lda, ldb;
    int nM, nN, nwg, G, c;
    __device__ void init(const bf16* A_, int lda_, const bf16* Bt_, int ldb_, int M, int N, int G_, int c_) { A = (const char*)A_; Bt = (const char*)Bt_; lda = lda_; ldb = ldb_; nM = M / BM; nN = N / BM; nwg = nM * nN; G = G_; c = c_; }
    __device__ bool next(int i, Unit& u) const {
        const long L = (long)i * G + c; if (L >= nwg) return false;
        int wgid = (int)L; { const int q = nwg / NXCD, r = nwg % NXCD, xcd = wgid % NXCD, off = wgid / NXCD; wgid = (xcd < r ? xcd * (q + 1) : r * (q + 1) + (xcd - r) * q) + off; }
        const int nig = WGM * nN, gid = wgid / nig, fm = gid * WGM, gsz = (nM - fm) < WGM ? (nM - fm) : WGM;
        u.pm = fm + ((wgid % nig) % gsz); u.pn = (wgid % nig) / gsz; u.ex = 0; return true;
    }
    __device__ __forceinline__ const char* a_base(const Unit& u) const { return A + (size_t)u.pm * BM * lda * 2; }
    __device__ __forceinline__ const char* b_base(const Unit& u) const { return Bt + (size_t)u.pn * BM * ldb * 2; }
    __device__ __forceinline__ unsigned a_rowoff(const Unit&, int) const { return 0u; }
};

template <class Epi, class Sched, bool GATHER = false>
__device__ __forceinline__ void gemm_phase(LAS unsigned char* lds, const int K, const Sched& S, const Epi& E) {
    const int tid = threadIdx.x, wid = __builtin_amdgcn_readfirstlane(tid >> 6), lane = tid & 63, wr = wid >> 2, wc = wid & 3, fr = lane & 15, fq = lane >> 4;
    const int nt = K / BK;
    const int lda = S.lda, ldb = S.ldb;
    int Rst[2], Cst[2];
    unsigned voffA[2], voffB[2];
#pragma unroll
    for (int i = 0; i < 2; ++i) { int R, C; stage_rc(tid * 16 + i * 8192, R, C); Rst[i] = R; Cst[i] = C; const int Rb = Epi::PERM ? ((R & ~31) + perm32(R & 31)) : R;
        voffA[i] = (unsigned)(R * lda + C) * 2u; voffB[i] = (unsigned)(Rb * ldb + C) * 2u; }
    const size_t kstep = (size_t)(BK * 2);
    const size_t hstepA = (size_t)HALF * lda * 2, hstepB = (size_t)HALF * ldb * 2;
    const unsigned ldsw = (unsigned)wid * 1024u;
    const int aoff = lds_byte(wr * 64 + fr, fq * 8), boff = lds_byte(wc * 32 + fr, fq * 8);
    unsigned vc[2][2], vn[2][2];
#define PG8_SA(b, h) (((b) * 2 + (h)) * HTB)
#define PG8_SB(b, h) ((4 + (b) * 2 + (h)) * HTB)
#define PG8_STAGE_B(bufoff, gbase) do { _Pragma("unroll") for (int _i = 0; _i < 2; ++_i) \
        __builtin_amdgcn_global_load_lds((const unsigned*)((const char*)(gbase) + voffB[_i]), (LAS unsigned*)(lds + (bufoff) + ldsw + _i * 8192), 16, 0, 0); } while (0)
#define PG8_STAGE_A(bufoff, gbase, h, vs) do { _Pragma("unroll") for (int _i = 0; _i < 2; ++_i) { \
        const char* _p = GATHER ? ((const char*)(gbase) + (vs)[h][_i]) : ((const char*)(gbase) + (h) * hstepA + voffA[_i]); \
        __builtin_amdgcn_global_load_lds((const unsigned*)_p, (LAS unsigned*)(lds + (bufoff) + ldsw + _i * 8192), 16, 0, 0); } } while (0)
#define PG8_LDA(dst, b, h) do { _Pragma("unroll") for (int m = 0; m < 4; ++m) _Pragma("unroll") for (int k = 0; k < 2; ++k) dst[m][k] = *(const LAS bf16x8*)(lds + PG8_SA(b, h) + aoff + m * 2048 + k * 1024); } while (0)
#define PG8_LDB(dst, b, h) do { _Pragma("unroll") for (int n = 0; n < 2; ++n) _Pragma("unroll") for (int k = 0; k < 2; ++k) dst[n][k] = *(const LAS bf16x8*)(lds + PG8_SB(b, h) + boff + n * 2048 + k * 1024); } while (0)
#define PG8_MMA(ai, bj, At, Bt) do { __builtin_amdgcn_s_setprio(1); _Pragma("unroll") for (int m = 0; m < 4; ++m) _Pragma("unroll") for (int n = 0; n < 2; ++n) _Pragma("unroll") for (int k = 0; k < 2; ++k) \
        acc[ai][bj][m][n] = __builtin_amdgcn_mfma_f32_16x16x32_bf16(Bt[n][k], At[m][k], acc[ai][bj][m][n], 0, 0, 0); __builtin_amdgcn_s_setprio(0); } while (0)
#define PG8_WAIT_V(n) asm volatile("s_waitcnt vmcnt(" #n ")" ::: "memory")
#define PG8_WAIT_L(n) asm volatile("s_waitcnt lgkmcnt(" #n ")" ::: "memory")
#define PG8_BAR __builtin_amdgcn_s_barrier()
#define PG8_SCHED __builtin_amdgcn_sched_barrier(0)
#define PG8_LOADV(dst, u) do { if constexpr (GATHER) { _Pragma("unroll") for (int _h = 0; _h < 2; ++_h) _Pragma("unroll") for (int _i = 0; _i < 2; ++_i) \
        dst[_h][_i] = S.a_rowoff(u, _h * HALF + Rst[_i]) + (unsigned)Cst[_i] * 2u; } } while (0)
    Unit cur, nxt; int ui = 0;
    if (!S.next(0, cur)) return;
    f32x4 acc[2][2][4][2];
#pragma unroll
    for (int a = 0; a < 2; ++a)
#pragma unroll
        for (int b = 0; b < 2; ++b)
#pragma unroll
            for (int m = 0; m < 4; ++m)
#pragma unroll
                for (int n = 0; n < 2; ++n) acc[a][b][m][n] = (f32x4){0.f, 0.f, 0.f, 0.f};
    bf16x8 At[4][2], B0[2][2], B1[2][2];
    const char* cA = S.a_base(cur); const char* cB = S.b_base(cur);
    PG8_LOADV(vc, cur);
#pragma unroll
    for (int _h = 0; _h < 2; ++_h)
#pragma unroll
        for (int _i = 0; _i < 2; ++_i) vn[_h][_i] = GATHER ? vc[_h][_i] : 0u;
    PG8_STAGE_B(PG8_SB(0, 0), cB); PG8_STAGE_B(PG8_SB(0, 1), cB + hstepB); PG8_STAGE_A(PG8_SA(0, 0), cA, 0, vc); PG8_STAGE_A(PG8_SA(0, 1), cA, 1, vc);
    if (wr == 1) PG8_BAR;
    PG8_WAIT_V(2); PG8_BAR;
    PG8_STAGE_B(PG8_SB(1, 0), cB + kstep); PG8_STAGE_A(PG8_SA(1, 0), cA + kstep, 0, vc); PG8_STAGE_B(PG8_SB(1, 1), cB + hstepB + kstep);
    PG8_WAIT_V(6); PG8_BAR;
    for (;;) {
        const bool has_next = S.next(ui + 1, nxt);
        const char* nA = has_next ? S.a_base(nxt) : cA; const char* nB = has_next ? S.b_base(nxt) : cB;
        if constexpr (GATHER) { if (has_next) { PG8_LOADV(vn, nxt); } else {
#pragma unroll
            for (int _h = 0; _h < 2; ++_h)
#pragma unroll
                for (int _i = 0; _i < 2; ++_i) vn[_h][_i] = vc[_h][_i]; }
            asm volatile("s_waitcnt vmcnt(0)" :: "v"(vn[0][0]), "v"(vn[0][1]), "v"(vn[1][0]), "v"(vn[1][1]) : "memory"); }
        for (int t = 0; t < nt; t += 2) {
            const bool last = (t == nt - 2);
            const char* a1 = cA + (size_t)(t + 1) * kstep;
            const char* a2 = last ? nA : cA + (size_t)(t + 2) * kstep; const char* b2 = last ? nB : cB + (size_t)(t + 2) * kstep;
            const char* a3 = a2 + kstep; const char* b3 = b2 + kstep;
            unsigned vs[2][2];
#pragma unroll
            for (int _h = 0; _h < 2; ++_h)
#pragma unroll
                for (int _i = 0; _i < 2; ++_i) vs[_h][_i] = GATHER ? (last ? vn[_h][_i] : vc[_h][_i]) : 0u;
            PG8_LDB(B0, 0, 0); PG8_LDB(B1, 0, 1); PG8_SCHED; PG8_LDA(At, 0, 0); PG8_STAGE_A(PG8_SA(1, 1), a1, 1, vc);
            PG8_WAIT_V(8); PG8_WAIT_L(0); PG8_BAR; PG8_MMA(0, 0, At, B0); PG8_MMA(0, 1, At, B1); PG8_BAR; PG8_SCHED;
            PG8_LDA(At, 0, 1); PG8_STAGE_B(PG8_SB(0, 0), b2); PG8_STAGE_B(PG8_SB(0, 1), b2 + hstepB); PG8_STAGE_A(PG8_SA(0, 0), a2, 0, vs);
            PG8_WAIT_V(8); PG8_WAIT_L(0); PG8_BAR; PG8_MMA(1, 0, At, B0); PG8_MMA(1, 1, At, B1); PG8_BAR; PG8_SCHED;
            PG8_LDB(B0, 1, 0); PG8_LDB(B1, 1, 1); PG8_SCHED; PG8_LDA(At, 1, 0); PG8_STAGE_A(PG8_SA(0, 1), a2, 1, vs);
            PG8_WAIT_V(8); PG8_WAIT_L(0); PG8_BAR; PG8_MMA(0, 0, At, B0); PG8_MMA(0, 1, At, B1); PG8_BAR; PG8_SCHED;
            PG8_LDA(At, 1, 1); PG8_STAGE_B(PG8_SB(1, 0), b3); PG8_STAGE_B(PG8_SB(1, 1), b3 + hstepB); PG8_STAGE_A(PG8_SA(1, 0), a3, 0, vs);
            PG8_WAIT_V(8); PG8_WAIT_L(0); PG8_BAR; PG8_MMA(1, 0, At, B0); PG8_MMA(1, 1, At, B1); PG8_BAR; PG8_SCHED;
        }
        if (wr == 0) PG8_BAR;
        E(acc, cur, wr, wc, fr, fq);
        if (!has_next) break;
#pragma unroll
        for (int a = 0; a < 2; ++a)
#pragma unroll
            for (int b = 0; b < 2; ++b)
#pragma unroll
                for (int m = 0; m < 4; ++m)
#pragma unroll
                    for (int n = 0; n < 2; ++n) acc[a][b][m][n] = (f32x4){0.f, 0.f, 0.f, 0.f};
        cur = nxt; cA = nA; cB = nB; ++ui;
#pragma unroll
        for (int _h = 0; _h < 2; ++_h)
#pragma unroll
            for (int _i = 0; _i < 2; ++_i) vc[_h][_i] = vn[_h][_i];
        if (wr == 1) PG8_BAR;
    }
    PG8_WAIT_V(0);
    PG8_BAR;
#undef PG8_SA
#undef PG8_SB
#undef PG8_STAGE_A
#undef PG8_STAGE_B
#undef PG8_LDA
#undef PG8_LDB
#undef PG8_MMA
#undef PG8_WAIT_V
#undef PG8_WAIT_L
#undef PG8_BAR
#undef PG8_SCHED
#undef PG8_LOADV
}
}
namespace pg8 {
struct EpiF32 {
    static constexpr bool PERM = false;
    float* C; int ldc;
    __device__ __forceinline__ void operator()(const f32x4 (&acc)[2][2][4][2], const Unit& u, int wr, int wc, int fr, int fq) const {
        const int row0 = u.pm * BM + wr * 64 + fr, col0 = u.pn * BM + wc * 32 + 4 * fq;
#pragma unroll
        for (int ai = 0; ai < 2; ++ai)
#pragma unroll
            for (int m = 0; m < 4; ++m) { float* rowp = C + (size_t)(row0 + ai * HALF + m * 16) * ldc + col0;
#pragma unroll
                for (int bj = 0; bj < 2; ++bj)
#pragma unroll
                    for (int n = 0; n < 2; ++n) *(f32x4*)(rowp + bj * HALF + n * 16) = acc[ai][bj][m][n]; }
    }
};
__device__ __forceinline__ float epi_act(int mode, float v, float aux) {
    if (mode == 1) return siluf_(v);
    if (mode == 2) return v * aux;
    if (mode == 3) return __logf(aux + (1.0f - aux) * sigmoidf_(v));
    if (mode == 4) return sigmoidf_(v);
    if (mode == 5) return 0.f;
    return v;
}
__device__ __forceinline__ void store_bf16_tile(const f32x4 (&acc)[2][2][4][2], bf16* O, int ldc, int row0, int col0, int mode, float auxs, const float* auxv  , int nbj) {
    f32x4 av[2][2];
#pragma unroll
    for (int bj = 0; bj < 2; ++bj)
#pragma unroll
        for (int n = 0; n < 2; ++n) av[bj][n] = auxv ? *(const f32x4*)(auxv + bj * HALF + 4 * n) : (f32x4){auxs, auxs, auxs, auxs};
#pragma unroll
    for (int ai = 0; ai < 2; ++ai)
#pragma unroll
        for (int m = 0; m < 4; ++m) { bf16* rowp = O + (size_t)(row0 + ai * HALF + m * 16) * ldc + col0;
#pragma unroll
            for (int bj = 0; bj < 2; ++bj) { if (bj < nbj) { f32x4 v0 = acc[ai][bj][m][0], v1 = acc[ai][bj][m][1];
                if (mode != 0) {
#pragma unroll
                    for (int j = 0; j < 4; ++j) { v0[j] = epi_act(mode, v0[j], av[bj][0][j]); v1[j] = epi_act(mode, v1[j], av[bj][1][j]); } }
                u32x4 w; w.x = cvt_pk_bf16(v0[0], v0[1]); w.y = cvt_pk_bf16(v0[2], v0[3]); w.z = cvt_pk_bf16(v1[0], v1[1]); w.w = cvt_pk_bf16(v1[2], v1[3]);
                *(u32x4*)(rowp + bj * HALF) = w; } } }
}
struct EpiBf16 {
    static constexpr bool PERM = true;
    bf16* O; int ldc;
    __device__ __forceinline__ void operator()(const f32x4 (&acc)[2][2][4][2], const Unit& u, int wr, int wc, int fr, int fq) const {
        store_bf16_tile(acc, O, ldc, u.pm * BM + wr * 64 + fr, u.pn * BM + wc * 32 + 8 * fq, 0, 0.f, nullptr, 2);
    }
};
template <bool XF32>
struct EpiResid {
    static constexpr bool PERM = true;
    bf16* O; const void* X; float* stats;
    __device__ __forceinline__ void operator()(const f32x4 (&acc)[2][2][4][2], const Unit& u, int wr, int wc, int fr, int fq) const {
        const int row0 = u.pm * BM + wr * 64 + fr, col0 = u.pn * BM + wc * 32 + 8 * fq;
#pragma unroll
        for (int ai = 0; ai < 2; ++ai) {
            f32x4 xr[4][2][2];
#pragma unroll
            for (int m = 0; m < 4; ++m)
#pragma unroll
                for (int bj = 0; bj < 2; ++bj) { const size_t off = (size_t)(row0 + ai * HALF + m * 16) * D + col0 + bj * HALF;
                    if (XF32) { const GAS f32x4* xp = (const GAS f32x4*)((const float*)X + off); xr[m][bj][0] = xp[0]; xr[m][bj][1] = xp[1]; }
                    else { const u32x4 a = *(const GAS u32x4*)((const bf16*)X + off);
                        xr[m][bj][0] = (f32x4){bflo(a.x), bfhi(a.x), bflo(a.y), bfhi(a.y)}; xr[m][bj][1] = (f32x4){bflo(a.z), bfhi(a.z), bflo(a.w), bfhi(a.w)}; } }
#pragma unroll
            for (int m = 0; m < 4; ++m) { const int r = row0 + ai * HALF + m * 16; float s = 0.f, ss = 0.f;
#pragma unroll
                for (int bj = 0; bj < 2; ++bj) {
                    const f32x4 v0 = acc[ai][bj][m][0] + xr[m][bj][0] * DN_ALPHA, v1 = acc[ai][bj][m][1] + xr[m][bj][1] * DN_ALPHA;
                    s += (v0[0] + v0[1]) + (v0[2] + v0[3]) + (v1[0] + v1[1]) + (v1[2] + v1[3]);
                    ss += (v0[0] * v0[0] + v0[1] * v0[1]) + (v0[2] * v0[2] + v0[3] * v0[3]) + (v1[0] * v1[0] + v1[1] * v1[1]) + (v1[2] * v1[2] + v1[3] * v1[3]);
                    u32x4 w; w.x = cvt_pk_bf16(v0[0], v0[1]); w.y = cvt_pk_bf16(v0[2], v0[3]); w.z = cvt_pk_bf16(v1[0], v1[1]); w.w = cvt_pk_bf16(v1[2], v1[3]);
                    *(u32x4*)(O + (size_t)r * D + col0 + bj * HALF) = w; }
                s += __shfl_xor(s, 16); ss += __shfl_xor(ss, 16); s += __shfl_xor(s, 32); ss += __shfl_xor(ss, 32);
                if (fq == 0) { float* sp = stats + ((size_t)r * 32 + u.pn * 4 + wc) * 2; sp[0] = s; sp[1] = ss; } }
        }
    }
};
struct EpiAB {
    static constexpr bool PERM = true;
    bf16* O; const float* lb;
    __device__ __forceinline__ void operator()(const f32x4 (&acc)[2][2][4][2], const Unit& u, int wr, int wc, int fr, int fq) const {
        const int pn = u.pn; int mode = 0; float auxs = 0.f; const float* auxv = nullptr;
        const int cl = wc * 32 + 8 * fq;
        if (pn < 4) mode = 1;
        else if (pn < 8) { mode = 3; auxv = lb + (pn - 4) * BM + cl; }
        else if (pn < 12) mode = 0;
        else if (pn < 16) mode = 1;
        else if (pn < 18) { mode = 2; auxs = 0.08838834764831845f; }
        else if (pn < 24) mode = 0;
        else mode = 1;
        store_bf16_tile(acc, O, N_AB, u.pm * BM + wr * 64 + fr, pn * BM + cl, mode, auxs, auxv, 2);
    }
};
struct EpiCD {
    static constexpr bool PERM = true;
    bf16* O; float* small;
    __device__ __forceinline__ void operator()(const f32x4 (&acc)[2][2][4][2], const Unit& u, int wr, int wc, int fr, int fq) const {
        const int pn = u.pn; const int cl = wc * 32 + 8 * fq; const int row0 = u.pm * BM + wr * 64 + fr;
        if (pn == 21) {
#pragma unroll
            for (int ai = 0; ai < 2; ++ai)
#pragma unroll
                for (int m = 0; m < 4; ++m) { float* rowp = small + (size_t)(row0 + ai * HALF + m * 16) * 128 + cl;
                    *(f32x4*)(rowp) = acc[ai][0][m][0]; *(f32x4*)(rowp + 4) = acc[ai][0][m][1]; }
            return;
        }
        int mode = 0; float auxs = 0.f;
        if (pn >= 5 && pn < 9) { mode = 2; auxs = 0.125f; }
        else if (pn >= 17) mode = 4;
        store_bf16_tile(acc, O, N_CD, row0, pn * BM + cl, mode, auxs, nullptr, 2);
    }
};
struct EpiHead {
    static constexpr bool PERM = true;
    bf16* O; int ldc; int colstride; int nbj; int mode; float auxs;
    __device__ __forceinline__ void operator()(const f32x4 (&acc)[2][2][4][2], const Unit& u, int wr, int wc, int fr, int fq) const {
        store_bf16_tile(acc, O, ldc, u.pm * BM + wr * 64 + fr, u.ex * colstride + wc * 32 + 8 * fq, mode, auxs, nullptr, nbj);
    }
};
struct HeadOrder {
    const char* A; const char* Bt; int lda, ldb; int acol; int G, c;
    __device__ bool next(int i, Unit& u) const { const int L = i * G + c; if (L >= 64 * 8) return false; u.pm = L >> 3; u.ex = L & 7; u.pn = 0; return true; }
    __device__ __forceinline__ const char* a_base(const Unit& u) const { return A + ((size_t)u.pm * BM * lda + (size_t)u.ex * acol) * 2; }
    __device__ __forceinline__ const char* b_base(const Unit& u) const { return Bt + (size_t)u.ex * BM * ldb * 2; }
    __device__ __forceinline__ unsigned a_rowoff(const Unit&, int) const { return 0u; }
};
struct MoeOrder {
    const char* A; const char* Bt; int lda, ldb; int NT; int G, c; int brows;
    const volatile LAS int* tab; const int* list;
    bool gather;
    __device__ bool next(int i, Unit& u) const {
        const int cx = ((G & 7) == 0) ? (c & 7) * (G >> 3) + (c >> 3) : c;
        const int L = i * G + cx; const int total = tab[16] * NT; if (L >= total) return false;
        const int mg = L / NT; u.pn = L - mg * NT; int e = 0;
#pragma unroll
        for (int j = 1; j < 16; ++j) e += (mg >= tab[j]) ? 1 : 0;
        u.ex = e; u.pm = mg; return true;
    }
    __device__ __forceinline__ const char* a_base(const Unit& u) const { return gather ? A : A + (size_t)u.pm * BM * lda * 2; }
    __device__ __forceinline__ const char* b_base(const Unit& u) const { return Bt + ((size_t)u.ex * brows + (size_t)u.pn * BM) * ldb * 2; }
    __device__ __forceinline__ unsigned a_rowoff(const Unit& u, int r) const {
        const int lr = (u.pm - tab[u.ex]) * BM + r; const int ne = tab[32 + u.ex];
        const int tok = (lr < ne) ? (list[u.ex * 16384 + lr] & 0x7fffffff) : 0;
        return (unsigned)tok * (unsigned)(lda * 2);
    }
};
struct EpiMoe1 {
    static constexpr bool PERM = true;
    bf16* hid; const float* wl; const volatile LAS int* tab;
    __device__ __forceinline__ void operator()(const f32x4 (&acc)[2][2][4][2], const Unit& u, int wr, int wc, int fr, int fq) const {
        const int e = u.ex, lr0 = (u.pm - tab[e]) * BM + wr * 64 + fr, ne = tab[32 + e];
        const int col0 = u.pn * 128 + wc * 32 + 8 * fq;
#pragma unroll
        for (int ai = 0; ai < 2; ++ai)
#pragma unroll
            for (int m = 0; m < 4; ++m) { const int lr = lr0 + ai * HALF + m * 16;
                if (lr < ne) { const float w = wl[e * 16384 + lr];
                    f32x4 a0 = acc[ai][0][m][0], a1 = acc[ai][0][m][1], b0 = acc[ai][1][m][0], b1 = acc[ai][1][m][1];
#pragma unroll
                    for (int j = 0; j < 4; ++j) { a0[j] = siluf_(a0[j]) * b0[j] * w; a1[j] = siluf_(a1[j]) * b1[j] * w; }
                    u32x4 o; o.x = cvt_pk_bf16(a0[0], a0[1]); o.y = cvt_pk_bf16(a0[2], a0[3]); o.z = cvt_pk_bf16(a1[0], a1[1]); o.w = cvt_pk_bf16(a1[2], a1[3]);
                    *(u32x4*)(hid + (size_t)(u.pm * BM + wr * 64 + fr + ai * HALF + m * 16) * DEXP + col0) = o; } }
    }
};
struct EpiMoe2 {
    static constexpr bool PERM = true;
    bf16* ys; const int* list; const volatile LAS int* tab;
    __device__ __forceinline__ void operator()(const f32x4 (&acc)[2][2][4][2], const Unit& u, int wr, int wc, int fr, int fq) const {
        const int e = u.ex, lr0 = (u.pm - tab[e]) * BM + wr * 64 + fr, ne = tab[32 + e];
        const int col0 = u.pn * BM + wc * 32 + 8 * fq;
#pragma unroll
        for (int ai = 0; ai < 2; ++ai)
#pragma unroll
            for (int m = 0; m < 4; ++m) { const int lr = lr0 + ai * HALF + m * 16;
                if (lr < ne) { const int ent = list[e * 16384 + lr]; const int tok = ent & 0x7fffffff, slot = (ent >> 31) & 1;
                    bf16* rowp = ys + ((size_t)slot * T + tok) * D + col0;
#pragma unroll
                    for (int bj = 0; bj < 2; ++bj) { const f32x4 v0 = acc[ai][bj][m][0], v1 = acc[ai][bj][m][1];
                        u32x4 o; o.x = cvt_pk_bf16(v0[0], v0[1]); o.y = cvt_pk_bf16(v0[2], v0[3]); o.z = cvt_pk_bf16(v1[0], v1[1]); o.w = cvt_pk_bf16(v1[2], v1[3]);
                        *(u32x4*)(rowp + bj * HALF) = o; } } }
    }
};
}
#define XB_TMO      128
#define XB_XCNT(j)  (256  + 64 * (j))
#define XB_XSUB(j)  (1280 + 64 * (j))
#define XB_XGEN(j)  (2304 + 64 * (j))
#define XB_TOP      3328
#define XB_TOPGEN   3392
#define XCD_BAR_WORDS 3456
#define XB_SPIN_CAP (1u << 22)

__device__ __forceinline__ unsigned xb_ld(unsigned* p)              { return __hip_atomic_load(p, __ATOMIC_RELAXED, __HIP_MEMORY_SCOPE_AGENT); }
__device__ __forceinline__ unsigned xb_add(unsigned* p, unsigned v) { return __hip_atomic_fetch_add(p, v, __ATOMIC_RELAXED, __HIP_MEMORY_SCOPE_AGENT); }
__device__ __forceinline__ unsigned xb_xcc_id() { return (unsigned)__builtin_amdgcn_s_getreg((3 << 11) | 20) & 0xFu; }
#define XB_SPIN(cond, bar) do { unsigned _sp = 0; while (cond) { __builtin_amdgcn_s_sleep(1); \
    if ((++_sp & 255u) == 0u) { if (xb_ld(&(bar)[XB_TMO])) break; if (_sp > XB_SPIN_CAP) { atomicAdd(&(bar)[XB_TMO], 1u); break; } } } } while (0)

struct XcdBarrier { unsigned* bar; unsigned x; volatile LAS unsigned* st; };

__device__ __forceinline__ XcdBarrier xcd_barrier_post(unsigned* bar, volatile LAS unsigned* st) {
    XcdBarrier b; b.bar = bar; b.x = xb_xcc_id(); b.st = st;
    if (threadIdx.x == 0) (void)xb_add(&bar[XB_XCNT(b.x)], 1u);
    return b;
}
__device__ __forceinline__ void xcd_barrier_complete(unsigned* bar, unsigned x, unsigned& nloc, unsigned& nx) {
    const unsigned G = gridDim.x * gridDim.y * gridDim.z;
    unsigned sum, cnt, mine, sp = 0u;
    for (;;) {
        sum = 0u; cnt = 0u; mine = 0u;
#pragma unroll
        for (unsigned j = 0; j < 16; ++j) { const unsigned c = xb_ld(&bar[XB_XCNT(j)]); sum += c; cnt += (c > 0u) ? 1u : 0u; mine = (j == x) ? c : mine; }
        if (sum == G) break;
        __builtin_amdgcn_s_sleep(1);
        if ((++sp & 255u) == 0u) { if (xb_ld(&bar[XB_TMO])) break; if (sp > XB_SPIN_CAP) { atomicAdd(&bar[XB_TMO], 1u); break; } }
    }
    nloc = mine > 0u ? mine : 1u; nx = cnt > 0u ? cnt : 1u;
}
__device__ __forceinline__ void xcd_barrier(const XcdBarrier& b) {
    asm volatile("s_waitcnt vmcnt(0)" ::: "memory");
    __syncthreads();
    if (threadIdx.x == 0) {
        unsigned* bar = b.bar;
        __builtin_amdgcn_s_waitcnt(0);
        unsigned nloc = b.st[0], nx = b.st[1];
        if (nloc == 0u) { xcd_barrier_complete(bar, b.x, nloc, nx); b.st[0] = nloc; b.st[1] = nx; }
        const unsigned old = xb_add(&bar[XB_XSUB(b.x)], 1u);
        const unsigned gen = old / nloc;
        if (old + 1u == (gen + 1u) * nloc) {
            __builtin_amdgcn_fence(__ATOMIC_RELEASE, "agent");
            asm volatile("s_waitcnt vmcnt(0)" ::: "memory");
            const unsigned og = xb_add(&bar[XB_TOP], 1u);
            const unsigned tg = og / nx;
            if (og + 1u == (tg + 1u) * nx) xb_add(&bar[XB_TOPGEN], 1u);
            else XB_SPIN(xb_ld(&bar[XB_TOPGEN]) == tg, bar);
            __builtin_amdgcn_fence(__ATOMIC_ACQUIRE, "agent");
            xb_add(&bar[XB_XGEN(b.x)], 1u);
            asm volatile("s_waitcnt vmcnt(0)" ::: "memory");
        } else {
            XB_SPIN(xb_ld(&bar[XB_XGEN(b.x)]) == gen, bar);
            __builtin_amdgcn_fence(__ATOMIC_ACQUIRE, "agent");
            asm volatile("s_waitcnt vmcnt(0)" ::: "memory");
        }
    }
    __syncthreads();
}

struct Args {
    const float* in[24]; float* out; unsigned char* ws; int ph_lo, ph_hi, use_bar, pad;
};
enum InIdx { I_X = 0, I_WINAB, I_WOUTAB, I_LBLOG, I_ANORM, I_WA2, I_BA2, I_BNORM, I_WINCD, I_WOUTCD, I_CKVG, I_WUK, I_WUV, I_CONVW, I_GATEB, I_DNORM, I_REL, I_WR, I_BR, I_W1, I_W3, I_W2, I_LNG, I_LNB };

struct Frame {
    LAS unsigned char* lds;
    gu32* ctl;
    int tid, lane, wave, G, bid;
    const float* const* in; float* out; unsigned char* ws;
};
#ifndef PROBE_REPCONV
#define PROBE_REPCONV 0
#endif
template <class SrcFn>
__device__ __forceinline__ void transpose_item(const SrcFn& src, int Kdst, bf16* WT, LAS float* scr, int kb, int nb, int lane) {
    const int k0 = 64 * kb, n0 = 32 * nb;
    float v[32];
#pragma unroll
    for (int i = 0; i < 32; ++i) v[i] = src(k0 + 2 * i + (lane >> 5), n0 + (lane & 31));
#pragma unroll
    for (int i = 0; i < 32; ++i) scr[(2 * i + (lane >> 5)) * 33 + (lane & 31)] = v[i];
    LDS_WAIT(); asm volatile("" ::: "memory");
    const int c = lane & 7;
#pragma unroll
    for (int j = 0; j < 4; ++j) { const int n = (lane >> 3) + 8 * j; const LAS float* s = scr + (8 * c) * 33 + n;
        u32x4 o; o.x = pk2(s[0 * 33], s[1 * 33]); o.y = pk2(s[2 * 33], s[3 * 33]); o.z = pk2(s[4 * 33], s[5 * 33]); o.w = pk2(s[6 * 33], s[7 * 33]);
        *(GAS u32x4*)(WT + (size_t)(n0 + n) * Kdst + k0 + 8 * c) = o; }
    LDS_WAIT(); asm volatile("" ::: "memory");
}
constexpr int TT_LD = 264;
template <class AddrFn>
__device__ __forceinline__ void wgt_load(const AddrFn& addr, int k0, int wave, int lane, f32x4 (&v)[8]) {
#pragma unroll
    for (int i = 0; i < 8; ++i) v[i] = *(const GAS f32x4*)addr(k0 + 8 * wave + i, 4 * lane);
}
__device__ __forceinline__ void wgt_emit(LAS bf16* tile, const f32x4 (&v)[8], bf16* WT, int Kdst, int k0, int n0, int wave, int lane) {
#pragma unroll
    for (int i = 0; i < 8; ++i) { u32x2 o; o.x = pk2(v[i].x, v[i].y); o.y = pk2(v[i].z, v[i].w); *(LAS u32x2*)(tile + (8 * wave + i) * TT_LD + 4 * lane) = o; }
    asm volatile("s_waitcnt lgkmcnt(0)" ::: "memory"); __builtin_amdgcn_s_barrier(); asm volatile("" ::: "memory");
    const int r16 = lane & 15, g4 = lane >> 4;
#pragma unroll
    for (int j = 0; j < 4; ++j) { const int it = wave * 4 + j, cg = it >> 1, hh = it & 1;
        const LAS bf16* p = tile + (32 * hh + 8 * g4 + (r16 >> 2)) * TT_LD + 16 * cg + 4 * (r16 & 3);
        const s16x4 lo = __builtin_bit_cast(s16x4, __builtin_amdgcn_ds_read_tr16_b64_v4i16((LAS s16x4*)p));
        const s16x4 hi = __builtin_bit_cast(s16x4, __builtin_amdgcn_ds_read_tr16_b64_v4i16((LAS s16x4*)(p + 4 * TT_LD)));
        const bf16x8 o = __builtin_shufflevector(lo, hi, 0, 1, 2, 3, 4, 5, 6, 7);
        *(GAS bf16x8*)(WT + (size_t)(n0 + 16 * cg + r16) * Kdst + k0 + 32 * hh + 8 * g4) = o; }
}
struct TItem { const float* p0; const float* p1; int pitch; bf16* WT; int Kdst, k0, n0; };
struct TAddr { const float* p0; const float* p1; int pitch;
    __device__ __forceinline__ const float* operator()(int k, int n4) const { return (n4 < 128 ? p0 : p1) + (size_t)k * pitch + (n4 & 127); } };
template <class Decode>
__device__ __forceinline__ void wgt_run(const Decode& decode, int nit, Frame& F) {
    LAS bf16* tile0 = (LAS bf16*)F.lds; LAS bf16* tile1 = (LAS bf16*)(F.lds + 64 * TT_LD * 2);
    f32x4 v[8], v2[8];
    int it = F.bid; int par = 0;
    TItem cur; if (it < nit) { cur = decode(it); wgt_load(TAddr{cur.p0, cur.p1, cur.pitch}, cur.k0, F.wave, F.lane, v); }
    while (it < nit) {
        const int nx = it + F.G; TItem nxt = cur;
        if (nx < nit) { nxt = decode(nx); wgt_load(TAddr{nxt.p0, nxt.p1, nxt.pitch}, nxt.k0, F.wave, F.lane, v2); }
        wgt_emit(par ? tile1 : tile0, v, cur.WT, cur.Kdst, cur.k0, cur.n0, F.wave, F.lane);
#pragma unroll
        for (int i = 0; i < 8; ++i) v[i] = v2[i];
        cur = nxt; it = nx; par ^= 1;
    }
}
__device__ __forceinline__ int cd_src_col(int n) {
    if (n < 2304) return n;
    if (n < 2816) return 2384 + (n - 2304);
    if (n < 3328) return 2896 + (n - 2816);
    if (n < 4352) return 3408 + (n - 3328);
    if (n < 5376) return 4440 + (n - 4352);
    if (n < 5440) return 2304 + (n - 5376);
    if (n < 5456) return 2368 + (n - 5440);
    if (n < 5460) return 4432 + (n - 5456);
    if (n < 5464) return 4436 + (n - 5460);
    return -1;
}
__device__ __forceinline__ void load_w16_T(LAS float* WT, const float* W, int ld, int col0, int tid) {
#pragma unroll 4
    for (int i = tid; i < 2048 * 4; i += 512) { const int k = i >> 2, e4 = (i & 3) * 4; const f32x4 w = *(const f32x4*)(W + (size_t)k * ld + col0 + e4);
        WT[(e4 + 0) * 2048 + k] = w.x; WT[(e4 + 1) * 2048 + k] = w.y; WT[(e4 + 2) * 2048 + k] = w.z; WT[(e4 + 3) * 2048 + k] = w.w; }
}
template <bool WBF16>
__device__ __forceinline__ void row_dot16(const f32x4 (&v)[8], const LAS void* WTv, int lane, float (&out)[16]) {
    float s[16];
#pragma unroll
    for (int e = 0; e < 16; ++e) { float a = 0.f;
        if (WBF16) { const LAS bf16* WT = (const LAS bf16*)WTv;
#pragma unroll
            for (int j = 0; j < 8; ++j) { const u32x2 w = *(const LAS u32x2*)(WT + e * 2048 + 256 * j + 4 * lane); a += (v[j].x * bflo(w.x) + v[j].y * bfhi(w.x)) + (v[j].z * bflo(w.y) + v[j].w * bfhi(w.y)); } }
        else { const LAS float* WT = (const LAS float*)WTv;
#pragma unroll
            for (int j = 0; j < 8; ++j) { const f32x4 w = *(const LAS f32x4*)(WT + e * 2048 + 256 * j + 4 * lane); a += (v[j].x * w.x + v[j].y * w.y) + (v[j].z * w.z + v[j].w * w.w); } }
        s[e] = a; __builtin_amdgcn_sched_barrier(0); }
#define RD_STEP(N, XOR) { const bool hi_ = (lane & (XOR)) != 0; _Pragma("unroll") for (int j = 0; j < (N); ++j) { const float send = hi_ ? s[j] : s[(N) + j]; const float keep = hi_ ? s[(N) + j] : s[j]; s[j] = keep + __shfl_xor(send, (XOR)); } }
    RD_STEP(8, 32) RD_STEP(4, 16) RD_STEP(2, 8) RD_STEP(1, 4)
#undef RD_STEP
    float r = s[0]; r += __shfl_xor(r, 2); r += __shfl_xor(r, 1);
#pragma unroll
    for (int e = 0; e < 16; ++e) out[e] = __builtin_bit_cast(float, __builtin_amdgcn_readlane(__builtin_bit_cast(int, r), (((e >> 3) & 1) << 5) | (((e >> 2) & 1) << 4) | (((e >> 1) & 1) << 3) | ((e & 1) << 2)));
}
__device__ __forceinline__ void store_row_bf16(bf16* orow, const f32x4 (&v)[8], int lane) {
    GAS unsigned long long* o8 = (GAS unsigned long long*)orow + lane;
#pragma unroll
    for (int j = 0; j < 8; ++j) o8[64 * j] = (unsigned long long)pk2(v[j].x, v[j].y) | ((unsigned long long)pk2(v[j].z, v[j].w) << 32);
}
__device__ __forceinline__ float log_sigmoid_(float z) { return -(fmaxf(-z, 0.f) + __logf(1.0f + __expf(-fabsf(z)))); }

__device__ __forceinline__ void p0_prologue(const Args& args, Frame& F) {
    LAS float* scr = (LAS float*)(F.lds + F.wave * 16384);
    const int gw = F.bid * 8 + F.wave, NGW = F.G * 8;
    unsigned char* ws = args.ws;
    { const int gt = F.bid * 512 + F.tid; if (gt < 1024) { const float a = args.in[I_LBLOG][gt], b = args.in[I_LBLOG][1024 + gt]; const float m = fmaxf(a, b); const float ea = __expf(a - m), eb = __expf(b - m); ((float*)(ws + WS_LB))[gt] = ea / (ea + eb); } }
    {
        const float* wab = args.in[I_WINAB]; const float* woab = args.in[I_WOUTAB]; const float* wcd = args.in[I_WINCD]; const float* wocd = args.in[I_WOUTCD];
        constexpr int J0 = 32 * 28, J1 = 32 * 8, J2 = 32 * 21, J3 = 32 * 8;
        for (int rep_ = 0; rep_ < ((PROBE_REPCONV & 2) ? 2 : 1); ++rep_)
        wgt_run([&](int it) { TItem t; int r = it;
            if (r < J0) { const int kb = r / 28, nb = r % 28; t.p0 = wab + 256 * nb; t.p1 = t.p0 + 128; t.pitch = PSRC_AB; t.WT = (bf16*)(ws + WS_WINAB); t.Kdst = 2048; t.k0 = 64 * kb; t.n0 = 256 * nb; return t; } r -= J0;
            if (r < J1) { const int kb = r / 8, nb = r % 8; t.p0 = woab + 256 * nb; t.p1 = t.p0 + 128; t.pitch = 2048; t.WT = (bf16*)(ws + WS_WOUTAB); t.Kdst = 2048; t.k0 = 64 * kb; t.n0 = 256 * nb; return t; } r -= J1;
            if (r < J2) { const int kb = r / 21, nb = r % 21; t.p0 = wcd + cd_src_col(256 * nb); t.p1 = t.p0 + 128; t.pitch = PSRC_CD; t.WT = (bf16*)(ws + WS_WINCD); t.Kdst = 2048; t.k0 = 64 * kb; t.n0 = 256 * nb; return t; } r -= J2;
            { const int kb = r / 8, nb = r % 8; t.p0 = wocd + 256 * nb; t.p1 = t.p0 + 128; t.pitch = 2048; t.WT = (bf16*)(ws + WS_WOUTCD); t.Kdst = 2048; t.k0 = 64 * kb; t.n0 = 256 * nb; return t; }
        }, J0 + J1 + J2 + J3, F);
        __syncthreads();
    }
    constexpr int I2 = 32 * 8, I4 = 4 * 64, I5 = 4 * 64;
    constexpr int NIT = I2 + I4 + I5;
    for (int it = gw; it < NIT; it += NGW) {
        int r = it;
        if (r < I2) { const float* W = args.in[I_WINCD]; transpose_item([&](int k, int n) { const int sc = cd_src_col(n); return sc >= 0 ? W[(size_t)k * PSRC_CD + sc] : 0.f; }, 2048, (bf16*)(ws + WS_WINCD), scr, r / 8, 168 + r % 8, F.lane); continue; } r -= I2;
        if (r < I4) { const float* W = args.in[I_WUK];
            transpose_item([&](int k, int n) { const int h = n >> 8, c = n & 255; return k < 128 ? W[(size_t)c * 1024 + h * 128 + k] * 0.08838834764831845f : 0.f; }, 256, (bf16*)(ws + WS_WUK), scr, r / 64, r % 64, F.lane); continue; } r -= I4;
        { const float* W = args.in[I_WUV];
            transpose_item([&](int k, int n) { const int h = n >> 8, d = n & 255; return d < 128 ? W[(size_t)k * 1024 + h * 128 + d] : 0.f; }, 256, (bf16*)(ws + WS_WUV), scr, r / 64, r % 64, F.lane); }
    }
    __syncthreads();
    LAS bf16* WT = (LAS bf16*)F.lds;
    LAS float* wa2 = (LAS float*)(F.lds + 65536);
#pragma unroll 4
    for (int i = F.tid; i < 2048 * 4; i += 512) { const int k = i >> 2, e4 = (i & 3) * 4; const f32x4 w = *(const f32x4*)(args.in[I_WINAB] + (size_t)k * PSRC_AB + 7168 + e4);
        WT[(e4 + 0) * 2048 + k] = (bf16)f2bf(w.x); WT[(e4 + 1) * 2048 + k] = (bf16)f2bf(w.y); WT[(e4 + 2) * 2048 + k] = (bf16)f2bf(w.z); WT[(e4 + 3) * 2048 + k] = (bf16)f2bf(w.w); }
    for (int i = F.tid; i < 16 * 128; i += 512) *(LAS f32x4*)(wa2 + 4 * i) = *(const f32x4*)(args.in[I_WA2] + 4 * i);
    __syncthreads();
    const float* ba2 = args.in[I_BA2];
    for (int rep_ = 0; rep_ < ((PROBE_REPCONV & 4) ? 2 : 1); ++rep_)
    for (int m = gw; m < T; m += NGW) {
        const GAS f32x4* xr = (const GAS f32x4*)(args.in[I_X] + (size_t)m * D) + F.lane;
        f32x4 v[8];
#pragma unroll
        for (int j = 0; j < 8; ++j) v[j] = xr[64 * j];
        store_row_bf16((bf16*)(ws + WS_XB) + (size_t)m * D, v, F.lane);
        float ba[16]; row_dot16<true>(v, WT, F.lane, ba);
        f32x4 z0 = *(const f32x4*)(ba2 + 8 * F.lane), z1 = *(const f32x4*)(ba2 + 8 * F.lane + 4);
#pragma unroll
        for (int r = 0; r < 16; ++r) { const f32x4 w0 = *(const LAS f32x4*)(wa2 + r * 512 + 8 * F.lane), w1 = *(const LAS f32x4*)(wa2 + r * 512 + 8 * F.lane + 4); z0 += w0 * ba[r]; z1 += w1 * ba[r]; }
        u32x4 o; o.x = pk2(log_sigmoid_(z0.x) * 0.0625f, log_sigmoid_(z0.y) * 0.0625f); o.y = pk2(log_sigmoid_(z0.z) * 0.0625f, log_sigmoid_(z0.w) * 0.0625f);
        o.z = pk2(log_sigmoid_(z1.x) * 0.0625f, log_sigmoid_(z1.y) * 0.0625f); o.w = pk2(log_sigmoid_(z1.z) * 0.0625f, log_sigmoid_(z1.w) * 0.0625f);
        *(GAS u32x4*)((bf16*)(ws + WS_LAB) + (size_t)m * 512 + 8 * F.lane) = o;
    }
}

template <int MODE, bool XF32, bool OUTF32>
__device__ __forceinline__ void ln_phase(const Args& args, Frame& F, int layer, const float* xin) {
    unsigned char* ws = args.ws;
    const int gw = F.bid * 8 + F.wave, NGW = F.G * 8;
    if (MODE == 0) {
        LAS float* scr = (LAS float*)(F.lds + F.wave * 16384);
        const float* w1 = args.in[I_W1] + (size_t)layer * NE * 2048 * 512; const float* w3 = args.in[I_W3] + (size_t)layer * NE * 2048 * 512; const float* w2 = args.in[I_W2] + (size_t)layer * NE * 512 * 2048;
        constexpr int IA = 16 * 32 * 4, IB = 16 * 8 * 8;
        for (int rep_ = 0; rep_ < ((PROBE_REPCONV & 1) ? 2 : 1); ++rep_)
        wgt_run([&](int it) { TItem t;
            if (it < IA) { const int e = it >> 7, r = it & 127, kb = r >> 2, pn = r & 3;
                t.p0 = w1 + (size_t)e * 2048 * 512 + 128 * pn; t.p1 = w3 + (size_t)e * 2048 * 512 + 128 * pn; t.pitch = 512; t.WT = (bf16*)(ws + WS_W13) + (size_t)e * 1024 * 2048; t.Kdst = 2048; t.k0 = 64 * kb; t.n0 = 256 * pn; return t; }
            const int r0 = it - IA; const int e = r0 >> 6, r = r0 & 63, kb = r >> 3, nb = r & 7;
            t.p0 = w2 + (size_t)e * 512 * 2048 + 256 * nb; t.p1 = t.p0 + 128; t.pitch = 2048; t.WT = (bf16*)(ws + WS_W2T) + (size_t)e * 2048 * 512; t.Kdst = 512; t.k0 = 64 * kb; t.n0 = 256 * nb; return t;
        }, IA + IB, F);
        (void)scr;
        __syncthreads();
        load_w16_T((LAS float*)F.lds, args.in[I_WR], 16, 0, F.tid);
        __syncthreads();
    }
    const float* g = args.in[I_LNG] + (layer * 2 + MODE) * D; const float* bb = args.in[I_LNB] + (layer * 2 + MODE) * D;
    const bf16* tmp = (const bf16*)(ws + WS_TMP);
    const bf16* xbin = (const bf16*)(ws + WS_XB);
    const bf16* ys = (const bf16*)(ws + WS_R2);
    for (int m = gw; m < T; m += NGW) {
        f32x4 v[8]; float s = 0.f; float rstd;
        if (MODE == 0) {
            const GAS u32x2* tr = (const GAS u32x2*)(tmp + (size_t)m * D) + F.lane;
#pragma unroll
            for (int j = 0; j < 8; ++j) { const u32x2 a = tr[64 * j]; v[j] = (f32x4){bflo(a.x), bfhi(a.x), bflo(a.y), bfhi(a.y)}; }
            float s2 = 0.f;
            if (F.lane < 32) { const float* sp = (const float*)(ws + WS_STATS) + ((size_t)m * 32 + F.lane) * 2; s = sp[0]; s2 = sp[1]; }
            const float mean = wave_sum(s) * (1.f / D); const float var = fmaxf(wave_sum(s2) * (1.f / D) - mean * mean, 0.f);
            rstd = 1.f / sqrtf(var + EPS);
#pragma unroll
            for (int j = 0; j < 8; ++j) v[j] = v[j] - mean;
        } else {
        if (XF32) { const GAS f32x4* xr = (const GAS f32x4*)(xin + (size_t)m * D) + F.lane;
#pragma unroll
            for (int j = 0; j < 8; ++j) v[j] = xr[64 * j] * DN_ALPHA; }
        else { const GAS u32x2* xr = (const GAS u32x2*)(xbin + (size_t)m * D) + F.lane;
#pragma unroll
            for (int j = 0; j < 8; ++j) { const u32x2 a = xr[64 * j]; v[j] = (f32x4){bflo(a.x), bfhi(a.x), bflo(a.y), bfhi(a.y)} * DN_ALPHA; } }
        { const GAS u32x2* y0 = (const GAS u32x2*)(ys + (size_t)m * D) + F.lane; const GAS u32x2* y1 = (const GAS u32x2*)(ys + ((size_t)T + m) * D) + F.lane;
#pragma unroll
            for (int j = 0; j < 8; ++j) { const u32x2 a = y0[64 * j], b = y1[64 * j]; f32x4 y; y.x = bflo(a.x) + bflo(b.x); y.y = bfhi(a.x) + bfhi(b.x); y.z = bflo(a.y) + bflo(b.y); y.w = bfhi(a.y) + bfhi(b.y);
                v[j] += y; } }
#pragma unroll
        for (int j = 0; j < 8; ++j) s += (v[j].x + v[j].y) + (v[j].z + v[j].w);
        const float mean = wave_sum(s) * (1.f / D); float s2 = 0.f;
#pragma unroll
        for (int j = 0; j < 8; ++j) { v[j] = v[j] - mean; s2 += (v[j].x * v[j].x + v[j].y * v[j].y) + (v[j].z * v[j].z + v[j].w * v[j].w); }
        rstd = 1.f / sqrtf(wave_sum(s2) * (1.f / D) + EPS);
        }
#pragma unroll
        for (int j = 0; j < 8; ++j) { const f32x4 gg = *(const f32x4*)(g + 256 * j + 4 * F.lane), bv = *(const f32x4*)(bb + 256 * j + 4 * F.lane); v[j] = v[j] * rstd * gg + bv; }
        if (OUTF32) { GAS f32x4* orow = (GAS f32x4*)(args.out + (size_t)m * D) + F.lane;
#pragma unroll
            for (int j = 0; j < 8; ++j) orow[64 * j] = v[j]; }
        if (!OUTF32) store_row_bf16((bf16*)(ws + WS_XB) + (size_t)m * D, v, F.lane);
        if (MODE == 0) {
            float lg[16]; row_dot16<false>(v, (const LAS float*)F.lds, F.lane, lg);
            const float* br = args.in[I_BR];
            float aff[16], sel[16];
#pragma unroll
            for (int e = 0; e < 16; ++e) { aff[e] = sigmoidf_(lg[e]); sel[e] = aff[e] + br[e]; }
            float best = -3.0e38f; int bi1 = 0, bi2 = 1; float ba1 = 0.f, ba2_ = 0.f;
#pragma unroll
            for (int gq = 0; gq < 4; ++gq) {
                int i1 = 0; float s1 = sel[4 * gq];
#pragma unroll
                for (int j = 1; j < 4; ++j) if (sel[4 * gq + j] > s1) { s1 = sel[4 * gq + j]; i1 = j; }
                int i2 = -1; float s2v = -3.0e38f;
#pragma unroll
                for (int j = 0; j < 4; ++j) if (j != i1 && sel[4 * gq + j] > s2v) { s2v = sel[4 * gq + j]; i2 = j; }
                const float sc = s1 + s2v;
                float a1 = 0.f, a2 = 0.f;
#pragma unroll
                for (int j = 0; j < 4; ++j) { a1 = (j == i1) ? aff[4 * gq + j] : a1; a2 = (j == i2) ? aff[4 * gq + j] : a2; }
                if (sc > best) { best = sc; bi1 = 4 * gq + i1; bi2 = 4 * gq + i2; ba1 = a1; ba2_ = a2; }
            }
            if (F.lane == 0) {
                const float inv = 1.0f / (ba1 + ba2_);
                unsigned* cnt = (unsigned*)(F.ctl + CW_CNT) + layer * 16 * 64;
                const unsigned p1 = __hip_atomic_fetch_add(cnt + bi1 * 64, 1u, RLX_AGENT), p2 = __hip_atomic_fetch_add(cnt + bi2 * 64, 1u, RLX_AGENT);
                int* list = (int*)(ws + WS_LIST); float* wl = (float*)(ws + WS_WL);
                list[bi1 * 16384 + p1] = m; wl[bi1 * 16384 + p1] = ba1 * inv;
                list[bi2 * 16384 + p2] = m | (int)0x80000000; wl[bi2 * 16384 + p2] = ba2_ * inv;
            }
        }
    }
}
__device__ __forceinline__ f32x4 mfma16(bf16x8 a, bf16x8 b, f32x4 c) { return __builtin_amdgcn_mfma_f32_16x16x32_bf16(a, b, c, 0, 0, 0); }
__device__ __forceinline__ bf16x8 lds_frag(const LAS bf16* M, int ld, int r0, int k0, int lane) { return *(const LAS bf16x8*)(M + (r0 + (lane & 15)) * ld + k0 + 8 * (lane >> 4)); }

constexpr int H0_AQ = 0, H0_AF = 1024, H0_AI = 2048, H0_AG = 3072, H0_BQ = 4096, H0_BK = 4608, H0_BV = 5120, H0_BG = 6144;
constexpr int LDK = 72, LDQ = 136;

template <int DV>
__device__ __forceinline__ void stage_vt(LAS bf16* VT, const bf16* V, int ldv, int tid) {
    constexpr int NS = 64 * DV / 512;
    const int e = tid % DV, sq = tid / DV;
    unsigned w[NS / 2];
#pragma unroll
    for (int i = 0; i < NS / 2; ++i) { const unsigned a = V[(size_t)(sq * NS + 2 * i) * ldv + e], b = V[(size_t)(sq * NS + 2 * i + 1) * ldv + e]; w[i] = a | (b << 16); }
#pragma unroll
    for (int i = 0; i < NS / 8; ++i) { u32x4 o; o.x = w[4 * i]; o.y = w[4 * i + 1]; o.z = w[4 * i + 2]; o.w = w[4 * i + 3]; *(LAS u32x4*)(VT + e * LDK + sq * NS + 8 * i) = o; }
}

template <int DV, bool IS_A>
__device__ __forceinline__ void ab_a_unit(const Args& args, Frame& F, int b, int n, int h) {
    unsigned char* ws = args.ws;
    const bf16* h0 = (const bf16*)(ws + WS_R1);
    const bf16* lab = (const bf16*)(ws + WS_LAB);
    const int t0 = b * SEQ + n * 64, tid = F.tid, lane = F.lane, w = F.wave;
    LAS bf16* KT = (LAS bf16*)F.lds;
    LAS bf16* VT = (LAS bf16*)(F.lds + 18432);
    LAS float* part = (LAS float*)(F.lds + 18432 + 36864);
    const int d = tid & 127, tq = tid >> 7;
    float lfv[16], kv[16]; float loc = 0.f;
#pragma unroll
    for (int i = 0; i < 16; ++i) { const size_t row = (size_t)(t0 + 16 * tq + i);
        if (IS_A) { lfv[i] = bf2f(h0[row * N_AB + H0_AF + h * 128 + d]); kv[i] = -expm1f(lfv[i]); }
        else { lfv[i] = bf2f(lab[row * 512 + h * 128 + d]); kv[i] = bf2f(h0[row * N_AB + H0_BK + h * 128 + d]); }
        loc += lfv[i]; }
    part[tq * 128 + d] = loc;
    stage_vt<DV>(VT, h0 + (size_t)t0 * N_AB + (IS_A ? H0_AI + h * 128 : H0_BV + h * 256), N_AB, tid);
    __syncthreads();
    float pre = 0.f, tot = 0.f;
#pragma unroll
    for (int j = 0; j < 4; ++j) { const float p = part[j * 128 + d]; tot += p; pre += (j < tq) ? p : 0.f; }
    { float bc = pre; unsigned wv[8];
#pragma unroll
        for (int i = 0; i < 16; i += 2) { bc += lfv[i]; const float k0 = kv[i] * __expf(tot - bc); bc += lfv[i + 1]; const float k1 = kv[i + 1] * __expf(tot - bc); wv[i >> 1] = pk2(k0, k1); }
        u32x4 o0, o1; o0.x = wv[0]; o0.y = wv[1]; o0.z = wv[2]; o0.w = wv[3]; o1.x = wv[4]; o1.y = wv[5]; o1.z = wv[6]; o1.w = wv[7];
        *(LAS u32x4*)(KT + d * LDK + 16 * tq) = o0; *(LAS u32x4*)(KT + d * LDK + 16 * tq + 8) = o1; }
    if (tq == 0) { float* G = (float*)(ws + (IS_A ? WS_GA : WS_GB)); G[(size_t)((b * NCH + n) * (IS_A ? 8 : 4) + h) * 128 + d] = __expf(tot); }
    __syncthreads();
    bf16* U = (bf16*)(ws + WS_R2) + (IS_A ? (size_t)((b * NCH + n) * 8 + h) * 128 * 128 : (size_t)64 * MiB / 2 + (size_t)((b * NCH + n) * 4 + h) * 256 * 128);
    const bf16x8 a0 = lds_frag(KT, LDK, 16 * w, 0, lane), a1 = lds_frag(KT, LDK, 16 * w, 32, lane);
#pragma unroll 4
    for (int et = 0; et < DV / 16; ++et) {
        f32x4 acc = {0.f, 0.f, 0.f, 0.f};
        acc = mfma16(a0, lds_frag(VT, LDK, 16 * et, 0, lane), acc);
        acc = mfma16(a1, lds_frag(VT, LDK, 16 * et, 32, lane), acc);
        u32x2 o; o.x = pk2(acc[0], acc[1]); o.y = pk2(acc[2], acc[3]);
        *(GAS u32x2*)(U + (size_t)(16 * et + (lane & 15)) * 128 + 16 * w + 4 * (lane >> 4)) = o;
    }
    __syncthreads();
}

__device__ __forceinline__ void ab_scan(const Args& args, Frame& F) {
    unsigned char* ws = args.ws;
    const int NT_A = BATCH * 8 * 128 * 16, NT_B = BATCH * 4 * 256 * 16;
    for (int gt = F.bid * 512 + F.tid; gt < NT_A + NT_B; gt += F.G * 512) {
        const bool isA = gt < NT_A; const int r = isA ? gt : gt - NT_A;
        const int d8 = r & 15; int e, h, b, H, DV;
        if (isA) { e = (r >> 4) & 127; h = (r >> 11) & 7; b = r >> 14; H = 8; DV = 128; } else { e = (r >> 4) & 255; h = (r >> 12) & 3; b = r >> 14; H = 4; DV = 256; }
        bf16* S = (bf16*)(ws + WS_R2) + (isA ? (size_t)0 : (size_t)64 * MiB / 2);
        const float* G = (const float*)(ws + (isA ? WS_GA : WS_GB));
        float st[8];
#pragma unroll
        for (int j = 0; j < 8; ++j) st[j] = 0.f;
#pragma unroll 4
        for (int n = 0; n < NCH; ++n) {
            GAS u32x4* p = (GAS u32x4*)(S + ((size_t)((b * NCH + n) * H + h) * DV + e) * 128 + 8 * d8);
            const float* gp = G + (size_t)((b * NCH + n) * H + h) * 128 + 8 * d8;
            const u32x4 u = *p; const f32x4 g0 = *(const f32x4*)gp, g1 = *(const f32x4*)(gp + 4);
            u32x4 o; o.x = pk2(st[0], st[1]); o.y = pk2(st[2], st[3]); o.z = pk2(st[4], st[5]); o.w = pk2(st[6], st[7]);
            *p = o;
            st[0] = g0.x * st[0] + bflo(u.x); st[1] = g0.y * st[1] + bfhi(u.x); st[2] = g0.z * st[2] + bflo(u.y); st[3] = g0.w * st[3] + bfhi(u.y);
            st[4] = g1.x * st[4] + bflo(u.z); st[5] = g1.y * st[5] + bfhi(u.z); st[6] = g1.z * st[6] + bflo(u.w); st[7] = g1.w * st[7] + bfhi(u.w);
        }
    }
}

template <int DV, bool IS_A>
__device__ __forceinline__ void ab_c_unit(const Args& args, Frame& F, int b, int n, int h) {
    unsigned char* ws = args.ws;
    const bf16* h0 = (const bf16*)(ws + WS_R1);
    const bf16* lab = (const bf16*)(ws + WS_LAB);
    const int t0 = b * SEQ + n * 64, tid = F.tid, lane = F.lane, w = F.wave, r16 = lane & 15, g4 = lane >> 4;
    LAS bf16* Qs = (LAS bf16*)F.lds;
    LAS bf16* Ks = (LAS bf16*)(F.lds + 17408);
    LAS bf16* P = (LAS bf16*)(F.lds + 34816);
    LAS bf16* VT = (LAS bf16*)(F.lds + 44032);
    LAS float* part = (LAS float*)(F.lds + 80896);
    LAS float* red = (LAS float*)(F.lds + 82944);
    const int d = tid & 127, tq = tid >> 7;
    float lfv[16], qv[16], kv[16]; float loc = 0.f;
#pragma unroll
    for (int i = 0; i < 16; ++i) { const size_t row = (size_t)(t0 + 16 * tq + i);
        if (IS_A) { lfv[i] = bf2f(h0[row * N_AB + H0_AF + h * 128 + d]); kv[i] = -expm1f(lfv[i]); qv[i] = bf2f(h0[row * N_AB + H0_AQ + h * 128 + d]); }
        else { lfv[i] = bf2f(lab[row * 512 + h * 128 + d]); kv[i] = bf2f(h0[row * N_AB + H0_BK + h * 128 + d]); qv[i] = bf2f(h0[row * N_AB + H0_BQ + h * 128 + d]); }
        loc += lfv[i]; }
    part[tq * 128 + d] = loc;
    stage_vt<DV>(VT, h0 + (size_t)t0 * N_AB + (IS_A ? H0_AI + h * 128 : H0_BV + h * 256), N_AB, tid);
    __syncthreads();
    { float pre = 0.f;
#pragma unroll
        for (int j = 0; j < 4; ++j) { const float p = part[j * 128 + d]; pre += (j < tq) ? p : 0.f; }
        float bc = pre;
#pragma unroll
        for (int i = 0; i < 16; ++i) { bc += lfv[i]; const int t = 16 * tq + i;
            Qs[t * LDQ + d] = (bf16)f2bf(qv[i] * __expf(bc)); Ks[t * LDQ + d] = (bf16)f2bf(kv[i] * __expf(fminf(-bc, 80.f))); } }
    __syncthreads();
    { const int mi = w >> 1;
#pragma unroll
        for (int q = 0; q < 2; ++q) { const int ni = 2 * (w & 1) + q; f32x4 acc = {0.f, 0.f, 0.f, 0.f};
            if (ni <= mi) {
#pragma unroll
                for (int ks = 0; ks < 4; ++ks) acc = mfma16(lds_frag(Qs, LDQ, 16 * mi, 32 * ks, lane), lds_frag(Ks, LDQ, 16 * ni, 32 * ks, lane), acc); }
            const int s = 16 * ni + r16;
#pragma unroll
            for (int j = 0; j < 4; ++j) { const int t = 16 * mi + 4 * g4 + j; P[t * LDK + s] = (bf16)f2bf((ni <= mi && s <= t) ? acc[j] : 0.f); } } }
    __syncthreads();
    constexpr int NE2 = DV / 32;
    const int mi = w & 3, e0 = (w >> 2) * (DV / 2);
    const bf16* S = (const bf16*)(ws + WS_R2) + (IS_A ? (size_t)((b * NCH + n) * 8 + h) * 128 * 128 : (size_t)64 * MiB / 2 + (size_t)((b * NCH + n) * 4 + h) * 256 * 128);
    f32x4 acc[NE2];
    { const bf16x8 p0 = lds_frag(P, LDK, 16 * mi, 0, lane), p1 = lds_frag(P, LDK, 16 * mi, 32, lane);
        bf16x8 qf[4];
#pragma unroll
        for (int ks = 0; ks < 4; ++ks) qf[ks] = lds_frag(Qs, LDQ, 16 * mi, 32 * ks, lane);
#pragma unroll
        for (int i = 0; i < NE2; ++i) { const int et0 = e0 + 16 * i; f32x4 a = {0.f, 0.f, 0.f, 0.f};
            a = mfma16(p0, lds_frag(VT, LDK, et0, 0, lane), a); a = mfma16(p1, lds_frag(VT, LDK, et0, 32, lane), a);
            if (n > 0) {
#pragma unroll
                for (int ks = 0; ks < 4; ++ks) { const bf16x8 sf = *(const GAS bf16x8*)(S + (size_t)(et0 + r16) * 128 + 32 * ks + 8 * g4); a = mfma16(qf[ks], sf, a); } }
            acc[i] = a; } }
    float ss[4];
#pragma unroll
    for (int j = 0; j < 4; ++j) { float s = 0.f;
#pragma unroll
        for (int i = 0; i < NE2; ++i) s += acc[i][j] * acc[i][j];
        s += __shfl_xor(s, 1); s += __shfl_xor(s, 2); s += __shfl_xor(s, 4); s += __shfl_xor(s, 8); ss[j] = s; }
    if (r16 == 0) {
#pragma unroll
        for (int j = 0; j < 4; ++j) red[w * 16 + 4 * g4 + j] = ss[j]; }
    __syncthreads();
    const float* gn = args.in[IS_A ? I_ANORM : I_BNORM];
    const int gcol = IS_A ? H0_AG + h * 128 : H0_BG + h * 256, ocol = IS_A ? h * 128 : 1024 + h * 256;
    bf16* mixed = (bf16*)(ws + WS_MIX);
#pragma unroll
    for (int j = 0; j < 4; ++j) { const float tot = red[w * 16 + 4 * g4 + j] + red[(w ^ 4) * 16 + 4 * g4 + j]; const float rstd = 1.0f / sqrtf(tot * (1.0f / DV) + EPS);
        const size_t row = (size_t)(t0 + 16 * mi + 4 * g4 + j);
#pragma unroll
        for (int i = 0; i < NE2; ++i) { const int e = e0 + 16 * i + r16; const float gate = bf2f(h0[row * N_AB + gcol + e]);
            mixed[row * D + ocol + e] = (bf16)f2bf(acc[i][j] * rstd * gn[e] * gate); } }
    __syncthreads();
}

__device__ __forceinline__ void ab_phase_a(const Args& args, Frame& F) {
    for (int u = F.bid; u < 3072; u += F.G) {
        if (u < 2048) { const int h = u & 7, n = (u >> 3) & 63, b = u >> 9; ab_a_unit<128, true>(args, F, b, n, h); }
        else { const int v = u - 2048; const int h = v & 3, n = (v >> 2) & 63, b = v >> 8; ab_a_unit<256, false>(args, F, b, n, h); }
    }
}
__device__ __forceinline__ void ab_phase_c(const Args& args, Frame& F) {
    for (int u = F.bid; u < 3072; u += F.G) {
        if (u < 2048) { const int h = u & 7, n = (u >> 3) & 63, b = u >> 9; ab_c_unit<128, true>(args, F, b, n, h); }
        else { const int v = u - 2048; const int h = v & 3, n = (v >> 2) & 63, b = v >> 8; ab_c_unit<256, false>(args, F, b, n, h); }
    }
}
__device__ __forceinline__ int swz128(int r, int c) { return r * 256 + ((((c >> 3) ^ r) & 15) << 4) + (c & 7) * 2; }
__device__ __forceinline__ bf16x8 frag128(const LAS unsigned char* tile, int r0, int k0, int lane) { const int r = r0 + (lane & 15), ch = (k0 >> 3) + (lane >> 4); return *(const LAS bf16x8*)(tile + r * 256 + (((ch ^ r) & 15) << 4)); }
__device__ __forceinline__ bf16x8 tfrag128(const LAS unsigned char* tile, int s0, int c0, int lane) {
    const int r16 = lane & 15, g4 = lane >> 4; const int row = s0 + 8 * g4 + (r16 >> 2), col = c0 + 4 * (r16 & 3);
    const s16x4 lo = __builtin_bit_cast(s16x4, __builtin_amdgcn_ds_read_tr16_b64_v4i16((LAS s16x4*)(tile + swz128(row, col))));
    const s16x4 hi = __builtin_bit_cast(s16x4, __builtin_amdgcn_ds_read_tr16_b64_v4i16((LAS s16x4*)(tile + swz128(row + 4, col))));
    return __builtin_shufflevector(lo, hi, 0, 1, 2, 3, 4, 5, 6, 7);
}
__device__ __forceinline__ void dma_tile128(LAS unsigned char* tile, const bf16* src, size_t pitch, int rows, int wave, int lane) {
    for (int ii = wave; ii < rows / 4; ii += 8) { const int row = 4 * ii + (lane >> 4), ch = ((lane & 15) ^ row) & 15;
        __builtin_amdgcn_global_load_lds((const unsigned*)(src + (size_t)row * pitch + ch * 8), (LAS unsigned*)(tile + ii * 1024), 16, 0, 0); }
}
#define BAR_LDS() do { asm volatile("s_waitcnt lgkmcnt(0)" ::: "memory"); __builtin_amdgcn_s_barrier(); asm volatile("" ::: "memory"); } while (0)
#define BAR_ALL() do { asm volatile("s_waitcnt vmcnt(0) lgkmcnt(0)" ::: "memory"); __builtin_amdgcn_s_barrier(); asm volatile("" ::: "memory"); } while (0)

__device__ __forceinline__ void ab_decode(int u, bool& isA, int& b, int& n, int& h) {
    if (u < 2048) { isA = true; h = u & 7; n = (u >> 3) & 63; b = u >> 9; } else { const int v = u - 2048; isA = false; h = v & 3; n = (v >> 2) & 63; b = v >> 8; }
}
__device__ __forceinline__ void ab_load_raw(const Args& args, int u, int tid, bool need_q, u32x4 (&R)[6]) {
    bool isA; int b, n, h; ab_decode(u, isA, b, n, h);
    const bf16* h0 = (const bf16*)(args.ws + WS_R1); const bf16* lab = (const bf16*)(args.ws + WS_LAB);
    const size_t t0 = (size_t)(b * SEQ + n * 64);
#pragma unroll
    for (int i = 0; i < 2; ++i) { const int cid = tid + 512 * i, row = cid >> 4, ch = cid & 15;
        const bf16* hrow = h0 + (t0 + row) * N_AB + h * 128 + ch * 8;
        R[i] = isA ? *(const GAS u32x4*)(hrow + H0_AF) : *(const GAS u32x4*)(lab + (t0 + row) * 512 + h * 128 + ch * 8);
        if (need_q) R[2 + i] = *(const GAS u32x4*)(hrow + (isA ? H0_AQ : H0_BQ));
        if (!isA) R[4 + i] = *(const GAS u32x4*)(hrow + H0_BK); else R[4 + i] = (u32x4){0u, 0u, 0u, 0u}; }
}
__device__ __forceinline__ void ab_store_raw(LAS unsigned char* LF, LAS unsigned char* Q, LAS unsigned char* K, int tid, bool need_q, bool isA, const u32x4 (&R)[6]) {
#pragma unroll
    for (int i = 0; i < 2; ++i) { const int cid = tid + 512 * i, row = cid >> 4, ch = cid & 15; const int off = row * 256 + (((ch ^ row) & 15) << 4);
        *(LAS u32x4*)(LF + off) = R[i]; if (need_q) *(LAS u32x4*)(Q + off) = R[2 + i]; if (!isA) *(LAS u32x4*)(K + off) = R[4 + i]; }
}

constexpr int C2_LF = 0, C2_Q = 16384, C2_K = 32768, C2_P = 49152, C2_V0 = 58368, C2_S0 = 74752, C2_S1 = 107520, C2_PART = 140288, C2_RED = 142336;
static_assert(C2_RED + 1024 <= LDS_BYTES - 1024, "phase (c) LDS map");

template <bool IS_A>
__device__ __forceinline__ void ab_c_unit2(const Args& args, Frame& F, int b, int n, int h) {
    unsigned char* ws = args.ws; const bf16* h0 = (const bf16*)(ws + WS_R1);
    const int t0 = b * SEQ + n * 64, tid = F.tid, lane = F.lane, w = F.wave, r16 = lane & 15, g4 = lane >> 4;
    LAS unsigned char* LF = F.lds + C2_LF; LAS unsigned char* Q = F.lds + C2_Q; LAS unsigned char* K = F.lds + C2_K;
    LAS bf16* P = (LAS bf16*)(F.lds + C2_P); LAS unsigned char* V0 = F.lds + C2_V0; LAS unsigned char* S0 = F.lds + C2_S0; LAS unsigned char* S1 = F.lds + C2_S1;
    LAS float* part = (LAS float*)(F.lds + C2_PART); LAS float* red = (LAS float*)(F.lds + C2_RED);
    constexpr int DV = IS_A ? 128 : 256;
    const bf16* Sg = (const bf16*)(ws + WS_R2) + (IS_A ? (size_t)((b * NCH + n) * 8 + h) * 128 * 128 : (size_t)64 * MiB / 2 + (size_t)((b * NCH + n) * 4 + h) * 256 * 128);
    const bf16* Vg = h0 + (size_t)t0 * N_AB + (IS_A ? H0_AI + h * 128 : H0_BV + h * 256);
    dma_tile128(V0, Vg, N_AB, 64, w, lane);
    if (n > 0) { dma_tile128(S0, Sg, 128, 128, w, lane); if (!IS_A) dma_tile128(S1, Sg + 128 * 128, 128, 128, w, lane); }
    const int d = tid & 127, tq = tid >> 7;
    float lfv[16]; float loc = 0.f;
#pragma unroll
    for (int i = 0; i < 16; ++i) { lfv[i] = bf2f(*(const LAS bf16*)(LF + swz128(16 * tq + i, d))); loc += lfv[i]; }
    part[tq * 128 + d] = loc;
    BAR_LDS();
    { float pre = 0.f;
#pragma unroll
        for (int j = 0; j < 4; ++j) { const float p = part[j * 128 + d]; pre += (j < tq) ? p : 0.f; }
        float bc = pre;
#pragma unroll
        for (int i = 0; i < 16; ++i) { bc += lfv[i]; const int off = swz128(16 * tq + i, d);
            const float qv = bf2f(*(const LAS bf16*)(Q + off)); const float kv = IS_A ? -expm1f(lfv[i]) : bf2f(*(const LAS bf16*)(K + off));
            *(LAS bf16*)(Q + off) = (bf16)f2bf(qv * __expf(bc)); *(LAS bf16*)(K + off) = (bf16)f2bf(kv * __expf(fminf(-bc, 80.f))); } }
    BAR_LDS();
    if (!IS_A) dma_tile128(LF, Vg + 128, N_AB, 64, w, lane);
    { const int mi = w >> 1;
#pragma unroll
        for (int q2 = 0; q2 < 2; ++q2) { const int ni = 2 * (w & 1) + q2; f32x4 acc = {0.f, 0.f, 0.f, 0.f};
            if (ni <= mi) {
#pragma unroll
                for (int ks = 0; ks < 4; ++ks) acc = mfma16(frag128(K, 16 * ni, 32 * ks, lane), frag128(Q, 16 * mi, 32 * ks, lane), acc); }
            const int t = 16 * mi + r16, s0 = 16 * ni + 4 * g4;
            float pv[4];
#pragma unroll
            for (int j = 0; j < 4; ++j) pv[j] = (ni <= mi && s0 + j <= t) ? acc[j] : 0.f;
            u32x2 o; o.x = pk2(pv[0], pv[1]); o.y = pk2(pv[2], pv[3]);
            *(LAS u32x2*)(P + t * LDK + s0) = o; } }
    const int mi = w & 3, eh = w >> 2;
    constexpr int NH = IS_A ? 1 : 2;
    const int gcol = IS_A ? H0_AG + h * 128 : H0_BG + h * 256, ocol = IS_A ? h * 128 : 1024 + h * 256;
    const size_t row = (size_t)(t0 + 16 * mi + r16);
    u32x2 gwv[NH][4];
#pragma unroll
    for (int hf = 0; hf < NH; ++hf)
#pragma unroll
        for (int i = 0; i < 4; ++i) gwv[hf][i] = *(const GAS u32x2*)(h0 + row * N_AB + gcol + 128 * hf + 64 * eh + 16 * i + 4 * g4);
    BAR_ALL();
    f32x4 acc[NH][4];
    { const bf16x8 p0 = lds_frag(P, LDK, 16 * mi, 0, lane), p1 = lds_frag(P, LDK, 16 * mi, 32, lane);
        bf16x8 qf[4];
#pragma unroll
        for (int ks = 0; ks < 4; ++ks) qf[ks] = frag128(Q, 16 * mi, 32 * ks, lane);
#pragma unroll
        for (int hf = 0; hf < NH; ++hf) { const LAS unsigned char* Vt = hf ? LF : V0; const LAS unsigned char* St = hf ? S1 : S0;
#pragma unroll
            for (int i = 0; i < 4; ++i) { const int e0 = 64 * eh + 16 * i; f32x4 a = {0.f, 0.f, 0.f, 0.f};
                a = mfma16(tfrag128(Vt, 0, e0, lane), p0, a); a = mfma16(tfrag128(Vt, 32, e0, lane), p1, a);
                if (n > 0) {
#pragma unroll
                    for (int ks = 0; ks < 4; ++ks) a = mfma16(frag128(St, e0, 32 * ks, lane), qf[ks], a); }
                acc[hf][i] = a; } } }
    float ss = 0.f;
#pragma unroll
    for (int hf = 0; hf < NH; ++hf)
#pragma unroll
        for (int i = 0; i < 4; ++i)
#pragma unroll
            for (int j = 0; j < 4; ++j) ss += acc[hf][i][j] * acc[hf][i][j];
    ss += __shfl_xor(ss, 16); ss += __shfl_xor(ss, 32);
    if (g4 == 0) red[eh * 64 + 16 * mi + r16] = ss;
    BAR_LDS();
    const float tot = red[16 * mi + r16] + red[64 + 16 * mi + r16]; const float rstd = 1.0f / sqrtf(tot * (1.0f / DV) + EPS);
    const float* gn = args.in[IS_A ? I_ANORM : I_BNORM];
    bf16* mixed = (bf16*)(ws + WS_MIX);
#pragma unroll
    for (int hf = 0; hf < NH; ++hf)
#pragma unroll
        for (int i = 0; i < 4; ++i) { const int e = 128 * hf + 64 * eh + 16 * i + 4 * g4;
            const u32x2 gw = gwv[hf][i]; const f32x4 gg = *(const f32x4*)(gn + e);
            u32x2 o; o.x = pk2(acc[hf][i][0] * rstd * gg.x * bflo(gw.x), acc[hf][i][1] * rstd * gg.y * bfhi(gw.x)); o.y = pk2(acc[hf][i][2] * rstd * gg.z * bflo(gw.y), acc[hf][i][3] * rstd * gg.w * bfhi(gw.y));
            *(GAS u32x2*)(mixed + row * D + ocol + e) = o; }
}

__device__ __forceinline__ void ab_phase_c2(const Args& args, Frame& F) {
    u32x4 R[6];
    int u = F.bid;
    if (u < 3072) ab_load_raw(args, u, F.tid, true, R);
    for (; u < 3072; u += F.G) {
        bool isA; int b, n, h; ab_decode(u, isA, b, n, h);
        BAR_ALL();
        ab_store_raw(F.lds + C2_LF, F.lds + C2_Q, F.lds + C2_K, F.tid, true, isA, R);
        if (u + F.G < 3072) ab_load_raw(args, u + F.G, F.tid, true, R);
        BAR_LDS();
        if (isA) ab_c_unit2<true>(args, F, b, n, h); else ab_c_unit2<false>(args, F, b, n, h);
    }
    BAR_ALL();
}

constexpr int A2_LF = 0, A2_K = 16384, A2_KT = 32768, A2_V0 = 51200, A2_V1 = 67584, A2_PART = 83968;
template <bool IS_A>
__device__ __forceinline__ void ab_a_unit2(const Args& args, Frame& F, int b, int n, int h) {
    unsigned char* ws = args.ws; const bf16* h0 = (const bf16*)(ws + WS_R1);
    const int t0 = b * SEQ + n * 64, tid = F.tid, lane = F.lane, w = F.wave;
    LAS unsigned char* LF = F.lds + A2_LF; LAS unsigned char* K = F.lds + A2_K; LAS bf16* KT = (LAS bf16*)(F.lds + A2_KT);
    LAS unsigned char* V0 = F.lds + A2_V0; LAS unsigned char* V1 = F.lds + A2_V1; LAS float* part = (LAS float*)(F.lds + A2_PART);
    constexpr int DV = IS_A ? 128 : 256;
    const bf16* Vg = h0 + (size_t)t0 * N_AB + (IS_A ? H0_AI + h * 128 : H0_BV + h * 256);
    dma_tile128(V0, Vg, N_AB, 64, w, lane);
    if (!IS_A) dma_tile128(V1, Vg + 128, N_AB, 64, w, lane);
    const int d = tid & 127, tq = tid >> 7;
    float lfv[16], kv[16]; float loc = 0.f;
#pragma unroll
    for (int i = 0; i < 16; ++i) { const int off = swz128(16 * tq + i, d); lfv[i] = bf2f(*(const LAS bf16*)(LF + off)); kv[i] = IS_A ? -expm1f(lfv[i]) : bf2f(*(const LAS bf16*)(K + off)); loc += lfv[i]; }
    part[tq * 128 + d] = loc;
    BAR_LDS();
    float pre = 0.f, tot = 0.f;
#pragma unroll
    for (int j = 0; j < 4; ++j) { const float p = part[j * 128 + d]; tot += p; pre += (j < tq) ? p : 0.f; }
    { float bc = pre; unsigned wv[8];
#pragma unroll
        for (int i = 0; i < 16; i += 2) { bc += lfv[i]; const float k0 = kv[i] * __expf(tot - bc); bc += lfv[i + 1]; const float k1 = kv[i + 1] * __expf(tot - bc); wv[i >> 1] = pk2(k0, k1); }
        u32x4 o0, o1; o0.x = wv[0]; o0.y = wv[1]; o0.z = wv[2]; o0.w = wv[3]; o1.x = wv[4]; o1.y = wv[5]; o1.z = wv[6]; o1.w = wv[7];
        *(LAS u32x4*)(KT + d * LDK + 16 * tq) = o0; *(LAS u32x4*)(KT + d * LDK + 16 * tq + 8) = o1; }
    if (tq == 0) { float* G = (float*)(ws + (IS_A ? WS_GA : WS_GB)); G[(size_t)((b * NCH + n) * (IS_A ? 8 : 4) + h) * 128 + d] = __expf(tot); }
    BAR_ALL();
    bf16* U = (bf16*)(ws + WS_R2) + (IS_A ? (size_t)((b * NCH + n) * 8 + h) * 128 * 128 : (size_t)64 * MiB / 2 + (size_t)((b * NCH + n) * 4 + h) * 256 * 128);
    const bf16x8 a0 = lds_frag(KT, LDK, 16 * w, 0, lane), a1 = lds_frag(KT, LDK, 16 * w, 32, lane);
#pragma unroll 4
    for (int et = 0; et < DV / 16; ++et) { const LAS unsigned char* Vt = (et < 8) ? V0 : V1; const int c0 = (et & 7) * 16;
        f32x4 acc = {0.f, 0.f, 0.f, 0.f};
        acc = mfma16(a0, tfrag128(Vt, 0, c0, lane), acc);
        acc = mfma16(a1, tfrag128(Vt, 32, c0, lane), acc);
        u32x2 o; o.x = pk2(acc[0], acc[1]); o.y = pk2(acc[2], acc[3]);
        *(GAS u32x2*)(U + (size_t)(16 * et + (lane & 15)) * 128 + 16 * w + 4 * (lane >> 4)) = o; }
}
__device__ __forceinline__ void ab_phase_a2(const Args& args, Frame& F) {
    u32x4 R[6];
    int u = F.bid;
    if (u < 3072) ab_load_raw(args, u, F.tid, false, R);
    for (; u < 3072; u += F.G) {
        bool isA; int b, n, h; ab_decode(u, isA, b, n, h);
        BAR_ALL();
        ab_store_raw(F.lds + A2_LF, F.lds + A2_LF, F.lds + A2_K, F.tid, false, isA, R);
        if (u + F.G < 3072) ab_load_raw(args, u + F.G, F.tid, false, R);
        BAR_LDS();
        if (isA) ab_a_unit2<true>(args, F, b, n, h); else ab_a_unit2<false>(args, F, b, n, h);
    }
    BAR_ALL();
}
#ifndef PROBE_SKIP
#define PROBE_SKIP 0
#endif
constexpr int H1_CQ = 0, H1_CKV = 1024, H1_IQ = 1280, H1_DQ = 2304, H1_DK = 2816, H1_DV = 3328, H1_DOG = 4352;
constexpr int SM_IK = 0, SM_IW = 64, SM_DI = 80, SM_DF = 84;
constexpr size_t SCORES_PER_BATCH = (size_t)4096 * 64 * 65 / 2;
__device__ __forceinline__ size_t score_row_off(int t) { const size_t c = (size_t)(t >> 6), r = (size_t)(t & 63); return 2048 * c * (c + 1) + 64 * r * (c + 1); }

__device__ __forceinline__ void dsa_prep_rows(const Args& args, Frame& F) {
    unsigned char* ws = args.ws; const bf16* h1 = (const bf16*)(ws + WS_R1); bf16* ckvn = (bf16*)(ws + WS_CKVN);
    const float* g = args.in[I_CKVG];
    const int gw = F.bid * 8 + F.wave, NGW = F.G * 8;
    for (int m = gw; m < T; m += NGW) {
        const u32x2 v = *(const GAS u32x2*)(h1 + (size_t)m * N_CD + H1_CKV + 4 * F.lane);
        const float a = bflo(v.x), b = bfhi(v.x), c = bflo(v.y), d = bfhi(v.y);
        const float ss = wave_sum(a * a + b * b + c * c + d * d); const float rs = 1.0f / sqrtf(ss * (1.0f / 256.f) + EPS);
        const f32x4 gg = *(const f32x4*)(g + 4 * F.lane);
        u32x2 o; o.x = pk2(a * rs * gg.x, b * rs * gg.y); o.y = pk2(c * rs * gg.z, d * rs * gg.w);
        *(GAS u32x2*)(ckvn + (size_t)m * 256 + 4 * F.lane) = o;
    }
}

__device__ __forceinline__ void dsa_indexer(const Args& args, Frame& F) {
    unsigned char* ws = args.ws; const bf16* h1 = (const bf16*)(ws + WS_R1); const float* small = (const float*)(ws + WS_SMALL);
    float* scores = (float*)(ws + WS_R2);
    LAS bf16* KS = (LAS bf16*)F.lds;
    const int lane = F.lane, w = F.wave, r16 = lane & 15, g4 = lane >> 4;
    const int u_lo = (int)((long)F.bid * (4 * 272) / F.G), u_hi = (int)((long)(F.bid + 1) * (4 * 272) / F.G);
    int u = u_lo;
    while (u < u_hi) {
        const int b = u / 272; int v = u % 272; int qt = 0;
        { int p = 0; while ((p + 1) * (p + 2) <= v) ++p; v -= p * (p + 1); if (v < p + 1) { qt = 2 * p; } else { qt = 2 * p + 1; v -= p + 1; } }
        const int seg0 = v; const int nsq = (qt >> 1) + 1;
        int nseg = nsq - seg0; if (nseg > u_hi - u) nseg = u_hi - u;
        const int q0 = qt * 128;
        const int tq = q0 + 16 * w + r16; const size_t qrow = (size_t)(b * SEQ + tq);
        bf16x8 qf[16][2]; float wv[16];
#pragma unroll
        for (int hh = 0; hh < 16; ++hh) {
#pragma unroll
            for (int ks = 0; ks < 2; ++ks) qf[hh][ks] = *(const GAS bf16x8*)(h1 + qrow * N_CD + H1_IQ + hh * 64 + ks * 32 + 8 * g4);
            wv[hh] = small[qrow * 128 + SM_IW + hh] * 0.25f; }
        const size_t rowbase = (size_t)b * SCORES_PER_BATCH + score_row_off(tq);
        const int rowlen = 64 * ((tq >> 6) + 1);
#pragma unroll 1
        for (int sg = 0; sg < nseg; ++sg) {
            const int s0 = (seg0 + sg) * 256;
            __syncthreads();
#pragma unroll 2
            for (int i = F.tid; i < 256 * 16; i += 512) { const int s = i >> 4, c4 = (i & 15) * 4; const f32x4 kv = *(const f32x4*)(small + (size_t)(b * SEQ + s0 + s) * 128 + SM_IK + c4);
                u32x2 o; o.x = pk2(kv.x, kv.y); o.y = pk2(kv.z, kv.w); *(LAS u32x2*)(KS + s * LDK + c4) = o; }
            __syncthreads();
#pragma unroll 1
            for (int kt = 0; kt < 16; ++kt) {
                if (s0 + 16 * kt > q0 + 16 * w + 15) break;
                const bf16x8 k0 = lds_frag(KS, LDK, 16 * kt, 0, lane), k1 = lds_frag(KS, LDK, 16 * kt, 32, lane);
                f32x4 sc = {0.f, 0.f, 0.f, 0.f};
#pragma unroll
                for (int hh = 0; hh < 16; ++hh) { f32x4 a = {0.f, 0.f, 0.f, 0.f}; a = mfma16(k0, qf[hh][0], a); a = mfma16(k1, qf[hh][1], a);
#pragma unroll
                    for (int j = 0; j < 4; ++j) sc[j] += wv[hh] * fmaxf(a[j], 0.f); }
                const int sk = s0 + 16 * kt + 4 * g4;
                if (sk < rowlen) *(GAS f32x4*)(scores + rowbase + sk) = sc;
            }
        }
        u += nseg;
    }
}

#ifndef PROBE_TOPK_NOHIST
#define PROBE_TOPK_NOHIST 0
#endif
#ifndef PROBE_TOPK_NOEMIT
#define PROBE_TOPK_NOEMIT 0
#endif
template <int NB>
__device__ __forceinline__ void topk_scan(LAS unsigned* hist, int lane, int need, int& bin, int& above, int& cnt) {
    unsigned c[NB]; unsigned tot = 0u;
#pragma unroll
    for (int q = 0; q < NB / 4; ++q) { const u32x4 v = *(const LAS u32x4*)(hist + NB * lane + 4 * q); c[4 * q] = v.x; c[4 * q + 1] = v.y; c[4 * q + 2] = v.z; c[4 * q + 3] = v.w; tot += (v.x + v.y) + (v.z + v.w); }
#pragma unroll
    for (int q = 0; q < NB / 4; ++q) *(LAS u32x4*)(hist + NB * lane + 4 * q) = (u32x4){0u, 0u, 0u, 0u};
    unsigned inc = tot;
#pragma unroll
    for (int o = 1; o < 64; o <<= 1) { const unsigned u = __shfl_down(inc, o); if (lane + o < 64) inc += u; }
    unsigned run = inc - tot; int fb = -1; unsigned fa = 0u, fc = 0u;
#pragma unroll
    for (int jj = NB - 1; jj >= 0; --jj) { const unsigned cj = c[jj]; const bool hit = (run < (unsigned)need) && (run + cj >= (unsigned)need); fb = hit ? jj : fb; fa = hit ? run : fa; fc = hit ? cj : fc; run += cj; }
    const unsigned long long m = __ballot(fb >= 0); const int L = (int)__builtin_ctzll(m);
    bin = __shfl(NB * lane + fb, L); above = (int)__shfl(fa, L); cnt = (int)__shfl(fc, L);
}
__device__ __forceinline__ void topk_keys16(const float* sr, int t, int lane, int c, unsigned (&key)[16]) {
#pragma unroll
    for (int j = 0; j < 16; ++j) { const int i = 16 * c + j; const int s = 64 * i + lane; unsigned k = 0u;
        if (64 * i <= t) { const unsigned bits = __builtin_bit_cast(unsigned, sr[s]); k = (bits & 0x80000000u) ? ~bits : (bits | 0x80000000u); if (s > t) k = 0u; }
        key[j] = k; }
}
__device__ __forceinline__ void topk_row(const float* sr, int t, int lane, LAS unsigned* hist, unsigned short* out) {
    const int nchunk = (t >> 10) + 1;
    int bin, above, cnt; unsigned tau; int need_eq = 0x7fffffff;
#if PROBE_TOPK_NOHIST
    tau = 0xC0000000u; if (false) {
#endif
#pragma unroll 1
    for (int c = 0; c < nchunk; ++c) { unsigned key[16]; topk_keys16(sr, t, lane, c, key);
#pragma unroll
        for (int j = 0; j < 16; ++j) __hip_atomic_fetch_add(hist + (key[j] >> 21), 1u, __ATOMIC_RELAXED, __HIP_MEMORY_SCOPE_WORKGROUP); }
    topk_scan<32>(hist, lane, 256, bin, above, cnt);
    tau = (unsigned)bin << 21; int need = 256 - above;
    if (need != cnt) {
        const unsigned p1 = (unsigned)bin;
#pragma unroll 1
        for (int c = 0; c < nchunk; ++c) { unsigned key[16]; topk_keys16(sr, t, lane, c, key);
#pragma unroll
            for (int j = 0; j < 16; ++j) if ((key[j] >> 21) == p1) __hip_atomic_fetch_add(hist + ((key[j] >> 10) & 2047u), 1u, __ATOMIC_RELAXED, __HIP_MEMORY_SCOPE_WORKGROUP); }
        topk_scan<32>(hist, lane, need, bin, above, cnt);
        tau |= (unsigned)bin << 10; need -= above;
        if (need != cnt) {
            const unsigned p2 = tau >> 10;
#pragma unroll 1
            for (int c = 0; c < nchunk; ++c) { unsigned key[16]; topk_keys16(sr, t, lane, c, key);
#pragma unroll
                for (int j = 0; j < 16; ++j) if ((key[j] >> 10) == p2) __hip_atomic_fetch_add(hist + (key[j] & 1023u), 1u, __ATOMIC_RELAXED, __HIP_MEMORY_SCOPE_WORKGROUP); }
            topk_scan<16>(hist, lane, need, bin, above, cnt);
            tau |= (unsigned)bin; need_eq = need - above;
        }
    }
#if PROBE_TOPK_NOHIST
    }
#endif
    int pos = 0, eqseen = 0;
    if (PROBE_TOPK_NOEMIT) return;
    const unsigned long long lt_mask = (1ull << lane) - 1ull;
#pragma unroll 1
    for (int c = 0; c < nchunk; ++c) { unsigned key[16]; topk_keys16(sr, t, lane, c, key);
#pragma unroll
        for (int j = 0; j < 16; ++j) {
            const bool gt = key[j] > tau, eq = key[j] == tau;
            const unsigned long long meq = __ballot(eq);
            const bool take = gt || (eq && (eqseen + __builtin_popcountll(meq & lt_mask) < need_eq));
            const unsigned long long mt = __ballot(take);
            if (take && (!PROBE_TOPK_NOHIST || pos + __builtin_popcountll(mt & lt_mask) < 256)) out[pos + __builtin_popcountll(mt & lt_mask)] = (unsigned short)(64 * (16 * c + j) + lane);
            pos += __builtin_popcountll(mt); eqseen += __builtin_popcountll(meq);
        } }
}
__device__ __forceinline__ bool topk_row_fast(const float* sr, int t, int lane, LAS unsigned* hist, LAS unsigned* memb, unsigned short* out) {
    const int nchunk = (t >> 10) + 1;
    float v[64];
#pragma unroll
    for (int c = 0; c < 4; ++c) {
        if (c < nchunk) {
#pragma unroll
            for (int j = 0; j < 16; ++j) { const int i = 16 * c + j; float x = -INFINITY; if (64 * i <= t) x = sr[64 * i + lane]; v[i] = x; }
        } else {
#pragma unroll
            for (int j = 0; j < 16; ++j) v[16 * c + j] = -INFINITY;
        }
    }
    float lo = v[0], hi = v[0];
#pragma unroll
    for (int o = 1; o < 64; o <<= 1) { lo = fminf(lo, __shfl_xor(lo, o)); hi = fmaxf(hi, __shfl_xor(hi, o)); }
    const float dd = hi - lo; lo -= 0.75f * dd; hi += 0.75f * dd;
    const float inv = (hi > lo) ? 2047.5f / (hi - lo) : 0.f;
#define TOPK_BIN(x, s) (((s) <= t) ? (int)fminf(fmaxf(((x) - lo) * inv, 0.f), 2047.f) : -1)
#pragma unroll
    for (int c = 0; c < 4; ++c) if (c < nchunk) {
#pragma unroll
        for (int j = 0; j < 16; ++j) { const int i = 16 * c + j; const int b = TOPK_BIN(v[i], 64 * i + lane); if (b >= 0) __hip_atomic_fetch_add(hist + b, 1u, __ATOMIC_RELAXED, __HIP_MEMORY_SCOPE_WORKGROUP); }
    }
    int B, above, cnt;
    topk_scan<32>(hist, lane, 256, B, above, cnt);
    if (cnt > 64) return false;
    const int need2 = 256 - above;
    const unsigned long long lt_mask = (1ull << lane) - 1ull;
    int pos = 0, nm = 0;
#pragma unroll
    for (int c = 0; c < 4; ++c) if (c < nchunk) {
#pragma unroll
        for (int j = 0; j < 16; ++j) { const int i = 16 * c + j; const int s = 64 * i + lane; const int b = TOPK_BIN(v[i], s);
            const unsigned long long mg = __ballot(b > B);
            if (b > B) out[pos + __builtin_popcountll(mg & lt_mask)] = (unsigned short)s;
            pos += __builtin_popcountll(mg);
            const unsigned long long me = __ballot(b == B);
            if (me != 0ull) { if (b == B) { const int slot = nm + __builtin_popcountll(me & lt_mask); const unsigned bits = __builtin_bit_cast(unsigned, v[i]);
                    memb[slot] = (bits & 0x80000000u) ? ~bits : (bits | 0x80000000u); memb[64 + slot] = (unsigned)s; }
                nm += __builtin_popcountll(me); }
        }
    }
#undef TOPK_BIN
    const unsigned mk = (lane < nm) ? memb[lane] : 0u, mi = (lane < nm) ? memb[64 + lane] : 0xffffffffu;
    int rank = 0;
    for (int q = 0; q < nm; ++q) { const unsigned kq = __builtin_amdgcn_readlane(mk, q), iq = __builtin_amdgcn_readlane(mi, q); rank += (kq > mk || (kq == mk && iq < mi)) ? 1 : 0; }
    if (lane < nm && rank < need2) out[above + rank] = (unsigned short)mi;
    return true;
}
__device__ __forceinline__ void dsa_topk(const Args& args, Frame& F) {
    unsigned char* ws = args.ws; const float* scores = (const float*)(ws + WS_R2); unsigned short* idx = (unsigned short*)(ws + WS_IDX);
    const int lane = F.lane; const int gw = F.bid * 8 + F.wave, NGW = F.G * 8;
    LAS unsigned* hist = (LAS unsigned*)(F.lds + F.wave * 8192);
    LAS unsigned* memb = (LAS unsigned*)(F.lds + 65536 + F.wave * 512);
    __syncthreads();
    for (int i = lane; i < 2048; i += 64) hist[i] = 0u;
    for (int rr = gw; rr < T; rr += NGW) {
        const int b = rr >> 12, jj = rr & 4095; const int t = (jj & 1) ? 4095 - (jj >> 1) : (jj >> 1); const int row = b * SEQ + t;
        unsigned short* out = idx + (size_t)row * 256;
        if (t < 256) {
#pragma unroll
            for (int i = 0; i < 4; ++i) { const int s = 64 * i + lane; out[s] = (unsigned short)(s <= t ? s : 0); }
            continue;
        }
        const float* sr = scores + (size_t)b * SCORES_PER_BATCH + score_row_off(t);
        if (!topk_row_fast(sr, t, lane, hist, memb, out)) topk_row(sr, t, lane, hist, out);
    }
}

#ifndef PROBE_ONETILE
#define PROBE_ONETILE 0
#endif
#ifndef PROBE_NOSTORE
#define PROBE_NOSTORE 0
#endif
#ifndef PROBE_NOGATHER
#define PROBE_NOGATHER 0
#endif
__device__ __forceinline__ void pl16(float& a, float& b) { asm volatile("s_nop 1\n\tv_permlane16_swap_b32 %0, %1" : "+v"(a), "+v"(b)); }
__device__ __forceinline__ void pl32(float& a, float& b) { asm volatile("s_nop 1\n\tv_permlane32_swap_b32 %0, %1" : "+v"(a), "+v"(b)); }
__device__ __forceinline__ float xmax16(float x) { float a = x, b = x; pl16(a, b); return fmaxf(a, b); }
__device__ __forceinline__ float xmax32(float x) { float a = x, b = x; pl32(a, b); return fmaxf(a, b); }
__device__ __forceinline__ float xadd16(float x) { float a = x, b = x; pl16(a, b); return a + b; }
__device__ __forceinline__ float xadd32(float x) { float a = x, b = x; pl32(a, b); return a + b; }
__device__ __forceinline__ s16x4 lds_tr(const LAS bf16* p) { return __builtin_bit_cast(s16x4, __builtin_amdgcn_ds_read_tr16_b64_v4i16((LAS s16x4*)p)); }
__device__ __forceinline__ void dsa_attention(const Args& args, Frame& F, bf16* obuf) {
    unsigned char* ws = args.ws; const bf16* ckvn = (const bf16*)(ws + WS_CKVN); bf16* qo = (bf16*)args.out; const unsigned short* idx = (const unsigned short*)(ws + WS_IDX);
    const int lane = F.lane, w = F.wave, r16 = lane & 15, g4 = lane >> 4;
    constexpr int LDV = 264;
    LAS bf16* KV = (LAS bf16*)(F.lds + w * (32 * LDV * 2));
    LAS float* rel = (LAS float*)(F.lds + 8 * 32 * LDV * 2);
    LAS unsigned char* bkt = (LAS unsigned char*)(F.lds + 8 * 32 * LDV * 2 + 1024);
    LAS unsigned char* bkey = (LAS unsigned char*)(F.lds + 8 * 32 * LDV * 2 + 1024 + 128 + w * 256);
    __syncthreads();
    if (F.tid < 256) rel[F.tid] = args.in[I_REL][F.tid];
    if (F.tid < 128) { const int n = F.tid; int bk = n; if (n >= 16) { int lg = 16 + (int)(__logf((float)n / 16.0f) / 2.0794415416798357f * 16.0f); bk = lg < 31 ? lg : 31; } bkt[n] = (unsigned char)bk; }
    __syncthreads();
    const bool g8 = (F.G & 7) == 0 && F.G >= 8;
    const int nwb = g8 ? (F.G / 8) * 2 * 8 : F.G * 8;
    const int wib = g8 ? ((F.bid >> 3) * 2 + (F.bid & 1)) * 8 + w : F.bid * 8 + w;
    const int bsel = g8 ? ((F.bid & 7) >> 1) : -1;
    const int nrows = g8 ? SEQ : T;
    const LAS bf16* tr_lo = KV + (4 * g4 + (r16 >> 2)) * LDV + 4 * (r16 & 3);
    const LAS bf16* tr_hi = tr_lo + 16 * LDV;
    for (int rr0 = wib; rr0 < nrows; rr0 += nwb) {
        const int b = g8 ? bsel : (rr0 >> 12); const int jj = rr0 & 4095; const int t = (jj & 1) ? 4095 - (jj >> 1) : (jj >> 1); const int row = b * SEQ + t;
        const int nsel = t < 255 ? t + 1 : 256;
        int myidx[4];
#pragma unroll
        for (int i = 0; i < 4; ++i) myidx[i] = idx[(size_t)row * 256 + 64 * i + lane];
#pragma unroll
        for (int i = 0; i < 4; ++i) { int dist = t - myidx[i]; dist = dist < 0 ? 0 : dist; bkey[64 * i + lane] = (dist < 128) ? bkt[dist] : (unsigned char)31; }
        bf16x8 qf[8];
#pragma unroll
        for (int ks = 0; ks < 8; ++ks) qf[ks] = *(const GAS bf16x8*)(qo + (size_t)row * D + (r16 & 7) * 256 + 32 * ks + 8 * g4);
        f32x4 o[16];
#pragma unroll
        for (int i = 0; i < 16; ++i) o[i] = (f32x4){0.f, 0.f, 0.f, 0.f};
        float mrun = -3.0e38f, lrun = 0.f;
        const int ntile = PROBE_ONETILE ? 1 : ((nsel + 31) >> 5);
        const bf16* kvb = ckvn + (size_t)(b * SEQ) * 256 + 8 * (lane & 31);
        u32x4 G[16];
        {
#pragma unroll
            for (int i = 0; i < 16; ++i) { const int kidx = __shfl(myidx[0], 2 * i + (lane >> 5)); G[i] = *(const GAS u32x4*)(kvb + (size_t)(PROBE_NOGATHER ? (kidx & 31) : kidx) * 256); } }
#pragma unroll 1
        for (int kt = 0; kt < ntile; ++kt) {
            const int src = (kt & 1) * 32;
            const int ireg = (kt >> 1) == 0 ? myidx[0] : (kt >> 1) == 1 ? myidx[1] : (kt >> 1) == 2 ? myidx[2] : myidx[3];
#pragma unroll
            for (int i = 0; i < 16; ++i) *(LAS u32x4*)(KV + (2 * i + (lane >> 5)) * LDV + 8 * (lane & 31)) = G[i];
            if (kt + 1 < ntile) {
                const int src2 = ((kt + 1) & 1) * 32;
                const int ireg2 = ((kt + 1) >> 1) == 0 ? myidx[0] : ((kt + 1) >> 1) == 1 ? myidx[1] : ((kt + 1) >> 1) == 2 ? myidx[2] : myidx[3];
#pragma unroll
                for (int i = 0; i < 16; ++i) { const int kidx = __shfl(ireg2, src2 + 2 * i + (lane >> 5)); G[i] = *(const GAS u32x4*)(kvb + (size_t)(PROBE_NOGATHER ? (kidx & 31) : kidx) * 256); }
            }
            f32x4 s0 = {0.f, 0.f, 0.f, 0.f}, s1 = {0.f, 0.f, 0.f, 0.f};
#pragma unroll
            for (int ks = 0; ks < 8; ++ks) { s0 = mfma16(lds_frag(KV, LDV, 0, 32 * ks, lane), qf[ks], s0); s1 = mfma16(lds_frag(KV, LDV, 16, 32 * ks, lane), qf[ks], s1); }
            float lg[8];
#pragma unroll
            for (int j = 0; j < 8; ++j) { const int kl = (j < 4 ? 4 * g4 + j : 16 + 4 * g4 + (j - 4)); const int kk = 32 * kt + kl; const int bk = (int)bkey[kk];
                const float v = (j < 4 ? s0[j] : s1[j - 4]) + rel[bk * 8 + (r16 & 7)];
                lg[j] = (kk < nsel) ? v : -3.0e38f; }
            float mx = lg[0];
#pragma unroll
            for (int j = 1; j < 8; ++j) mx = fmaxf(mx, lg[j]);
            mx = xmax16(mx); mx = xmax32(mx);
            const bool grow = mx > mrun;
            const float mnew = grow ? mx : mrun; const float corr = grow ? __expf(mrun - mnew) : 1.0f;
            float p[8], ps = 0.f;
#pragma unroll
            for (int j = 0; j < 8; ++j) { p[j] = (lg[j] > -1.0e38f) ? __expf(lg[j] - mnew) : 0.f; ps += p[j]; }
            ps = xadd16(ps); ps = xadd32(ps);
            lrun = lrun * corr + ps; mrun = mnew;
            bf16x8 pf; { u32x4 pw; pw.x = pk2(p[0], p[1]); pw.y = pk2(p[2], p[3]); pw.z = pk2(p[4], p[5]); pw.w = pk2(p[6], p[7]); pf = __builtin_bit_cast(bf16x8, pw); }
            if (__any(grow)) {
                float cr[4];
#pragma unroll
                for (int j = 0; j < 4; ++j) cr[j] = __shfl(corr, (4 * g4 + j) & 7);
#pragma unroll
                for (int nt = 0; nt < 16; ++nt)
#pragma unroll
                    for (int j = 0; j < 4; ++j) o[nt][j] *= cr[j];
            }
#pragma unroll
            for (int nt = 0; nt < 16; ++nt) {
                const s16x4 lo = lds_tr(tr_lo + 16 * nt), hi = lds_tr(tr_hi + 16 * nt);
                bf16x8 vf; vf[0] = lo[0]; vf[1] = lo[1]; vf[2] = lo[2]; vf[3] = lo[3]; vf[4] = hi[0]; vf[5] = hi[1]; vf[6] = hi[2]; vf[7] = hi[3];
                o[nt] = mfma16(pf, vf, o[nt]);
            }
        }
        float linv[4];
#pragma unroll
        for (int j = 0; j < 4; ++j) linv[j] = 1.0f / __shfl(lrun, (4 * g4 + j) & 7);
        if (g4 < 2 && !PROBE_NOSTORE) {
#pragma unroll
            for (int nt = 0; nt < 16; ++nt)
#pragma unroll
                for (int j = 0; j < 4; ++j) obuf[(size_t)row * D + (4 * g4 + j) * 256 + 16 * nt + r16] = (bf16)f2bf(o[nt][j] * linv[j]);
        }
    }
}
__device__ __forceinline__ float ml_wave_incl_scan_add(float v, int lane) {
#pragma unroll
    for (int o = 1; o < 64; o <<= 1) { const float u = __shfl_up(v, o); if (lane >= o) v += u; }
    return v;
}
__device__ __forceinline__ float ml_wave_incl_scan_max(float v, int lane) {
#pragma unroll
    for (int o = 1; o < 64; o <<= 1) { const float u = __shfl_up(v, o); if (lane >= o) v = fmaxf(v, u); }
    return v;
}
constexpr size_t ML_A = 0, ML_BL = 4096, ML_MP = 8192;

__device__ __forceinline__ void ml_conv16(const bf16* h1, int b, int s0, int col, const float (&w4)[4], float (&out)[16]) {
    float x[19];
#pragma unroll
    for (int i = 0; i < 19; ++i) { const int s = s0 - 3 + i; x[i] = (s >= 0) ? bf2f(h1[(size_t)(b * SEQ + s) * N_CD + col]) : 0.f; }
#pragma unroll
    for (int i = 0; i < 16; ++i) { const float c = w4[0] * x[i] + w4[1] * x[i + 1] + w4[2] * x[i + 2] + w4[3] * x[i + 3]; out[i] = siluf_(c); }
}

__device__ __forceinline__ void ml_a_unit(const Args& args, Frame& F, int b, int n, int h) {
    unsigned char* ws = args.ws; const bf16* h1 = (const bf16*)(ws + WS_R1); const float* small = (const float*)(ws + WS_SMALL);
    const int t0 = b * SEQ + n * 64, tid = F.tid, lane = F.lane, w = F.wave;
    LAS bf16* KT = (LAS bf16*)F.lds;
    LAS bf16* VT = (LAS bf16*)(F.lds + 18432);
    LAS float* part = (LAS float*)(F.lds + 55296);
    LAS float* uu = (LAS float*)(F.lds + 57344);
    const float* gb = args.in[I_GATEB];
    if (w == 0) {
        const float ig = small[(size_t)(t0 + lane) * 128 + SM_DI + h] + gb[h];
        const float lf = log_sigmoid_(small[(size_t)(t0 + lane) * 128 + SM_DF + h] + gb[4 + h]);
        const float bc = ml_wave_incl_scan_add(lf, lane); const float bl = __shfl(bc, 63);
        const float lu = bl - bc + ig; const float a = wave_max(lu);
        uu[lane] = __expf(lu - a);
        if (lane == 0) { float* sc = (float*)(ws + WS_MLSC); const int si = (b * NCH + n) * 4 + h; sc[ML_A / 4 + si] = a; sc[ML_BL / 4 + si] = bl; }
    }
    stage_vt<256>(VT, h1 + (size_t)t0 * N_CD + H1_DV + h * 256, N_CD, tid);
    __syncthreads();
    const int d = tid & 127, tq = tid >> 7;
    { const float* cw = args.in[I_CONVW]; const int ch = 512 + h * 128 + d; float w4[4];
#pragma unroll
        for (int j = 0; j < 4; ++j) w4[j] = cw[j * 1024 + ch];
        float kc[16]; ml_conv16(h1, b, n * 64 + 16 * tq, H1_DK + h * 128 + d, w4, kc);
        float loc = 0.f; unsigned wv[8];
#pragma unroll
        for (int i = 0; i < 16; i += 2) { const float k0 = kc[i] * 0.08838834764831845f * uu[16 * tq + i], k1 = kc[i + 1] * 0.08838834764831845f * uu[16 * tq + i + 1]; loc += k0 + k1; wv[i >> 1] = pk2(k0, k1); }
        u32x4 o0, o1; o0.x = wv[0]; o0.y = wv[1]; o0.z = wv[2]; o0.w = wv[3]; o1.x = wv[4]; o1.y = wv[5]; o1.z = wv[6]; o1.w = wv[7];
        *(LAS u32x4*)(KT + d * LDK + 16 * tq) = o0; *(LAS u32x4*)(KT + d * LDK + 16 * tq + 8) = o1;
        part[tq * 128 + d] = loc; }
    __syncthreads();
    if (tid < 128) { float* nl = (float*)(ws + WS_MLN); nl[(size_t)((b * NCH + n) * 4 + h) * 128 + tid] = part[tid] + part[128 + tid] + part[256 + tid] + part[384 + tid]; }
    bf16* U = (bf16*)(ws + WS_R2) + (size_t)((b * NCH + n) * 4 + h) * 256 * 128;
    const bf16x8 a0 = lds_frag(KT, LDK, 16 * w, 0, lane), a1 = lds_frag(KT, LDK, 16 * w, 32, lane);
#pragma unroll 4
    for (int et = 0; et < 16; ++et) {
        f32x4 acc = {0.f, 0.f, 0.f, 0.f};
        acc = mfma16(a0, lds_frag(VT, LDK, 16 * et, 0, lane), acc);
        acc = mfma16(a1, lds_frag(VT, LDK, 16 * et, 32, lane), acc);
        u32x2 o; o.x = pk2(acc[0], acc[1]); o.y = pk2(acc[2], acc[3]);
        *(GAS u32x2*)(U + (size_t)(16 * et + (lane & 15)) * 128 + 16 * w + 4 * (lane >> 4)) = o;
    }
    __syncthreads();
}

__device__ __forceinline__ void ml_scan(const Args& args, Frame& F) {
    unsigned char* ws = args.ws; float* sc = (float*)(ws + WS_MLSC);
    const int NTC = BATCH * 4 * 256 * 16, NTN = BATCH * 4 * 128;
    for (int gt = 64 * (F.wave * F.G + F.bid) + F.lane; gt < NTC + NTN; gt += F.G * 512) {
        if (gt < NTC) {
            const int d8 = gt & 15, e = (gt >> 4) & 255, h = (gt >> 12) & 3, b = gt >> 14;
            bf16* S = (bf16*)args.out + (size_t)33554432;
            float st[8]; float m = 0.f;
#pragma unroll
            for (int j = 0; j < 8; ++j) st[j] = 0.f;
#pragma unroll 4
            for (int n = 0; n < NCH; ++n) { const int si = (b * NCH + n) * 4 + h;
                GAS u32x4* p = (GAS u32x4*)(S + ((size_t)si * 256 + e) * 128 + 8 * d8);
                const u32x4 u = *p; const float a = sc[ML_A / 4 + si], bl = sc[ML_BL / 4 + si];
                u32x4 o; o.x = pk2(st[0], st[1]); o.y = pk2(st[2], st[3]); o.z = pk2(st[4], st[5]); o.w = pk2(st[6], st[7]);
                *p = o;
                const float mn = fmaxf(bl + m, a); const float dec = __expf(bl + m - mn), inw = __expf(a - mn); m = mn;
                st[0] = dec * st[0] + inw * bflo(u.x); st[1] = dec * st[1] + inw * bfhi(u.x); st[2] = dec * st[2] + inw * bflo(u.y); st[3] = dec * st[3] + inw * bfhi(u.y);
                st[4] = dec * st[4] + inw * bflo(u.z); st[5] = dec * st[5] + inw * bfhi(u.z); st[6] = dec * st[6] + inw * bflo(u.w); st[7] = dec * st[7] + inw * bfhi(u.w);
            }
        } else {
            const int r = gt - NTC; const int d = r & 127, h = (r >> 7) & 3, b = r >> 9;
            float* nl = (float*)(ws + WS_MLN); float st = 0.f, m = 0.f;
            for (int n = 0; n < NCH; ++n) { const int si = (b * NCH + n) * 4 + h;
                const float u = nl[(size_t)si * 128 + d]; const float a = sc[ML_A / 4 + si], bl = sc[ML_BL / 4 + si];
                nl[(size_t)si * 128 + d] = st; if (d == 0) sc[ML_MP / 4 + si] = m;
                const float mn = fmaxf(bl + m, a); st = __expf(bl + m - mn) * st + __expf(a - mn) * u; m = mn; }
        }
    }
}

__device__ __forceinline__ void ml_c_unit(const Args& args, Frame& F, int b, int n, int h) {
    unsigned char* ws = args.ws; const bf16* h1 = (const bf16*)(ws + WS_R1); const float* small = (const float*)(ws + WS_SMALL);
    const int t0 = b * SEQ + n * 64, tid = F.tid, lane = F.lane, w = F.wave, r16 = lane & 15, g4 = lane >> 4;
    LAS bf16* Qs = (LAS bf16*)F.lds;
    LAS bf16* Ks = (LAS bf16*)(F.lds + 17408);
    LAS bf16* P = (LAS bf16*)(F.lds + 34816);
    LAS bf16* VT = (LAS bf16*)(F.lds + 44032);
    LAS bf16* NT = (LAS bf16*)(F.lds + 80896);
    LAS float* red = (LAS float*)(F.lds + 85248);
    LAS float* bcs = (LAS float*)(F.lds + 85760);
    LAS float* igs = (LAS float*)(F.lds + 86016);
    LAS float* mts = (LAS float*)(F.lds + 86272);
    LAS float* psum = (LAS float*)(F.lds + 86528);
    const float* gb = args.in[I_GATEB];
    const int si = (b * NCH + n) * 4 + h;
    const float mprev = ((const float*)(ws + WS_MLSC))[ML_MP / 4 + si];
    if (w == 0) {
        const float ig = small[(size_t)(t0 + lane) * 128 + SM_DI + h] + gb[h];
        const float lf = log_sigmoid_(small[(size_t)(t0 + lane) * 128 + SM_DF + h] + gb[4 + h]);
        const float bc = ml_wave_incl_scan_add(lf, lane);
        const float gmb = ig - bc;
        const float pm = ml_wave_incl_scan_max(gmb, lane);
        bcs[lane] = bc; igs[lane] = gmb; mts[lane] = bc + fmaxf(pm, mprev);
    }
    if (w == 1) { const float* nl = (const float*)(ws + WS_MLN);
        for (int i = lane; i < 16 * LDQ; i += 64) { const int rr = i / LDQ, cc = i % LDQ; NT[i] = (bf16)((rr == 0 && cc < 128) ? f2bf(nl[(size_t)si * 128 + cc]) : 0u); } }
    stage_vt<256>(VT, h1 + (size_t)t0 * N_CD + H1_DV + h * 256, N_CD, tid);
    { const int d = tid & 127, tq = tid >> 7; const float* cw = args.in[I_CONVW]; float w4[4]; float qc[16];
#pragma unroll
        for (int j = 0; j < 4; ++j) w4[j] = cw[j * 1024 + h * 128 + d];
        ml_conv16(h1, b, n * 64 + 16 * tq, H1_DQ + h * 128 + d, w4, qc);
#pragma unroll
        for (int i = 0; i < 16; ++i) Qs[(16 * tq + i) * LDQ + d] = (bf16)f2bf(qc[i]);
#pragma unroll
        for (int j = 0; j < 4; ++j) w4[j] = cw[j * 1024 + 512 + h * 128 + d];
        ml_conv16(h1, b, n * 64 + 16 * tq, H1_DK + h * 128 + d, w4, qc);
#pragma unroll
        for (int i = 0; i < 16; ++i) Ks[(16 * tq + i) * LDQ + d] = (bf16)f2bf(qc[i] * 0.08838834764831845f); }
    __syncthreads();
    { const int mi = w >> 1; float rs[4] = {0.f, 0.f, 0.f, 0.f};
#pragma unroll
        for (int q = 0; q < 2; ++q) { const int ni = 2 * (w & 1) + q; f32x4 acc = {0.f, 0.f, 0.f, 0.f};
            if (ni <= mi) {
#pragma unroll
                for (int ks = 0; ks < 4; ++ks) acc = mfma16(lds_frag(Qs, LDQ, 16 * mi, 32 * ks, lane), lds_frag(Ks, LDQ, 16 * ni, 32 * ks, lane), acc); }
            const int s = 16 * ni + r16; const float gs = igs[s];
#pragma unroll
            for (int j = 0; j < 4; ++j) { const int t = 16 * mi + 4 * g4 + j; float v = 0.f;
                if (ni <= mi && s <= t) v = acc[j] * __expf(bcs[t] + gs - mts[t]);
                const unsigned vb = f2bf(v); P[t * LDK + s] = (bf16)vb; rs[j] += v; } }
#pragma unroll
        for (int j = 0; j < 4; ++j) { float s = rs[j]; s += __shfl_xor(s, 1); s += __shfl_xor(s, 2); s += __shfl_xor(s, 4); s += __shfl_xor(s, 8); if (r16 == 0) psum[(w & 1) * 64 + 16 * mi + 4 * g4 + j] = s; } }
    __syncthreads();
    const int mi = w & 3, e0 = (w >> 2) * 128;
    const bf16* C = (const bf16*)(ws + WS_R2) + (size_t)si * 256 * 128;
    f32x4 acc1[8], acc2[8]; f32x4 accn = {0.f, 0.f, 0.f, 0.f};
    { const bf16x8 p0 = lds_frag(P, LDK, 16 * mi, 0, lane), p1 = lds_frag(P, LDK, 16 * mi, 32, lane);
        bf16x8 qf[4];
#pragma unroll
        for (int ks = 0; ks < 4; ++ks) qf[ks] = lds_frag(Qs, LDQ, 16 * mi, 32 * ks, lane);
#pragma unroll
        for (int ks = 0; ks < 4; ++ks) accn = mfma16(qf[ks], lds_frag(NT, LDQ, 0, 32 * ks, lane), accn);
#pragma unroll
        for (int i = 0; i < 8; ++i) { const int et0 = e0 + 16 * i; f32x4 a = {0.f, 0.f, 0.f, 0.f}, c = {0.f, 0.f, 0.f, 0.f};
            a = mfma16(p0, lds_frag(VT, LDK, et0, 0, lane), a); a = mfma16(p1, lds_frag(VT, LDK, et0, 32, lane), a);
            if (n > 0) {
#pragma unroll
                for (int ks = 0; ks < 4; ++ks) { const bf16x8 sf = *(const GAS bf16x8*)(C + (size_t)(et0 + r16) * 128 + 32 * ks + 8 * g4); c = mfma16(qf[ks], sf, c); } }
            acc1[i] = a; acc2[i] = c; } }
    float hv[8][4]; float ss[4];
#pragma unroll
    for (int j = 0; j < 4; ++j) { const int t = 16 * mi + 4 * g4 + j;
        const float mt = mts[t]; const float wi = __expf(bcs[t] + mprev - mt);
        const float qn_inter = __shfl(accn[j], 16 * g4);
        const float qn = psum[t] + psum[64 + t] + wi * qn_inter;
        const float den = fmaxf(fabsf(qn), __expf(-mt)); const float inv = 1.0f / den; float s = 0.f;
#pragma unroll
        for (int i = 0; i < 8; ++i) { const float v = (acc1[i][j] + wi * acc2[i][j]) * inv; hv[i][j] = v; s += v * v; }
        s += __shfl_xor(s, 1); s += __shfl_xor(s, 2); s += __shfl_xor(s, 4); s += __shfl_xor(s, 8); ss[j] = s; }
    if (r16 == 0) {
#pragma unroll
        for (int j = 0; j < 4; ++j) red[w * 16 + 4 * g4 + j] = ss[j]; }
    __syncthreads();
    const float* gn = args.in[I_DNORM]; bf16* mixed = (bf16*)(ws + WS_MIX);
#pragma unroll
    for (int j = 0; j < 4; ++j) { const float tot = red[w * 16 + 4 * g4 + j] + red[(w ^ 4) * 16 + 4 * g4 + j]; const float rstd = 1.0f / sqrtf(tot * (1.0f / 256.f) + EPS);
        const size_t row = (size_t)(t0 + 16 * mi + 4 * g4 + j);
#pragma unroll
        for (int i = 0; i < 8; ++i) { const int e = e0 + 16 * i + r16; const float gate = bf2f(h1[row * N_CD + H1_DOG + h * 256 + e]);
            mixed[row * D + 1024 + h * 256 + e] = (bf16)f2bf(hv[i][j] * rstd * gn[e] * gate); } }
    __syncthreads();
}
__device__ __forceinline__ void ml_phase_a(const Args& args, Frame& F) { for (int u = F.bid; u < 1024; u += F.G) { const int h = u & 3, n = (u >> 2) & 63, b = u >> 8; ml_a_unit(args, F, b, n, h); } }
__device__ __forceinline__ void ml_phase_c(const Args& args, Frame& F) { for (int u = F.bid; u < 1024; u += F.G) { const int h = u & 3, n = (u >> 2) & 63, b = u >> 8; ml_c_unit(args, F, b, n, h); } }
__device__ __forceinline__ void ml_load_raw(const Args& args, int u, int tid, bool need_q, u32x4 (&R)[6]) {
    const int h = u & 3, n = (u >> 2) & 63, b = u >> 8;
    const bf16* h1 = (const bf16*)(args.ws + WS_R1); const size_t t0 = (size_t)(b * SEQ + n * 64);
#pragma unroll
    for (int i = 0; i < 2; ++i) { const int cid = tid + 512 * i, row = cid >> 4, ch = cid & 15; const bf16* hrow = h1 + (t0 + row) * N_CD + h * 128 + ch * 8;
        if (need_q) R[i] = *(const GAS u32x4*)(hrow + H1_DQ); R[2 + i] = *(const GAS u32x4*)(hrow + H1_DK); }
    R[4] = (u32x4){0u, 0u, 0u, 0u}; R[5] = (u32x4){0u, 0u, 0u, 0u};
    if (tid < 48 && n > 0) { const int row = tid >> 4, ch = tid & 15; const bf16* hrow = h1 + (t0 - 3 + row) * N_CD + h * 128 + ch * 8;
        if (need_q) R[4] = *(const GAS u32x4*)(hrow + H1_DQ); R[5] = *(const GAS u32x4*)(hrow + H1_DK); }
}
__device__ __forceinline__ void ml_store_raw(LAS unsigned char* Q, LAS unsigned char* K, LAS unsigned char* HQ, LAS unsigned char* HK, int tid, bool need_q, const u32x4 (&R)[6]) {
#pragma unroll
    for (int i = 0; i < 2; ++i) { const int cid = tid + 512 * i, row = cid >> 4, ch = cid & 15; const int off = row * 256 + (((ch ^ row) & 15) << 4);
        if (need_q) *(LAS u32x4*)(Q + off) = R[i]; *(LAS u32x4*)(K + off) = R[2 + i]; }
    if (tid < 48) { if (need_q) *(LAS u32x4*)(HQ + tid * 16) = R[4]; *(LAS u32x4*)(HK + tid * 16) = R[5]; }
}
__device__ __forceinline__ void ml_conv16_lds(const LAS unsigned char* X, const LAS unsigned char* HX, int tq, int d, const float (&w4)[4], float (&out)[16]) {
    float x[19];
#pragma unroll
    for (int i = 0; i < 19; ++i) { const int r = 16 * tq - 3 + i; x[i] = (r >= 0) ? bf2f(*(const LAS bf16*)(X + swz128(r, d))) : bf2f(*(const LAS bf16*)(HX + ((r + 3) * 128 + d) * 2)); }
#pragma unroll
    for (int i = 0; i < 16; ++i) { const float c = w4[0] * x[i] + w4[1] * x[i + 1] + w4[2] * x[i + 2] + w4[3] * x[i + 3]; out[i] = siluf_(c); }
}
constexpr int M2_Q = 0, M2_K = 16384, M2_P = 32768, M2_V0 = 41984, M2_V1 = 58368, M2_S0 = 74752, M2_S1 = 107520, M2_NT = 140288, M2_HQ = 140544, M2_HK = 141312,
              M2_BCS = 142080, M2_IGS = 142336, M2_MTS = 142592, M2_RED = 142848, M2_PSUM = 143360;
static_assert(M2_NT + 4096 <= LDS_BYTES - 1024 && M2_PSUM + 512 <= LDS_BYTES - 1024, "mlstm (c) LDS map");

__device__ __forceinline__ void ml_c_unit2(const Args& args, Frame& F, int b, int n, int h) {
    unsigned char* ws = args.ws; const bf16* h1 = (const bf16*)(ws + WS_R1); const float* small = (const float*)(ws + WS_SMALL);
    const int t0 = b * SEQ + n * 64, tid = F.tid, lane = F.lane, w = F.wave, r16 = lane & 15, g4 = lane >> 4;
    LAS unsigned char* Q = F.lds + M2_Q; LAS unsigned char* K = F.lds + M2_K; LAS bf16* P = (LAS bf16*)(F.lds + M2_P);
    LAS unsigned char* V0 = F.lds + M2_V0; LAS unsigned char* V1 = F.lds + M2_V1; LAS unsigned char* S0 = F.lds + M2_S0; LAS unsigned char* S1 = F.lds + M2_S1;
    LAS unsigned char* NT = F.lds + M2_NT; LAS unsigned char* HQ = F.lds + M2_HQ; LAS unsigned char* HK = F.lds + M2_HK;
    LAS float* bcs = (LAS float*)(F.lds + M2_BCS); LAS float* igs = (LAS float*)(F.lds + M2_IGS); LAS float* mts = (LAS float*)(F.lds + M2_MTS);
    LAS float* red = (LAS float*)(F.lds + M2_RED); LAS float* psum = (LAS float*)(F.lds + M2_PSUM);
    const float* gb = args.in[I_GATEB];
    const int si = (b * NCH + n) * 4 + h;
    const float mprev = ((const float*)(ws + WS_MLSC))[ML_MP / 4 + si];
    const bf16* Cg = (const bf16*)args.out + (size_t)33554432 + (size_t)si * 256 * 128;
    const bf16* Vg = h1 + (size_t)t0 * N_CD + H1_DV + h * 256;
    dma_tile128(V0, Vg, N_CD, 64, w, lane); dma_tile128(V1, Vg + 128, N_CD, 64, w, lane);
    if (n > 0) { dma_tile128(S0, Cg, 128, 128, w, lane); dma_tile128(S1, Cg + 128 * 128, 128, 128, w, lane); }
    if (w == 0) {
        const float ig = small[(size_t)(t0 + lane) * 128 + SM_DI + h] + gb[h];
        const float lf = log_sigmoid_(small[(size_t)(t0 + lane) * 128 + SM_DF + h] + gb[4 + h]);
        const float bc = ml_wave_incl_scan_add(lf, lane);
        const float gmb = ig - bc;
        const float pm = ml_wave_incl_scan_max(gmb, lane);
        bcs[lane] = bc; igs[lane] = gmb; mts[lane] = bc + fmaxf(pm, mprev);
    }
    if (w == 1) { const float* nl = (const float*)(ws + WS_MLN); const f32x2 nv = *(const f32x2*)(nl + (size_t)si * 128 + 2 * lane); *(LAS unsigned*)(NT + 4 * lane) = pk2(nv.x, nv.y); }
    { const int d = tid & 127, tq = tid >> 7; const float* cw = args.in[I_CONVW]; float w4[4]; float qc[16], kc[16];
#pragma unroll
        for (int j = 0; j < 4; ++j) w4[j] = cw[j * 1024 + h * 128 + d];
        ml_conv16_lds(Q, HQ, tq, d, w4, qc);
#pragma unroll
        for (int j = 0; j < 4; ++j) w4[j] = cw[j * 1024 + 512 + h * 128 + d];
        ml_conv16_lds(K, HK, tq, d, w4, kc);
        BAR_LDS();
#pragma unroll
        for (int i = 0; i < 16; ++i) { const int off = swz128(16 * tq + i, d); *(LAS bf16*)(Q + off) = (bf16)f2bf(qc[i]); *(LAS bf16*)(K + off) = (bf16)f2bf(kc[i] * 0.08838834764831845f); } }
    BAR_LDS();
    { const int mi = w >> 1; float rs = 0.f; const int t = 16 * mi + r16; const float bt = bcs[t] - mts[t];
#pragma unroll
        for (int q2 = 0; q2 < 2; ++q2) { const int ni = 2 * (w & 1) + q2; f32x4 acc = {0.f, 0.f, 0.f, 0.f};
            if (ni <= mi) {
#pragma unroll
                for (int ks = 0; ks < 4; ++ks) acc = mfma16(frag128(K, 16 * ni, 32 * ks, lane), frag128(Q, 16 * mi, 32 * ks, lane), acc); }
            const int s0 = 16 * ni + 4 * g4; float pv[4];
#pragma unroll
            for (int j = 0; j < 4; ++j) { float v = 0.f; if (ni <= mi && s0 + j <= t) v = acc[j] * __expf(bt + igs[s0 + j]); pv[j] = v; rs += v; }
            u32x2 o; o.x = pk2(pv[0], pv[1]); o.y = pk2(pv[2], pv[3]);
            *(LAS u32x2*)(P + t * LDK + s0) = o; }
        rs += __shfl_xor(rs, 16); rs += __shfl_xor(rs, 32);
        if (g4 == 0) psum[(w & 1) * 64 + t] = rs; }
    BAR_ALL();
    const int mi = w & 3, eh = w >> 2; const int t = 16 * mi + r16;
    f32x4 acc1[2][4], acc2[2][4]; f32x4 accn = {0.f, 0.f, 0.f, 0.f};
    { const bf16x8 p0 = lds_frag(P, LDK, 16 * mi, 0, lane), p1 = lds_frag(P, LDK, 16 * mi, 32, lane);
        bf16x8 qf[4];
#pragma unroll
        for (int ks = 0; ks < 4; ++ks) qf[ks] = frag128(Q, 16 * mi, 32 * ks, lane);
#pragma unroll
        for (int ks = 0; ks < 4; ++ks) accn = mfma16(frag128(NT, 0, 32 * ks, lane), qf[ks], accn);
#pragma unroll
        for (int hf = 0; hf < 2; ++hf) { const LAS unsigned char* Vt = hf ? V1 : V0; const LAS unsigned char* St = hf ? S1 : S0;
#pragma unroll
            for (int i = 0; i < 4; ++i) { const int e0 = 64 * eh + 16 * i; f32x4 a = {0.f, 0.f, 0.f, 0.f}, c = {0.f, 0.f, 0.f, 0.f};
                a = mfma16(tfrag128(Vt, 0, e0, lane), p0, a); a = mfma16(tfrag128(Vt, 32, e0, lane), p1, a);
                if (n > 0) {
#pragma unroll
                    for (int ks = 0; ks < 4; ++ks) c = mfma16(frag128(St, e0, 32 * ks, lane), qf[ks], c); }
                acc1[hf][i] = a; acc2[hf][i] = c; } } }
    const float mt = mts[t]; const float wi = __expf(bcs[t] + mprev - mt);
    const float qn_inter = __shfl(accn[0], r16);
    const float qn = psum[t] + psum[64 + t] + wi * qn_inter;
    const float inv = 1.0f / fmaxf(fabsf(qn), __expf(-mt));
    float ss = 0.f;
#pragma unroll
    for (int hf = 0; hf < 2; ++hf)
#pragma unroll
        for (int i = 0; i < 4; ++i)
#pragma unroll
            for (int j = 0; j < 4; ++j) { const float v = (acc1[hf][i][j] + wi * acc2[hf][i][j]) * inv; acc1[hf][i][j] = v; ss += v * v; }
    ss += __shfl_xor(ss, 16); ss += __shfl_xor(ss, 32);
    if (g4 == 0) red[eh * 64 + t] = ss;
    BAR_LDS();
    const float tot = red[t] + red[64 + t]; const float rstd = 1.0f / sqrtf(tot * (1.0f / 256.f) + EPS);
    const float* gn = args.in[I_DNORM]; bf16* mixed = (bf16*)(ws + WS_MIX);
    const size_t row = (size_t)(t0 + t);
#pragma unroll
    for (int hf = 0; hf < 2; ++hf)
#pragma unroll
        for (int i = 0; i < 4; ++i) { const int e = 128 * hf + 64 * eh + 16 * i + 4 * g4;
            const u32x2 gw = *(const GAS u32x2*)(h1 + row * N_CD + H1_DOG + h * 256 + e); const f32x4 gg = *(const f32x4*)(gn + e);
            u32x2 o; o.x = pk2(acc1[hf][i][0] * rstd * gg.x * bflo(gw.x), acc1[hf][i][1] * rstd * gg.y * bfhi(gw.x)); o.y = pk2(acc1[hf][i][2] * rstd * gg.z * bflo(gw.y), acc1[hf][i][3] * rstd * gg.w * bfhi(gw.y));
            *(GAS u32x2*)(mixed + row * D + 1024 + h * 256 + e) = o; }
}
__device__ __forceinline__ void ml_phase_c2(const Args& args, Frame& F) {
    u32x4 R[6];
    int u = F.bid;
    if (u < 1024) ml_load_raw(args, u, F.tid, true, R);
    for (; u < 1024; u += F.G) {
        const int h = u & 3, n = (u >> 2) & 63, b = u >> 8;
        BAR_ALL();
        ml_store_raw(F.lds + M2_Q, F.lds + M2_K, F.lds + M2_HQ, F.lds + M2_HK, F.tid, true, R);
        if (u + F.G < 1024) ml_load_raw(args, u + F.G, F.tid, true, R);
        BAR_LDS();
        ml_c_unit2(args, F, b, n, h);
    }
    BAR_ALL();
}

constexpr int MA_K = 0, MA_KT = 16384, MA_V0 = 34816, MA_V1 = 51200, MA_HK = 67584, MA_PART = 68352, MA_UU = 70400;
__device__ __forceinline__ void ml_a_unit2(const Args& args, Frame& F, int b, int n, int h) {
    unsigned char* ws = args.ws; const bf16* h1 = (const bf16*)(ws + WS_R1); const float* small = (const float*)(ws + WS_SMALL);
    const int t0 = b * SEQ + n * 64, tid = F.tid, lane = F.lane, w = F.wave;
    LAS unsigned char* K = F.lds + MA_K; LAS bf16* KT = (LAS bf16*)(F.lds + MA_KT); LAS unsigned char* V0 = F.lds + MA_V0; LAS unsigned char* V1 = F.lds + MA_V1;
    LAS unsigned char* HK = F.lds + MA_HK; LAS float* part = (LAS float*)(F.lds + MA_PART); LAS float* uu = (LAS float*)(F.lds + MA_UU);
    const float* gb = args.in[I_GATEB];
    const bf16* Vg = h1 + (size_t)t0 * N_CD + H1_DV + h * 256;
    dma_tile128(V0, Vg, N_CD, 64, w, lane); dma_tile128(V1, Vg + 128, N_CD, 64, w, lane);
    if (w == 0) {
        const float ig = small[(size_t)(t0 + lane) * 128 + SM_DI + h] + gb[h];
        const float lf = log_sigmoid_(small[(size_t)(t0 + lane) * 128 + SM_DF + h] + gb[4 + h]);
        const float bc = ml_wave_incl_scan_add(lf, lane); const float bl = __shfl(bc, 63);
        const float lu = bl - bc + ig; const float a = wave_max(lu);
        uu[lane] = __expf(lu - a);
        if (lane == 0) { float* sc = (float*)(ws + WS_MLSC); const int si = (b * NCH + n) * 4 + h; sc[ML_A / 4 + si] = a; sc[ML_BL / 4 + si] = bl; }
    }
    const int d = tid & 127, tq = tid >> 7;
    float kc[16];
    { const float* cw = args.in[I_CONVW]; float w4[4];
#pragma unroll
        for (int j = 0; j < 4; ++j) w4[j] = cw[j * 1024 + 512 + h * 128 + d];
        ml_conv16_lds(K, HK, tq, d, w4, kc); }
    BAR_LDS();
    { float loc = 0.f; unsigned wv[8];
#pragma unroll
        for (int i = 0; i < 16; i += 2) { const float k0 = kc[i] * 0.08838834764831845f * uu[16 * tq + i], k1 = kc[i + 1] * 0.08838834764831845f * uu[16 * tq + i + 1]; loc += k0 + k1; wv[i >> 1] = pk2(k0, k1); }
        u32x4 o0, o1; o0.x = wv[0]; o0.y = wv[1]; o0.z = wv[2]; o0.w = wv[3]; o1.x = wv[4]; o1.y = wv[5]; o1.z = wv[6]; o1.w = wv[7];
        *(LAS u32x4*)(KT + d * LDK + 16 * tq) = o0; *(LAS u32x4*)(KT + d * LDK + 16 * tq + 8) = o1;
        part[tq * 128 + d] = loc; }
    BAR_ALL();
    if (tid < 128) { float* nl = (float*)(ws + WS_MLN); nl[(size_t)((b * NCH + n) * 4 + h) * 128 + tid] = part[tid] + part[128 + tid] + part[256 + tid] + part[384 + tid]; }
    bf16* U = (bf16*)args.out + (size_t)33554432 + (size_t)((b * NCH + n) * 4 + h) * 256 * 128;
    const bf16x8 a0 = lds_frag(KT, LDK, 16 * w, 0, lane), a1 = lds_frag(KT, LDK, 16 * w, 32, lane);
#pragma unroll 4
    for (int et = 0; et < 16; ++et) { const LAS unsigned char* Vt = (et < 8) ? V0 : V1; const int c0 = (et & 7) * 16;
        f32x4 acc = {0.f, 0.f, 0.f, 0.f};
        acc = mfma16(a0, tfrag128(Vt, 0, c0, lane), acc);
        acc = mfma16(a1, tfrag128(Vt, 32, c0, lane), acc);
        u32x2 o; o.x = pk2(acc[0], acc[1]); o.y = pk2(acc[2], acc[3]);
        *(GAS u32x2*)(U + (size_t)(16 * et + (lane & 15)) * 128 + 16 * w + 4 * (lane >> 4)) = o; }
}
__device__ __forceinline__ void ml_phase_a2(const Args& args, Frame& F) {
    u32x4 R[6];
    int u = F.bid;
    if (u < 1024) ml_load_raw(args, u, F.tid, false, R);
    for (; u < 1024; u += F.G) {
        const int h = u & 3, n = (u >> 2) & 63, b = u >> 8;
        BAR_ALL();
        ml_store_raw(F.lds + MA_K, F.lds + MA_K, F.lds + MA_HK, F.lds + MA_HK, F.tid, false, R);
        if (u + F.G < 1024) ml_load_raw(args, u + F.G, F.tid, false, R);
        BAR_LDS();
        ml_a_unit2(args, F, b, n, h);
    }
    BAR_ALL();
}
constexpr int N_PHASES = 20;
constexpr int LDS_TAB_OFF = LDS_BYTES - 1024, LDS_BARW_OFF = LDS_BYTES - 512;

__device__ __forceinline__ void moe_table(Frame& F, int layer) {
    volatile LAS int* tab = (volatile LAS int*)(F.lds + LDS_TAB_OFF);
    __syncthreads();
    if (F.tid == 0) { int acc = 0;
        for (int e = 0; e < 16; ++e) { const int c = (int)__hip_atomic_load((unsigned*)(F.ctl + CW_CNT) + (layer * 16 + e) * 64, RLX_AGENT); tab[e] = acc; tab[32 + e] = c; acc += (c + 255) >> 8; }
        tab[16] = acc; }
    __syncthreads();
}

__global__ void __launch_bounds__(512, 2) hybrid_fwd(Args args) {
    extern __shared__ __attribute__((aligned(16))) unsigned char lds_raw[];
    Frame F;
    F.lds = (LAS unsigned char*)lds_raw;
    F.tid = threadIdx.x; F.lane = F.tid & 63; F.wave = __builtin_amdgcn_readfirstlane(F.tid >> 6);
    F.G = gridDim.x; F.bid = blockIdx.x;
    unsigned char* ws = args.ws;
    F.ctl = (gu32*)(ws + WS_CTL);
    if (F.tid < 256) ((LAS unsigned*)(F.lds + LDS_TAB_OFF))[F.tid] = 0u;
    __syncthreads();
    XcdBarrier bar; bar.bar = (unsigned*)(F.ctl + CW_BAR); bar.x = 0; bar.st = nullptr;
    if (args.use_bar) bar = xcd_barrier_post((unsigned*)(F.ctl + CW_BAR), (volatile LAS unsigned*)(F.lds + LDS_BARW_OFF));
    const int lo = args.ph_lo, hi = args.ph_hi;
#ifndef PH_MASK
#define PH_MASK 0xffffffu
#endif
#define IN(k) (((PH_MASK >> (k)) & 1u) && lo <= (k) && (k) < hi)
#define SEAM(k) do { if (IN(k) && IN((k) + 1)) xcd_barrier(bar); } while (0)
#ifndef DIAG_OC_MODE
#define DIAG_OC_MODE 0
#endif
#ifndef DIAG_OC_SCALE
#define DIAG_OC_SCALE 0.f
#endif
#ifndef PROBE_SKIP
#define PROBE_SKIP 0
#endif
#ifndef PROBE_DUP
#define PROBE_DUP -1
#endif
#define REP(k) for (int _r = 0; _r < ((PROBE_DUP == (k)) ? 2 : 1); ++_r)
#define REPBAR(k) do { if (PROBE_DUP == (k) && _r == 0) xcd_barrier(bar); } while (0)
    const volatile LAS int* tab = (const volatile LAS int*)(F.lds + LDS_TAB_OFF);

    if (IN(0)) REP(0) { p0_prologue(args, F); REPBAR(0); } SEAM(0);
    if (IN(1)) REP(1) { pg8::StaticOrder S; S.init((const bf16*)(ws + WS_XB), D, (const bf16*)(ws + WS_WINAB), D, T, N_AB, F.G, F.bid);
        pg8::EpiAB E{(bf16*)(ws + WS_R1), (const float*)(ws + WS_LB)};
        pg8::gemm_phase<pg8::EpiAB, pg8::StaticOrder, false>(F.lds, D, S, E); REPBAR(1); } SEAM(1);
    if (IN(2)) REP(2) { ab_phase_a2(args, F); REPBAR(2); } SEAM(2);
    if (IN(3)) REP(3) { ab_scan(args, F); REPBAR(3); } SEAM(3);
    if (IN(4)) REP(4) { ab_phase_c2(args, F); REPBAR(4); } SEAM(4);
    if (IN(5)) REP(5) { pg8::StaticOrder S; S.init((const bf16*)(ws + WS_MIX), D, (const bf16*)(ws + WS_WOUTAB), D, T, D, F.G, F.bid);
        pg8::EpiResid<true> E{(bf16*)(ws + WS_TMP), (const void*)args.in[I_X], (float*)(ws + WS_STATS)};
        pg8::gemm_phase<pg8::EpiResid<true>, pg8::StaticOrder, false>(F.lds, D, S, E); REPBAR(5); } SEAM(5);
    if (IN(6)) REP(6) { ln_phase<0, true, false>(args, F, 0, args.in[I_X]); REPBAR(6); } SEAM(6);
    if (IN(7)) REP(7) { moe_table(F, 0);
        pg8::MoeOrder S{(const char*)(ws + WS_XB), (const char*)(ws + WS_W13), D, D, 4, F.G, F.bid, 1024, tab, (const int*)(ws + WS_LIST), true};
        pg8::EpiMoe1 E{(bf16*)(ws + WS_MIX), (const float*)(ws + WS_WL), tab};
        pg8::gemm_phase<pg8::EpiMoe1, pg8::MoeOrder, true>(F.lds, D, S, E); REPBAR(7); } SEAM(7);
    if (IN(8)) REP(8) { moe_table(F, 0);
        pg8::MoeOrder S{(const char*)(ws + WS_MIX), (const char*)(ws + WS_W2T), DEXP, DEXP, 8, F.G, F.bid, 2048, tab, (const int*)(ws + WS_LIST), false};
        pg8::EpiMoe2 E{(bf16*)(ws + WS_R2), (const int*)(ws + WS_LIST), tab};
        pg8::gemm_phase<pg8::EpiMoe2, pg8::MoeOrder, false>(F.lds, DEXP, S, E); REPBAR(8); } SEAM(8);
    if (IN(9)) REP(9) { ln_phase<1, false, false>(args, F, 0, nullptr); REPBAR(9); } SEAM(9);
    if (IN(10)) REP(10) { pg8::StaticOrder S; S.init((const bf16*)(ws + WS_XB), D, (const bf16*)(ws + WS_WINCD), D, T, N_CD, F.G, F.bid);
        pg8::EpiCD E{(bf16*)(ws + WS_R1), (float*)(ws + WS_SMALL)};
        pg8::gemm_phase<pg8::EpiCD, pg8::StaticOrder, false>(F.lds, D, S, E); REPBAR(10); } SEAM(10);
    if (IN(11)) REP(11) {
        { pg8::HeadOrder S{(const char*)(ws + WS_R1), (const char*)(ws + WS_WUK), N_CD, 256, 128, F.G, F.bid};
          pg8::EpiHead E{(bf16*)args.out, D, 256, 2, 0, 0.f};
          pg8::gemm_phase<pg8::EpiHead, pg8::HeadOrder, false>(F.lds, 256 + args.pad, S, E); }
        if (!(PROBE_SKIP & 1)) dsa_indexer(args, F);
        ml_phase_a2(args, F); REPBAR(11); } SEAM(11);
    if (IN(12)) REP(12) { dsa_prep_rows(args, F); if (!(PROBE_SKIP & 2)) dsa_topk(args, F); ml_scan(args, F); REPBAR(12); } SEAM(12);
    if (IN(13)) REP(13) { if (!(PROBE_SKIP & 4)) dsa_attention(args, F, _r == 0 ? (bf16*)args.out : (bf16*)(ws + WS_MIX)); ml_phase_c2(args, F); REPBAR(13); } SEAM(13);
    if (IN(14)) REP(14) { pg8::HeadOrder S{(const char*)args.out, (const char*)(ws + WS_WUV), D, 256, 256, F.G, F.bid};
        pg8::EpiHead E{(bf16*)(ws + WS_MIX), D, 128, 1, DIAG_OC_MODE, DIAG_OC_SCALE};
        pg8::gemm_phase<pg8::EpiHead, pg8::HeadOrder, false>(F.lds, 256 + args.pad, S, E); REPBAR(14); } SEAM(14);
    if (IN(15)) REP(15) { pg8::StaticOrder S; S.init((const bf16*)(ws + WS_MIX), D, (const bf16*)(ws + WS_WOUTCD), D, T, D, F.G, F.bid);
        pg8::EpiResid<false> E{(bf16*)(ws + WS_TMP), (const void*)(ws + WS_XB), (float*)(ws + WS_STATS)};
        pg8::gemm_phase<pg8::EpiResid<false>, pg8::StaticOrder, false>(F.lds, D, S, E); REPBAR(15); } SEAM(15);
    if (IN(16)) REP(16) { ln_phase<0, false, false>(args, F, 1, nullptr); REPBAR(16); } SEAM(16);
    if (IN(17)) REP(17) { moe_table(F, 1);
        pg8::MoeOrder S{(const char*)(ws + WS_XB), (const char*)(ws + WS_W13), D, D, 4, F.G, F.bid, 1024, tab, (const int*)(ws + WS_LIST), true};
        pg8::EpiMoe1 E{(bf16*)(ws + WS_MIX), (const float*)(ws + WS_WL), tab};
        pg8::gemm_phase<pg8::EpiMoe1, pg8::MoeOrder, true>(F.lds, D, S, E); REPBAR(17); } SEAM(17);
    if (IN(18)) REP(18) { moe_table(F, 1);
        pg8::MoeOrder S{(const char*)(ws + WS_MIX), (const char*)(ws + WS_W2T), DEXP, DEXP, 8, F.G, F.bid, 2048, tab, (const int*)(ws + WS_LIST), false};
        pg8::EpiMoe2 E{(bf16*)(ws + WS_R2), (const int*)(ws + WS_LIST), tab};
        pg8::gemm_phase<pg8::EpiMoe2, pg8::MoeOrder, false>(F.lds, DEXP, S, E); REPBAR(18); } SEAM(18);
    if (IN(19)) { ln_phase<1, false, true>(args, F, 1, nullptr); }
#undef IN
#undef SEAM
}

#ifndef MK_ONE_LAUNCH
#define MK_ONE_LAUNCH 1
#endif
extern "C" void kernel_launch(void* const* d_in, const int* in_sizes, int n_in, void* d_out, int out_size, void* d_ws, size_t ws_size, hipStream_t stream) {
    static int grid = 0;
    if (grid == 0) {
        if (n_in != 24 || in_sizes[0] != T * D || out_size != T * D || ws_size < WS_END) { fprintf(stderr, "kernel_launch: unexpected shapes (n_in %d, in0 %d, out %d, ws %zu < %zu); nothing launched\n", n_in, n_in > 0 ? in_sizes[0] : -1, out_size, ws_size, (size_t)WS_END); grid = -1; return; }
        int dev = 0, cus = 0, per_cu = 0;
        if (hipGetDevice(&dev) != hipSuccess || hipDeviceGetAttribute(&cus, hipDeviceAttributeMultiprocessorCount, dev) != hipSuccess) { grid = -1; return; }
        if (hipFuncSetAttribute((const void*)hybrid_fwd, hipFuncAttributeMaxDynamicSharedMemorySize, LDS_BYTES) != hipSuccess) { fprintf(stderr, "kernel_launch: hipFuncSetAttribute failed\n"); grid = -1; return; }
        if (hipOccupancyMaxActiveBlocksPerMultiprocessor(&per_cu, (const void*)hybrid_fwd, 512, LDS_BYTES) != hipSuccess || per_cu < 1) fprintf(stderr, "kernel_launch: occupancy query reports %d\n", per_cu);
        (void)hipGetLastError();
        grid = cus;
    }
    if (grid < 0) return;
    if (hipMemsetAsync((char*)d_ws + WS_CTL, 0, CTL_ZERO_BYTES, stream) != hipSuccess) return;
    Args a{};
    for (int i = 0; i < 24; ++i) a.in[i] = (const float*)d_in[i];
    a.out = (float*)d_out; a.ws = (unsigned char*)d_ws; a.pad = 0;
#if MK_ONE_LAUNCH
    a.ph_lo = 0; a.ph_hi = N_PHASES; a.use_bar = 1;
    hipLaunchKernelGGL(hybrid_fwd, dim3(grid), dim3(512), LDS_BYTES, stream, a);
#else
    a.use_bar = 0;
    for (int p = 0; p < N_PHASES; ++p) { a.ph_lo = p; a.ph_hi = p + 1; hipLaunchKernelGGL(hybrid_fwd, dim3(grid), dim3(512), LDS_BYTES, stream, a); }
#endif
}
```

```cpp
#include <hip/hip_runtime.h>
#include <cstdio>
#include <cstdint>

#define LAS __attribute__((address_space(3)))
#define GAS __attribute__((address_space(1)))
typedef unsigned short bf16;
typedef short bf16x8 __attribute__((ext_vector_type(8)));
typedef short s16x4 __attribute__((ext_vector_type(4)));
typedef float f32x4 __attribute__((ext_vector_type(4)));
typedef float f32x2 __attribute__((ext_vector_type(2)));
typedef unsigned u32x4 __attribute__((ext_vector_type(4)));
typedef unsigned u32x2 __attribute__((ext_vector_type(2)));
typedef GAS unsigned gu32;

constexpr int BATCH = 4, SEQ = 4096, T = BATCH * SEQ, D = 2048, NCH = SEQ / 64;
constexpr int N_AB = 7168, PSRC_AB = 7184;
constexpr int N_CD = 5632, PSRC_CD = 5464;
constexpr int NE = 16, DEXP = 512;
constexpr float DN_ALPHA = 1.4142135623730951f;
constexpr float EPS = 1e-5f;

constexpr size_t MiB = 1u << 20;
constexpr size_t WS_CTL = 0, CTL_ZERO_BYTES = 128 * 1024;
constexpr size_t WS_LB = 1 * MiB;
constexpr size_t WS_MLSC = 1 * MiB + 65536;
constexpr size_t WS_GA = 2 * MiB;
constexpr size_t WS_GB = 3 * MiB;
constexpr size_t WS_MLN = 4 * MiB;
constexpr size_t WS_LIST = 5 * MiB;
constexpr size_t WS_WL = 6 * MiB;
constexpr size_t WS_SMALL = 8 * MiB;
constexpr size_t WS_LAB = 16 * MiB;
constexpr size_t WS_IDX = 32 * MiB;
constexpr size_t WS_CKVN = 40 * MiB;
constexpr size_t WS_W = 48 * MiB;
constexpr size_t WS_WINAB = WS_W, WS_WOUTAB = WS_W + 28 * MiB, WS_WINCD = WS_W + 36 * MiB, WS_WOUTCD = WS_W + 58 * MiB, WS_WUK = WS_W + 66 * MiB, WS_WUV = WS_W + 67 * MiB;
constexpr size_t WS_XB = 116 * MiB;
constexpr size_t WS_MIX = 180 * MiB;
constexpr size_t WS_R1 = 244 * MiB;
constexpr size_t WS_TMP = WS_R1, WS_W13 = WS_R1 + 128 * MiB, WS_W2T = WS_R1 + 192 * MiB;
constexpr size_t WS_R2 = 468 * MiB;
constexpr size_t WS_END = 598 * MiB;
constexpr int CW_TMO = 0, CW_CODE = 1;
constexpr int CW_BAR = 4096;
constexpr int CW_CNT = 16384;
static_assert((CW_CNT + 2 * 16 * 64) * 4 <= (int)CTL_ZERO_BYTES && (CW_BAR + 3456) * 4 <= (int)CTL_ZERO_BYTES, "control words inside the cleared region");

constexpr int RING_BYTES = 131072;
constexpr int LDSCTL_OFF = RING_BYTES, MISC_OFF = LDSCTL_OFF + 320;
constexpr int LDS_BYTES = 147456;

#define RLX_AGENT __ATOMIC_RELAXED, __HIP_MEMORY_SCOPE_AGENT
#define LDS_WAIT() asm volatile("s_waitcnt lgkmcnt(0)" ::: "memory")
#define VM_WAIT() asm volatile("s_waitcnt vmcnt(0)" ::: "memory")
__device__ __forceinline__ unsigned f2bf(float f) { unsigned u = __builtin_bit_cast(unsigned, f); return (u + 0x7fffu + ((u >> 16) & 1u)) >> 16; }
__device__ __forceinline__ unsigned pk2(float lo, float hi) { return f2bf(lo) | (f2bf(hi) << 16); }
__device__ __forceinline__ float bf2f(unsigned b) { return __builtin_bit_cast(float, b << 16); }
__device__ __forceinline__ float bflo(unsigned w) { return __builtin_bit_cast(float, w << 16); }
__device__ __forceinline__ float bfhi(unsigned w) { return __builtin_bit_cast(float, w & 0xffff0000u); }
__device__ __forceinline__ unsigned cvt_pk_bf16(float lo, float hi) { unsigned r; asm volatile("v_cvt_pk_bf16_f32 %0, %1, %2" : "=v"(r) : "v"(lo), "v"(hi)); return r; }
__device__ __forceinline__ float sigmoidf_(float v) { return __builtin_amdgcn_rcpf(1.0f + __expf(-v)); }
__device__ __forceinline__ float siluf_(float v) { return v * __builtin_amdgcn_rcpf(1.0f + __expf(-v)); }
__device__ __forceinline__ float wave_sum(float v) {
#pragma unroll
    for (int o = 1; o < 64; o <<= 1) v += __shfl_xor(v, o);
    return v;
}
__device__ __forceinline__ float wave_max(float v) {
#pragma unroll
    for (int o = 1; o < 64; o <<= 1) v = fmaxf(v, __shfl_xor(v, o));
    return v;
}
namespace pg8 {
constexpr int BM = 256, BK = 64, HALF = 128, HTB = HALF * BK * 2, STAGE_BYTES = 8 * HTB, NXCD = 8, WGM = 8;
__host__ __device__ __forceinline__ int lds_byte(int r, int c) { const int st = (r >> 4) * 2 + (c >> 5), rr = r & 15, cc = c & 31, ob = rr * 64 + cc * 2; return st * 1024 + (ob ^ (((ob >> 9) & 1) << 5)); }
__host__ __device__ __forceinline__ void stage_rc(int b, int& R, int& C) { const int st = b / 1024, sb = b % 1024, swz = sb ^ (((sb >> 9) & 1) << 5); R = (st >> 1) * 16 + swz / 64; C = (st & 1) * 32 + (swz % 64) / 2; }
__host__ __device__ __forceinline__ int perm32(int rho) { const int n = rho >> 4, i = rho & 15; return 8 * (i >> 2) + 4 * n + (i & 3); }

struct Unit { int pm, pn, ex; };

struct StaticOrder {
    const char* A; const char* Bt; int lda, ldb;
    int nM, nN, nwg, G, c;
    __device__ void init(const bf16* A_, int lda_, const bf16* Bt_, int ldb_, int M, int N, int G_, int c_) { A = (const char*)A_; Bt = (const char*)Bt_; lda = lda_; ldb = ldb_; nM = M / BM; nN = N / BM; nwg = nM * nN; G = G_; c = c_; }
    __device__ bool next(int i, Unit& u) const {
        const long L = (long)i * G + c; if (L >= nwg) return false;
        int wgid = (int)L; { const int q = nwg / NXCD, r = nwg % NXCD, xcd = wgid % NXCD, off = wgid / NXCD; wgid = (xcd < r ? xcd * (q + 1) : r * (q + 1) + (xcd - r) * q) + off; }
        const int nig = WGM * nN, gid = wgid / nig, fm = gid * WGM, gsz = (nM - fm) < WGM ? (nM - fm) : WGM;
        u.pm = fm + ((wgid % nig) % gsz); u.pn = (wgid % nig) / gsz; u.ex = 0; return true;
    }
    __device__ __forceinline__ const char* a_base(const Unit& u) const { return A + (size_t)u.pm * BM * lda * 2; }
    __device__ __forceinline__ const char* b_base(const Unit& u) const { return Bt + (size_t)u.pn * BM * ldb * 2; }
    __device__ __forceinline__ unsigned a_rowoff(const Unit&, int) const { return 0u; }
};

template <class Epi, class Sched, bool GATHER = false>
__device__ __forceinline__ void gemm_phase(LAS unsigned char* lds, const int K, const Sched& S, const Epi& E) {
    const int tid = threadIdx.x, wid = __builtin_amdgcn_readfirstlane(tid >> 6), lane = tid & 63, wr = wid >> 2, wc = wid & 3, fr = lane & 15, fq = lane >> 4;
    const int nt = K / BK;
    const int lda = S.lda, ldb = S.ldb;
    int Rst[2], Cst[2];
    unsigned voffA[2], voffB[2];
#pragma unroll
    for (int i = 0; i < 2; ++i) { int R, C; stage_rc(tid * 16 + i * 8192, R, C); Rst[i] = R; Cst[i] = C; const int Rb = Epi::PERM ? ((R & ~31) + perm32(R & 31)) : R;
        voffA[i] = (unsigned)(R * lda + C) * 2u; voffB[i] = (unsigned)(Rb * ldb + C) * 2u; }
    const size_t kstep = (size_t)(BK * 2);
    const size_t hstepA = (size_t)HALF * lda * 2, hstepB = (size_t)HALF * ldb * 2;
    const unsigned ldsw = (unsigned)wid * 1024u;
    const int aoff = lds_byte(wr * 64 + fr, fq * 8), boff = lds_byte(wc * 32 + fr, fq * 8);
    unsigned vc[2][2], vn[2][2];
#define PG8_SA(b, h) (((b) * 2 + (h)) * HTB)
#define PG8_SB(b, h) ((4 + (b) * 2 + (h)) * HTB)
#define PG8_STAGE_B(bufoff, gbase) do { _Pragma("unroll") for (int _i = 0; _i < 2; ++_i) \
        __builtin_amdgcn_global_load_lds((const unsigned*)((const char*)(gbase) + voffB[_i]), (LAS unsigned*)(lds + (bufoff) + ldsw + _i * 8192), 16, 0, 0); } while (0)
#define PG8_STAGE_A(bufoff, gbase, h, vs) do { _Pragma("unroll") for (int _i = 0; _i < 2; ++_i) { \
        const char* _p = GATHER ? ((const char*)(gbase) + (vs)[h][_i]) : ((const char*)(gbase) + (h) * hstepA + voffA[_i]); \
        __builtin_amdgcn_global_load_lds((const unsigned*)_p, (LAS unsigned*)(lds + (bufoff) + ldsw + _i * 8192), 16, 0, 0); } } while (0)
#define PG8_LDA(dst, b, h) do { _Pragma("unroll") for (int m = 0; m < 4; ++m) _Pragma("unroll") for (int k = 0; k < 2; ++k) dst[m][k] = *(const LAS bf16x8*)(lds + PG8_SA(b, h) + aoff + m * 2048 + k * 1024); } while (0)
#define PG8_LDB(dst, b, h) do { _Pragma("unroll") for (int n = 0; n < 2; ++n) _Pragma("unroll") for (int k = 0; k < 2; ++k) dst[n][k] = *(const LAS bf16x8*)(lds + PG8_SB(b, h) + boff + n * 2048 + k * 1024); } while (0)
#define PG8_MMA(ai, bj, At, Bt) do { __builtin_amdgcn_s_setprio(1); _Pragma("unroll") for (int m = 0; m < 4; ++m) _Pragma("unroll") for (int n = 0; n < 2; ++n) _Pragma("unroll") for (int k = 0; k < 2; ++k) \
        acc[ai][bj][m][n] = __builtin_amdgcn_mfma_f32_16x16x32_bf16(Bt[n][k], At[m][k], acc[ai][bj][m][n], 0, 0, 0); __builtin_amdgcn_s_setprio(0); } while (0)
#define PG8_WAIT_V(n) asm volatile("s_waitcnt vmcnt(" #n ")" ::: "memory")
#define PG8_WAIT_L(n) asm volatile("s_waitcnt lgkmcnt(" #n ")" ::: "memory")
#define PG8_BAR __builtin_amdgcn_s_barrier()
#define PG8_SCHED __builtin_amdgcn_sched_barrier(0)
#define PG8_LOADV(dst, u) do { if constexpr (GATHER) { _Pragma("unroll") for (int _h = 0; _h < 2; ++_h) _Pragma("unroll") for (int _i = 0; _i < 2; ++_i) \
        dst[_h][_i] = S.a_rowoff(u, _h * HALF + Rst[_i]) + (unsigned)Cst[_i] * 2u; } } while (0)
    Unit cur, nxt; int ui = 0;
    if (!S.next(0, cur)) return;
    f32x4 acc[2][2][4][2];
#pragma unroll
    for (int a = 0; a < 2; ++a)
#pragma unroll
        for (int b = 0; b < 2; ++b)
#pragma unroll
            for (int m = 0; m < 4; ++m)
#pragma unroll
                for (int n = 0; n < 2; ++n) acc[a][b][m][n] = (f32x4){0.f, 0.f, 0.f, 0.f};
    bf16x8 At[4][2], B0[2][2], B1[2][2];
    const char* cA = S.a_base(cur); const char* cB = S.b_base(cur);
    PG8_LOADV(vc, cur);
#pragma unroll
    for (int _h = 0; _h < 2; ++_h)
#pragma unroll
        for (int _i = 0; _i < 2; ++_i) vn[_h][_i] = GATHER ? vc[_h][_i] : 0u;
    PG8_STAGE_B(PG8_SB(0, 0), cB); PG8_STAGE_B(PG8_SB(0, 1), cB + hstepB); PG8_STAGE_A(PG8_SA(0, 0), cA, 0, vc); PG8_STAGE_A(PG8_SA(0, 1), cA, 1, vc);
    if (wr == 1) PG8_BAR;
    PG8_WAIT_V(2); PG8_BAR;
    PG8_STAGE_B(PG8_SB(1, 0), cB + kstep); PG8_STAGE_A(PG8_SA(1, 0), cA + kstep, 0, vc); PG8_STAGE_B(PG8_SB(1, 1), cB + hstepB + kstep);
    PG8_WAIT_V(6); PG8_BAR;
    for (;;) {
        const bool has_next = S.next(ui + 1, nxt);
        const char* nA = has_next ? S.a_base(nxt) : cA; const char* nB = has_next ? S.b_base(nxt) : cB;
        if constexpr (GATHER) { if (has_next) { PG8_LOADV(vn, nxt); } else {
#pragma unroll
            for (int _h = 0; _h < 2; ++_h)
#pragma unroll
                for (int _i = 0; _i < 2; ++_i) vn[_h][_i] = vc[_h][_i]; }
            asm volatile("s_waitcnt vmcnt(0)" :: "v"(vn[0][0]), "v"(vn[0][1]), "v"(vn[1][0]), "v"(vn[1][1]) : "memory"); }
        for (int t = 0; t < nt; t += 2) {
            const bool last = (t == nt - 2);
            const char* a1 = cA + (size_t)(t + 1) * kstep;
            const char* a2 = last ? nA : cA + (size_t)(t + 2) * kstep; const char* b2 = last ? nB : cB + (size_t)(t + 2) * kstep;
            const char* a3 = a2 + kstep; const char* b3 = b2 + kstep;
            unsigned vs[2][2];
#pragma unroll
            for (int _h = 0; _h < 2; ++_h)
#pragma unroll
                for (int _i = 0; _i < 2; ++_i) vs[_h][_i] = GATHER ? (last ? vn[_h][_i] : vc[_h][_i]) : 0u;
            PG8_LDB(B0, 0, 0); PG8_LDB(B1, 0, 1); PG8_SCHED; PG8_LDA(At, 0, 0); PG8_STAGE_A(PG8_SA(1, 1), a1, 1, vc);
            PG8_WAIT_V(8); PG8_WAIT_L(0); PG8_BAR; PG8_MMA(0, 0, At, B0); PG8_MMA(0, 1, At, B1); PG8_BAR; PG8_SCHED;
            PG8_LDA(At, 0, 1); PG8_STAGE_B(PG8_SB(0, 0), b2); PG8_STAGE_B(PG8_SB(0, 1), b2 + hstepB); PG8_STAGE_A(PG8_SA(0, 0), a2, 0, vs);
            PG8_WAIT_V(8); PG8_WAIT_L(0); PG8_BAR; PG8_MMA(1, 0, At, B0); PG8_MMA(1, 1, At, B1); PG8_BAR; PG8_SCHED;
            PG8_LDB(B0, 1, 0); PG8_LDB(B1, 1, 1); PG8_SCHED; PG8_LDA(At, 1, 0); PG8_STAGE_A(PG8_SA(0, 1), a2, 1, vs);
            PG8_WAIT_V(8); PG8_WAIT_L(0); PG8_BAR; PG8_MMA(0, 0, At, B0); PG8_MMA(0, 1, At, B1); PG8_BAR; PG8_SCHED;
            PG8_LDA(At, 1, 1); PG8_STAGE_B(PG8_SB(1, 0), b3); PG8_STAGE_B(PG8_SB(1, 1), b3 + hstepB); PG8_STAGE_A(PG8_SA(1, 0), a3, 0, vs);
            PG8_WAIT_V(8); PG8_WAIT_L(0); PG8_BAR; PG8_MMA(1, 0, At, B0); PG8_MMA(1, 1, At, B1); PG8_BAR; PG8_SCHED;
        }
        if (wr == 0) PG8_BAR;
        E(acc, cur, wr, wc, fr, fq);
        if (!has_next) break;
#pragma unroll
        for (int a = 0; a < 2; ++a)
#pragma unroll
            for (int b = 0; b < 2; ++b)
#pragma unroll
                for (int m = 0; m < 4; ++m)
#pragma unroll
                    for (int n = 0; n < 2; ++n) acc[a][b][m][n] = (f32x4){0.f, 0.f, 0.f, 0.f};
        cur = nxt; cA = nA; cB = nB; ++ui;
#pragma unroll
        for (int _h = 0; _h < 2; ++_h)
#pragma unroll
            for (int _i = 0; _i < 2; ++_i) vc[_h][_i] = vn[_h][_i];
        if (wr == 1) PG8_BAR;
    }
    PG8_WAIT_V(0);
    PG8_BAR;
#undef PG8_SA
#undef PG8_SB
#undef PG8_STAGE_A
#undef PG8_STAGE_B
#undef PG8_LDA
#undef PG8_LDB
#undef PG8_MMA
#undef PG8_WAIT_V
#undef PG8_WAIT_L
#undef PG8_BAR
#undef PG8_SCHED
#undef PG8_LOADV
}
}
namespace pg8 {
struct EpiF32 {
    static constexpr bool PERM = false;
    float* C; int ldc;
    __device__ __forceinline__ void operator()(const f32x4 (&acc)[2][2][4][2], const Unit& u, int wr, int wc, int fr, int fq) const {
        const int row0 = u.pm * BM + wr * 64 + fr, col0 = u.pn * BM + wc * 32 + 4 * fq;
#pragma unroll
        for (int ai = 0; ai < 2; ++ai)
#pragma unroll
            for (int m = 0; m < 4; ++m) { float* rowp = C + (size_t)(row0 + ai * HALF + m * 16) * ldc + col0;
#pragma unroll
                for (int bj = 0; bj < 2; ++bj)
#pragma unroll
                    for (int n = 0; n < 2; ++n) *(f32x4*)(rowp + bj * HALF + n * 16) = acc[ai][bj][m][n]; }
    }
};
__device__ __forceinline__ float epi_act(int mode, float v, float aux) {
    if (mode == 1) return siluf_(v);
    if (mode == 2) return v * aux;
    if (mode == 3) return __logf(aux + (1.0f - aux) * sigmoidf_(v));
    if (mode == 4) return sigmoidf_(v);
    if (mode == 5) return 0.f;
    return v;
}
__device__ __forceinline__ void store_bf16_tile(const f32x4 (&acc)[2][2][4][2], bf16* O, int ldc, int row0, int col0, int mode, float auxs, const float* auxv  , int nbj) {
    f32x4 av[2][2];
#pragma unroll
    for (int bj = 0; bj < 2; ++bj)
#pragma unroll
        for (int n = 0; n < 2; ++n) av[bj][n] = auxv ? *(const f32x4*)(auxv + bj * HALF + 4 * n) : (f32x4){auxs, auxs, auxs, auxs};
#pragma unroll
    for (int ai = 0; ai < 2; ++ai)
#pragma unroll
        for (int m = 0; m < 4; ++m) { bf16* rowp = O + (size_t)(row0 + ai * HALF + m * 16) * ldc + col0;
#pragma unroll
            for (int bj = 0; bj < 2; ++bj) { if (bj < nbj) { f32x4 v0 = acc[ai][bj][m][0], v1 = acc[ai][bj][m][1];
                if (mode != 0) {
#pragma unroll
                    for (int j = 0; j < 4; ++j) { v0[j] = epi_act(mode, v0[j], av[bj][0][j]); v1[j] = epi_act(mode, v1[j], av[bj][1][j]); } }
                u32x4 w; w.x = cvt_pk_bf16(v0[0], v0[1]); w.y = cvt_pk_bf16(v0[2], v0[3]); w.z = cvt_pk_bf16(v1[0], v1[1]); w.w = cvt_pk_bf16(v1[2], v1[3]);
                *(u32x4*)(rowp + bj * HALF) = w; } } }
}
struct EpiBf16 {
    static constexpr bool PERM = true;
    bf16* O; int ldc;
    __device__ __forceinline__ void operator()(const f32x4 (&acc)[2][2][4][2], const Unit& u, int wr, int wc, int fr, int fq) const {
        store_bf16_tile(acc, O, ldc, u.pm * BM + wr * 64 + fr, u.pn * BM + wc * 32 + 8 * fq, 0, 0.f, nullptr, 2);
    }
};
struct EpiAB {
    static constexpr bool PERM = true;
    bf16* O; const float* lb;
    __device__ __forceinline__ void operator()(const f32x4 (&acc)[2][2][4][2], const Unit& u, int wr, int wc, int fr, int fq) const {
        const int pn = u.pn; int mode = 0; float auxs = 0.f; const float* auxv = nullptr;
        const int cl = wc * 32 + 8 * fq;
        if (pn < 4) mode = 1;
        else if (pn < 8) { mode = 3; auxv = lb + (pn - 4) * BM + cl; }
        else if (pn < 12) mode = 0;
        else if (pn < 16) mode = 1;
        else if (pn < 18) { mode = 2; auxs = 0.08838834764831845f; }
        else if (pn < 24) mode = 0;
        else mode = 1;
        store_bf16_tile(acc, O, N_AB, u.pm * BM + wr * 64 + fr, pn * BM + cl, mode, auxs, auxv, 2);
    }
};
struct EpiCD {
    static constexpr bool PERM = true;
    bf16* O; float* small;
    __device__ __forceinline__ void operator()(const f32x4 (&acc)[2][2][4][2], const Unit& u, int wr, int wc, int fr, int fq) const {
        const int pn = u.pn; const int cl = wc * 32 + 8 * fq; const int row0 = u.pm * BM + wr * 64 + fr;
        if (pn == 21) {
#pragma unroll
            for (int ai = 0; ai < 2; ++ai)
#pragma unroll
                for (int m = 0; m < 4; ++m) { float* rowp = small + (size_t)(row0 + ai * HALF + m * 16) * 128 + cl;
                    *(f32x4*)(rowp) = acc[ai][0][m][0]; *(f32x4*)(rowp + 4) = acc[ai][0][m][1]; }
            return;
        }
        int mode = 0; float auxs = 0.f;
        if (pn >= 5 && pn < 9) { mode = 2; auxs = 0.125f; }
        else if (pn >= 17) mode = 4;
        store_bf16_tile(acc, O, N_CD, row0, pn * BM + cl, mode, auxs, nullptr, 2);
    }
};
struct EpiHead {
    static constexpr bool PERM = true;
    bf16* O; int ldc; int colstride; int nbj; int mode; float auxs;
    __device__ __forceinline__ void operator()(const f32x4 (&acc)[2][2][4][2], const Unit& u, int wr, int wc, int fr, int fq) const {
        store_bf16_tile(acc, O, ldc, u.pm * BM + wr * 64 + fr, u.ex * colstride + wc * 32 + 8 * fq, mode, auxs, nullptr, nbj);
    }
};
struct HeadOrder {
    const char* A; const char* Bt; int lda, ldb; int acol; int G, c;
    __device__ bool next(int i, Unit& u) const { const int L = i * G + c; if (L >= 64 * 8) return false; u.pm = L >> 3; u.ex = L & 7; u.pn = 0; return true; }
    __device__ __forceinline__ const char* a_base(const Unit& u) const { return A + ((size_t)u.pm * BM * lda + (size_t)u.ex * acol) * 2; }
    __device__ __forceinline__ const char* b_base(const Unit& u) const { return Bt + (size_t)u.ex * BM * ldb * 2; }
    __device__ __forceinline__ unsigned a_rowoff(const Unit&, int) const { return 0u; }
};
struct MoeOrder {
    const char* A; const char* Bt; int lda, ldb; int NT; int G, c; int brows;
    const volatile LAS int* tab; const int* list;
    bool gather;
    __device__ bool next(int i, Unit& u) const {
        const int cx = ((G & 7) == 0) ? (c & 7) * (G >> 3) + (c >> 3) : c;
        const int L = i * G + cx; const int total = tab[16] * NT; if (L >= total) return false;
        const int mg = L / NT; u.pn = L - mg * NT; int e = 0;
#pragma unroll
        for (int j = 1; j < 16; ++j) e += (mg >= tab[j]) ? 1 : 0;
        u.ex = e; u.pm = mg; return true;
    }
    __device__ __forceinline__ const char* a_base(const Unit& u) const { return gather ? A : A + (size_t)u.pm * BM * lda * 2; }
    __device__ __forceinline__ const char* b_base(const Unit& u) const { return Bt + ((size_t)u.ex * brows + (size_t)u.pn * BM) * ldb * 2; }
    __device__ __forceinline__ unsigned a_rowoff(const Unit& u, int r) const {
        const int lr = (u.pm - tab[u.ex]) * BM + r; const int ne = tab[32 + u.ex];
        const int tok = (lr < ne) ? (list[u.ex * 16384 + lr] & 0x7fffffff) : 0;
        return (unsigned)tok * (unsigned)(lda * 2);
    }
};
struct EpiMoe1 {
    static constexpr bool PERM = true;
    bf16* hid; const float* wl; const volatile LAS int* tab;
    __device__ __forceinline__ void operator()(const f32x4 (&acc)[2][2][4][2], const Unit& u, int wr, int wc, int fr, int fq) const {
        const int e = u.ex, lr0 = (u.pm - tab[e]) * BM + wr * 64 + fr, ne = tab[32 + e];
        const int col0 = u.pn * 128 + wc * 32 + 8 * fq;
#pragma unroll
        for (int ai = 0; ai < 2; ++ai)
#pragma unroll
            for (int m = 0; m < 4; ++m) { const int lr = lr0 + ai * HALF + m * 16;
                if (lr < ne) { const float w = wl[e * 16384 + lr];
                    f32x4 a0 = acc[ai][0][m][0], a1 = acc[ai][0][m][1], b0 = acc[ai][1][m][0], b1 = acc[ai][1][m][1];
#pragma unroll
                    for (int j = 0; j < 4; ++j) { a0[j] = siluf_(a0[j]) * b0[j] * w; a1[j] = siluf_(a1[j]) * b1[j] * w; }
                    u32x4 o; o.x = cvt_pk_bf16(a0[0], a0[1]); o.y = cvt_pk_bf16(a0[2], a0[3]); o.z = cvt_pk_bf16(a1[0], a1[1]); o.w = cvt_pk_bf16(a1[2], a1[3]);
                    *(u32x4*)(hid + (size_t)(u.pm * BM + wr * 64 + fr + ai * HALF + m * 16) * DEXP + col0) = o; } }
    }
};
struct EpiMoe2 {
    static constexpr bool PERM = true;
    bf16* ys; const int* list; const volatile LAS int* tab;
    __device__ __forceinline__ void operator()(const f32x4 (&acc)[2][2][4][2], const Unit& u, int wr, int wc, int fr, int fq) const {
        const int e = u.ex, lr0 = (u.pm - tab[e]) * BM + wr * 64 + fr, ne = tab[32 + e];
        const int col0 = u.pn * BM + wc * 32 + 8 * fq;
#pragma unroll
        for (int ai = 0; ai < 2; ++ai)
#pragma unroll
            for (int m = 0; m < 4; ++m) { const int lr = lr0 + ai * HALF + m * 16;
                if (lr < ne) { const int ent = list[e * 16384 + lr]; const int tok = ent & 0x7fffffff, slot = (ent >> 31) & 1;
                    bf16* rowp = ys + ((size_t)slot * T + tok) * D + col0;
#pragma unroll
                    for (int bj = 0; bj < 2; ++bj) { const f32x4 v0 = acc[ai][bj][m][0], v1 = acc[ai][bj][m][1];
                        u32x4 o; o.x = cvt_pk_bf16(v0[0], v0[1]); o.y = cvt_pk_bf16(v0[2], v0[3]); o.z = cvt_pk_bf16(v1[0], v1[1]); o.w = cvt_pk_bf16(v1[2], v1[3]);
                        *(u32x4*)(rowp + bj * HALF) = o; } } }
    }
};
}
#define XB_TMO      128
#define XB_XCNT(j)  (256  + 64 * (j))
#define XB_XSUB(j)  (1280 + 64 * (j))
#define XB_XGEN(j)  (2304 + 64 * (j))
#define XB_TOP      3328
#define XB_TOPGEN   3392
#define XCD_BAR_WORDS 3456
#define XB_SPIN_CAP (1u << 22)

__device__ __forceinline__ unsigned xb_ld(unsigned* p)              { return __hip_atomic_load(p, __ATOMIC_RELAXED, __HIP_MEMORY_SCOPE_AGENT); }
__device__ __forceinline__ unsigned xb_add(unsigned* p, unsigned v) { return __hip_atomic_fetch_add(p, v, __ATOMIC_RELAXED, __HIP_MEMORY_SCOPE_AGENT); }
__device__ __forceinline__ unsigned xb_xcc_id() { return (unsigned)__builtin_amdgcn_s_getreg((3 << 11) | 20) & 0xFu; }
#define XB_SPIN(cond, bar) do { unsigned _sp = 0; while (cond) { __builtin_amdgcn_s_sleep(1); \
    if ((++_sp & 255u) == 0u) { if (xb_ld(&(bar)[XB_TMO])) break; if (_sp > XB_SPIN_CAP) { atomicAdd(&(bar)[XB_TMO], 1u); break; } } } } while (0)

struct XcdBarrier { unsigned* bar; unsigned x; volatile LAS unsigned* st; };

__device__ __forceinline__ XcdBarrier xcd_barrier_post(unsigned* bar, volatile LAS unsigned* st) {
    XcdBarrier b; b.bar = bar; b.x = xb_xcc_id(); b.st = st;
    if (threadIdx.x == 0) (void)xb_add(&bar[XB_XCNT(b.x)], 1u);
    return b;
}
__device__ __forceinline__ void xcd_barrier_complete(unsigned* bar, unsigned x, unsigned& nloc, unsigned& nx) {
    const unsigned G = gridDim.x * gridDim.y * gridDim.z;
    unsigned sum, cnt, mine, sp = 0u;
    for (;;) {
        sum = 0u; cnt = 0u; mine = 0u;
#pragma unroll
        for (unsigned j = 0; j < 16; ++j) { const unsigned c = xb_ld(&bar[XB_XCNT(j)]); sum += c; cnt += (c > 0u) ? 1u : 0u; mine = (j == x) ? c : mine; }
        if (sum == G) break;
        __builtin_amdgcn_s_sleep(1);
        if ((++sp & 255u) == 0u) { if (xb_ld(&bar[XB_TMO])) break; if (sp > XB_SPIN_CAP) { atomicAdd(&bar[XB_TMO], 1u); break; } }
    }
    nloc = mine > 0u ? mine : 1u; nx = cnt > 0u ? cnt : 1u;
}
__device__ __forceinline__ void xcd_barrier(const XcdBarrier& b) {
    asm volatile("s_waitcnt vmcnt(0)" ::: "memory");
    __syncthreads();
    if (threadIdx.x == 0) {
        unsigned* bar = b.bar;
        __builtin_amdgcn_s_waitcnt(0);
        unsigned nloc = b.st[0], nx = b.st[1];
        if (nloc == 0u) { xcd_barrier_complete(bar, b.x, nloc, nx); b.st[0] = nloc; b.st[1] = nx; }
        const unsigned old = xb_add(&bar[XB_XSUB(b.x)], 1u);
        const unsigned gen = old / nloc;
        if (old + 1u == (gen + 1u) * nloc) {
            __builtin_amdgcn_fence(__ATOMIC_RELEASE, "agent");
            asm volatile("s_waitcnt vmcnt(0)" ::: "memory");
            const unsigned og = xb_add(&bar[XB_TOP], 1u);
            const unsigned tg = og / nx;
            if (og + 1u == (tg + 1u) * nx) xb_add(&bar[XB_TOPGEN], 1u);
            else XB_SPIN(xb_ld(&bar[XB_TOPGEN]) == tg, bar);
            __builtin_amdgcn_fence(__ATOMIC_ACQUIRE, "agent");
            xb_add(&bar[XB_XGEN(b.x)], 1u);
            asm volatile("s_waitcnt vmcnt(0)" ::: "memory");
        } else {
            XB_SPIN(xb_ld(&bar[XB_XGEN(b.x)]) == gen, bar);
            __builtin_amdgcn_fence(__ATOMIC_ACQUIRE, "agent");
            asm volatile("s_waitcnt vmcnt(0)" ::: "memory");
        }
    }
    __syncthreads();
}

struct Args {
    const float* in[24]; float* out; unsigned char* ws; int ph_lo, ph_hi, use_bar, pad;
};
enum InIdx { I_X = 0, I_WINAB, I_WOUTAB, I_LBLOG, I_ANORM, I_WA2, I_BA2, I_BNORM, I_WINCD, I_WOUTCD, I_CKVG, I_WUK, I_WUV, I_CONVW, I_GATEB, I_DNORM, I_REL, I_WR, I_BR, I_W1, I_W3, I_W2, I_LNG, I_LNB };

struct Frame {
    LAS unsigned char* lds;
    gu32* ctl;
    int tid, lane, wave, G, bid;
    const float* const* in; float* out; unsigned char* ws;
};
#ifndef PROBE_REPCONV
#define PROBE_REPCONV 0
#endif
template <class SrcFn>
__device__ __forceinline__ void transpose_item(const SrcFn& src, int Kdst, bf16* WT, LAS float* scr, int kb, int nb, int lane) {
    const int k0 = 64 * kb, n0 = 32 * nb;
    float v[32];
#pragma unroll
    for (int i = 0; i < 32; ++i) v[i] = src(k0 + 2 * i + (lane >> 5), n0 + (lane & 31));
#pragma unroll
    for (int i = 0; i < 32; ++i) scr[(2 * i + (lane >> 5)) * 33 + (lane & 31)] = v[i];
    LDS_WAIT(); asm volatile("" ::: "memory");
    const int c = lane & 7;
#pragma unroll
    for (int j = 0; j < 4; ++j) { const int n = (lane >> 3) + 8 * j; const LAS float* s = scr + (8 * c) * 33 + n;
        u32x4 o; o.x = pk2(s[0 * 33], s[1 * 33]); o.y = pk2(s[2 * 33], s[3 * 33]); o.z = pk2(s[4 * 33], s[5 * 33]); o.w = pk2(s[6 * 33], s[7 * 33]);
        *(GAS u32x4*)(WT + (size_t)(n0 + n) * Kdst + k0 + 8 * c) = o; }
    LDS_WAIT(); asm volatile("" ::: "memory");
}
constexpr int TT_LD = 264;
template <class AddrFn>
__device__ __forceinline__ void wgt_load(const AddrFn& addr, int k0, int wave, int lane, f32x4 (&v)[8]) {
#pragma unroll
    for (int i = 0; i < 8; ++i) v[i] = *(const GAS f32x4*)addr(k0 + 8 * wave + i, 4 * lane);
}
__device__ __forceinline__ void wgt_emit(LAS bf16* tile, const f32x4 (&v)[8], bf16* WT, int Kdst, int k0, int n0, int wave, int lane) {
#pragma unroll
    for (int i = 0; i < 8; ++i) { u32x2 o; o.x = pk2(v[i].x, v[i].y); o.y = pk2(v[i].z, v[i].w); *(LAS u32x2*)(tile + (8 * wave + i) * TT_LD + 4 * lane) = o; }
    asm volatile("s_waitcnt lgkmcnt(0)" ::: "memory"); __builtin_amdgcn_s_barrier(); asm volatile("" ::: "memory");
    const int r16 = lane & 15, g4 = lane >> 4;
#pragma unroll
    for (int j = 0; j < 4; ++j) { const int it = wave * 4 + j, cg = it >> 1, hh = it & 1;
        const LAS bf16* p = tile + (32 * hh + 8 * g4 + (r16 >> 2)) * TT_LD + 16 * cg + 4 * (r16 & 3);
        const s16x4 lo = __builtin_bit_cast(s16x4, __builtin_amdgcn_ds_read_tr16_b64_v4i16((LAS s16x4*)p));
        const s16x4 hi = __builtin_bit_cast(s16x4, __builtin_amdgcn_ds_read_tr16_b64_v4i16((LAS s16x4*)(p + 4 * TT_LD)));
        const bf16x8 o = __builtin_shufflevector(lo, hi, 0, 1, 2, 3, 4, 5, 6, 7);
        *(GAS bf16x8*)(WT + (size_t)(n0 + 16 * cg + r16) * Kdst + k0 + 32 * hh + 8 * g4) = o; }
}
struct TItem { const float* p0; const float* p1; int pitch; bf16* WT; int Kdst, k0, n0; };
struct TAddr { const float* p0; const float* p1; int pitch;
    __device__ __forceinline__ const float* operator()(int k, int n4) const { return (n4 < 128 ? p0 : p1) + (size_t)k * pitch + (n4 & 127); } };
template <class Decode>
__device__ __forceinline__ void wgt_run(const Decode& decode, int nit, Frame& F) {
    LAS bf16* tile0 = (LAS bf16*)F.lds; LAS bf16* tile1 = (LAS bf16*)(F.lds + 64 * TT_LD * 2);
    f32x4 v[8], v2[8];
    int it = F.bid; int par = 0;
    TItem cur; if (it < nit) { cur = decode(it); wgt_load(TAddr{cur.p0, cur.p1, cur.pitch}, cur.k0, F.wave, F.lane, v); }
    while (it < nit) {
        const int nx = it + F.G; TItem nxt = cur;
        if (nx < nit) { nxt = decode(nx); wgt_load(TAddr{nxt.p0, nxt.p1, nxt.pitch}, nxt.k0, F.wave, F.lane, v2); }
        wgt_emit(par ? tile1 : tile0, v, cur.WT, cur.Kdst, cur.k0, cur.n0, F.wave, F.lane);
#pragma unroll
        for (int i = 0; i < 8; ++i) v[i] = v2[i];
        cur = nxt; it = nx; par ^= 1;
    }
}
__device__ __forceinline__ int cd_src_col(int n) {
    if (n < 2304) return n;
    if (n < 2816) return 2384 + (n - 2304);
    if (n < 3328) return 2896 + (n - 2816);
    if (n < 4352) return 3408 + (n - 3328);
    if (n < 5376) return 4440 + (n - 4352);
    if (n < 5440) return 2304 + (n - 5376);
    if (n < 5456) return 2368 + (n - 5440);
    if (n < 5460) return 4432 + (n - 5456);
    if (n < 5464) return 4436 + (n - 5460);
    return -1;
}
__device__ __forceinline__ void load_w16_T(LAS float* WT, const float* W, int ld, int col0, int tid) {
#pragma unroll 4
    for (int i = tid; i < 2048 * 4; i += 512) { const int k = i >> 2, e4 = (i & 3) * 4; const f32x4 w = *(const f32x4*)(W + (size_t)k * ld + col0 + e4);
        WT[(e4 + 0) * 2048 + k] = w.x; WT[(e4 + 1) * 2048 + k] = w.y; WT[(e4 + 2) * 2048 + k] = w.z; WT[(e4 + 3) * 2048 + k] = w.w; }
}
template <bool WBF16>
__device__ __forceinline__ void row_dot16(const f32x4 (&v)[8], const LAS void* WTv, int lane, float (&out)[16]) {
    float s[16];
#pragma unroll
    for (int e = 0; e < 16; ++e) { float a = 0.f;
        if (WBF16) { const LAS bf16* WT = (const LAS bf16*)WTv;
#pragma unroll
            for (int j = 0; j < 8; ++j) { const u32x2 w = *(const LAS u32x2*)(WT + e * 2048 + 256 * j + 4 * lane); a += (v[j].x * bflo(w.x) + v[j].y * bfhi(w.x)) + (v[j].z * bflo(w.y) + v[j].w * bfhi(w.y)); } }
        else { const LAS float* WT = (const LAS float*)WTv;
#pragma unroll
            for (int j = 0; j < 8; ++j) { const f32x4 w = *(const LAS f32x4*)(WT + e * 2048 + 256 * j + 4 * lane); a += (v[j].x * w.x + v[j].y * w.y) + (v[j].z * w.z + v[j].w * w.w); } }
        s[e] = a; __builtin_amdgcn_sched_barrier(0); }
#define RD_STEP(N, XOR) { const bool hi_ = (lane & (XOR)) != 0; _Pragma("unroll") for (int j = 0; j < (N); ++j) { const float send = hi_ ? s[j] : s[(N) + j]; const float keep = hi_ ? s[(N) + j] : s[j]; s[j] = keep + __shfl_xor(send, (XOR)); } }
    RD_STEP(8, 32) RD_STEP(4, 16) RD_STEP(2, 8) RD_STEP(1, 4)
#undef RD_STEP
    float r = s[0]; r += __shfl_xor(r, 2); r += __shfl_xor(r, 1);
#pragma unroll
    for (int e = 0; e < 16; ++e) out[e] = __builtin_bit_cast(float, __builtin_amdgcn_readlane(__builtin_bit_cast(int, r), (((e >> 3) & 1) << 5) | (((e >> 2) & 1) << 4) | (((e >> 1) & 1) << 3) | ((e & 1) << 2)));
}
template <bool WBF16>
__device__ __forceinline__ void row_dot16x2(const f32x4 (&v0)[8], const f32x4 (&v1)[8], const LAS void* WTv, int lane, float (&out0)[16], float (&out1)[16]) {
    float s[16], q[16];
#pragma unroll
    for (int e = 0; e < 16; ++e) { float a = 0.f, b = 0.f;
        if (WBF16) { const LAS bf16* WT = (const LAS bf16*)WTv;
#pragma unroll
            for (int j = 0; j < 8; ++j) { const u32x2 w = *(const LAS u32x2*)(WT + e * 2048 + 256 * j + 4 * lane); const float w0 = bflo(w.x), w1 = bfhi(w.x), w2 = bflo(w.y), w3 = bfhi(w.y);
                a += (v0[j].x * w0 + v0[j].y * w1) + (v0[j].z * w2 + v0[j].w * w3); b += (v1[j].x * w0 + v1[j].y * w1) + (v1[j].z * w2 + v1[j].w * w3); } }
        else { const LAS float* WT = (const LAS float*)WTv;
#pragma unroll
            for (int j = 0; j < 8; ++j) { const f32x4 w = *(const LAS f32x4*)(WT + e * 2048 + 256 * j + 4 * lane);
                a += (v0[j].x * w.x + v0[j].y * w.y) + (v0[j].z * w.z + v0[j].w * w.w); b += (v1[j].x * w.x + v1[j].y * w.y) + (v1[j].z * w.z + v1[j].w * w.w); } }
        s[e] = a; q[e] = b; __builtin_amdgcn_sched_barrier(0); }
#define RD_STEP2(N, XOR) { const bool hi_ = (lane & (XOR)) != 0; _Pragma("unroll") for (int j = 0; j < (N); ++j) { \
        { const float send = hi_ ? s[j] : s[(N) + j]; const float keep = hi_ ? s[(N) + j] : s[j]; s[j] = keep + __shfl_xor(send, (XOR)); } \
        { const float send = hi_ ? q[j] : q[(N) + j]; const float keep = hi_ ? q[(N) + j] : q[j]; q[j] = keep + __shfl_xor(send, (XOR)); } } }
    RD_STEP2(8, 32) RD_STEP2(4, 16) RD_STEP2(2, 8) RD_STEP2(1, 4)
#undef RD_STEP2
    float r = s[0]; r += __shfl_xor(r, 2); r += __shfl_xor(r, 1);
    float r2 = q[0]; r2 += __shfl_xor(r2, 2); r2 += __shfl_xor(r2, 1);
#pragma unroll
    for (int e = 0; e < 16; ++e) { const int sl = (((e >> 3) & 1) << 5) | (((e >> 2) & 1) << 4) | (((e >> 1) & 1) << 3) | ((e & 1) << 2);
        out0[e] = __builtin_bit_cast(float, __builtin_amdgcn_readlane(__builtin_bit_cast(int, r), sl)); out1[e] = __builtin_bit_cast(float, __builtin_amdgcn_readlane(__builtin_bit_cast(int, r2), sl)); }
}
__device__ __forceinline__ void store_row_bf16(bf16* orow, const f32x4 (&v)[8], int lane) {
    GAS unsigned long long* o8 = (GAS unsigned long long*)orow + lane;
#pragma unroll
    for (int j = 0; j < 8; ++j) o8[64 * j] = (unsigned long long)pk2(v[j].x, v[j].y) | ((unsigned long long)pk2(v[j].z, v[j].w) << 32);
}
__device__ __forceinline__ float log_sigmoid_(float z) { return -(fmaxf(-z, 0.f) + __logf(1.0f + __expf(-fabsf(z)))); }

__device__ __forceinline__ void p0_prologue(const Args& args, Frame& F) {
    LAS float* scr = (LAS float*)(F.lds + F.wave * 16384);
    const int gw = F.bid * 8 + F.wave, NGW = F.G * 8;
    unsigned char* ws = args.ws;
    { const int gt = F.bid * 512 + F.tid; if (gt < 1024) { const float a = args.in[I_LBLOG][gt], b = args.in[I_LBLOG][1024 + gt]; const float m = fmaxf(a, b); const float ea = __expf(a - m), eb = __expf(b - m); ((float*)(ws + WS_LB))[gt] = ea / (ea + eb); } }
    {
        const float* wab = args.in[I_WINAB]; const float* woab = args.in[I_WOUTAB]; const float* wcd = args.in[I_WINCD]; const float* wocd = args.in[I_WOUTCD];
        constexpr int J0 = 32 * 28, J1 = 32 * 8, J2 = 32 * 21, J3 = 32 * 8;
        for (int rep_ = 0; rep_ < ((PROBE_REPCONV & 2) ? 2 : 1); ++rep_)
        wgt_run([&](int it) { TItem t; int r = it;
            if (r < J0) { const int kb = r / 28, nb = r % 28; t.p0 = wab + 256 * nb; t.p1 = t.p0 + 128; t.pitch = PSRC_AB; t.WT = (bf16*)(ws + WS_WINAB); t.Kdst = 2048; t.k0 = 64 * kb; t.n0 = 256 * nb; return t; } r -= J0;
            if (r < J1) { const int kb = r / 8, nb = r % 8; t.p0 = woab + 256 * nb; t.p1 = t.p0 + 128; t.pitch = 2048; t.WT = (bf16*)(ws + WS_WOUTAB); t.Kdst = 2048; t.k0 = 64 * kb; t.n0 = 256 * nb; return t; } r -= J1;
            if (r < J2) { const int kb = r / 21, nb = r % 21; t.p0 = wcd + cd_src_col(256 * nb); t.p1 = t.p0 + 128; t.pitch = PSRC_CD; t.WT = (bf16*)(ws + WS_WINCD); t.Kdst = 2048; t.k0 = 64 * kb; t.n0 = 256 * nb; return t; } r -= J2;
            { const int kb = r / 8, nb = r % 8; t.p0 = wocd + 256 * nb; t.p1 = t.p0 + 128; t.pitch = 2048; t.WT = (bf16*)(ws + WS_WOUTCD); t.Kdst = 2048; t.k0 = 64 * kb; t.n0 = 256 * nb; return t; }
        }, J0 + J1 + J2 + J3, F);
        __syncthreads();
    }
    constexpr int I2 = 32 * 8, I4 = 4 * 64, I5 = 4 * 64;
    constexpr int NIT = I2 + I4 + I5;
    for (int it = gw; it < NIT; it += NGW) {
        int r = it;
        if (r < I2) { const float* W = args.in[I_WINCD]; transpose_item([&](int k, int n) { const int sc = cd_src_col(n); return sc >= 0 ? W[(size_t)k * PSRC_CD + sc] : 0.f; }, 2048, (bf16*)(ws + WS_WINCD), scr, r / 8, 168 + r % 8, F.lane); continue; } r -= I2;
        if (r < I4) { const float* W = args.in[I_WUK];
            transpose_item([&](int k, int n) { const int h = n >> 8, c = n & 255; return k < 128 ? W[(size_t)c * 1024 + h * 128 + k] * 0.08838834764831845f : 0.f; }, 256, (bf16*)(ws + WS_WUK), scr, r / 64, r % 64, F.lane); continue; } r -= I4;
        { const float* W = args.in[I_WUV];
            transpose_item([&](int k, int n) { const int h = n >> 8, d = n & 255; return d < 128 ? W[(size_t)k * 1024 + h * 128 + d] : 0.f; }, 256, (bf16*)(ws + WS_WUV), scr, r / 64, r % 64, F.lane); }
    }
    __syncthreads();
    LAS bf16* WT = (LAS bf16*)F.lds;
    LAS float* wa2 = (LAS float*)(F.lds + 65536);
#pragma unroll 4
    for (int i = F.tid; i < 2048 * 4; i += 512) { const int k = i >> 2, e4 = (i & 3) * 4; const f32x4 w = *(const f32x4*)(args.in[I_WINAB] + (size_t)k * PSRC_AB + 7168 + e4);
        WT[(e4 + 0) * 2048 + k] = (bf16)f2bf(w.x); WT[(e4 + 1) * 2048 + k] = (bf16)f2bf(w.y); WT[(e4 + 2) * 2048 + k] = (bf16)f2bf(w.z); WT[(e4 + 3) * 2048 + k] = (bf16)f2bf(w.w); }
    for (int i = F.tid; i < 16 * 128; i += 512) *(LAS f32x4*)(wa2 + 4 * i) = *(const f32x4*)(args.in[I_WA2] + 4 * i);
    __syncthreads();
    const float* ba2 = args.in[I_BA2];
    for (int rep_ = 0; rep_ < ((PROBE_REPCONV & 4) ? 2 : 1); ++rep_)
    for (int m = gw; m < T; m += NGW) {
        const GAS f32x4* xr = (const GAS f32x4*)(args.in[I_X] + (size_t)m * D) + F.lane;
        f32x4 v[8];
#pragma unroll
        for (int j = 0; j < 8; ++j) v[j] = xr[64 * j];
        store_row_bf16((bf16*)(ws + WS_XB) + (size_t)m * D, v, F.lane);
        float ba[16]; row_dot16<true>(v, WT, F.lane, ba);
        f32x4 z0 = *(const f32x4*)(ba2 + 8 * F.lane), z1 = *(const f32x4*)(ba2 + 8 * F.lane + 4);
#pragma unroll
        for (int r = 0; r < 16; ++r) { const f32x4 w0 = *(const LAS f32x4*)(wa2 + r * 512 + 8 * F.lane), w1 = *(const LAS f32x4*)(wa2 + r * 512 + 8 * F.lane + 4); z0 += w0 * ba[r]; z1 += w1 * ba[r]; }
        u32x4 o; o.x = pk2(log_sigmoid_(z0.x) * 0.0625f, log_sigmoid_(z0.y) * 0.0625f); o.y = pk2(log_sigmoid_(z0.z) * 0.0625f, log_sigmoid_(z0.w) * 0.0625f);
        o.z = pk2(log_sigmoid_(z1.x) * 0.0625f, log_sigmoid_(z1.y) * 0.0625f); o.w = pk2(log_sigmoid_(z1.z) * 0.0625f, log_sigmoid_(z1.w) * 0.0625f);
        *(GAS u32x4*)((bf16*)(ws + WS_LAB) + (size_t)m * 512 + 8 * F.lane) = o;
    }
}

template <int MODE, bool XF32, bool OUTF32>
__device__ __forceinline__ void ln_phase(const Args& args, Frame& F, int layer, const float* xin) {
    unsigned char* ws = args.ws;
    const int gw = F.bid * 8 + F.wave, NGW = F.G * 8;
    if (MODE == 0) {
        LAS float* scr = (LAS float*)(F.lds + F.wave * 16384);
        const float* w1 = args.in[I_W1] + (size_t)layer * NE * 2048 * 512; const float* w3 = args.in[I_W3] + (size_t)layer * NE * 2048 * 512; const float* w2 = args.in[I_W2] + (size_t)layer * NE * 512 * 2048;
        constexpr int IA = 16 * 32 * 4, IB = 16 * 8 * 8;
        for (int rep_ = 0; rep_ < ((PROBE_REPCONV & 1) ? 2 : 1); ++rep_)
        wgt_run([&](int it) { TItem t;
            if (it < IA) { const int e = it >> 7, r = it & 127, kb = r >> 2, pn = r & 3;
                t.p0 = w1 + (size_t)e * 2048 * 512 + 128 * pn; t.p1 = w3 + (size_t)e * 2048 * 512 + 128 * pn; t.pitch = 512; t.WT = (bf16*)(ws + WS_W13) + (size_t)e * 1024 * 2048; t.Kdst = 2048; t.k0 = 64 * kb; t.n0 = 256 * pn; return t; }
            const int r0 = it - IA; const int e = r0 >> 6, r = r0 & 63, kb = r >> 3, nb = r & 7;
            t.p0 = w2 + (size_t)e * 512 * 2048 + 256 * nb; t.p1 = t.p0 + 128; t.pitch = 2048; t.WT = (bf16*)(ws + WS_W2T) + (size_t)e * 2048 * 512; t.Kdst = 512; t.k0 = 64 * kb; t.n0 = 256 * nb; return t;
        }, IA + IB, F);
        (void)scr;
        __syncthreads();
        load_w16_T((LAS float*)F.lds, args.in[I_WR], 16, 0, F.tid);
        __syncthreads();
    }
    const float* g = args.in[I_LNG] + (layer * 2 + MODE) * D; const float* bb = args.in[I_LNB] + (layer * 2 + MODE) * D;
    const bf16* tmp = (const bf16*)(ws + WS_TMP);
    const bf16* xbin = (const bf16*)(ws + WS_XB);
    const bf16* ys = (const bf16*)(ws + WS_R2);
    auto ln_row = [&](const int m, f32x4 (&v)[8], const bool wr) {
        float s = 0.f;
        if (XF32) { const GAS f32x4* xr = (const GAS f32x4*)(xin + (size_t)m * D) + F.lane;
#pragma unroll
            for (int j = 0; j < 8; ++j) v[j] = xr[64 * j] * DN_ALPHA; }
        else { const GAS u32x2* xr = (const GAS u32x2*)(xbin + (size_t)m * D) + F.lane;
#pragma unroll
            for (int j = 0; j < 8; ++j) { const u32x2 a = xr[64 * j]; v[j] = (f32x4){bflo(a.x), bfhi(a.x), bflo(a.y), bfhi(a.y)} * DN_ALPHA; } }
        if (MODE == 0) { const GAS u32x2* tr = (const GAS u32x2*)(tmp + (size_t)m * D) + F.lane;
#pragma unroll
            for (int j = 0; j < 8; ++j) { const u32x2 a = tr[64 * j]; v[j] += (f32x4){bflo(a.x), bfhi(a.x), bflo(a.y), bfhi(a.y)}; } }
        else { const GAS u32x2* y0 = (const GAS u32x2*)(ys + (size_t)m * D) + F.lane; const GAS u32x2* y1 = (const GAS u32x2*)(ys + ((size_t)T + m) * D) + F.lane;
#pragma unroll
            for (int j = 0; j < 8; ++j) { const u32x2 a = y0[64 * j], b = y1[64 * j]; f32x4 y; y.x = bflo(a.x) + bflo(b.x); y.y = bfhi(a.x) + bfhi(b.x); y.z = bflo(a.y) + bflo(b.y); y.w = bfhi(a.y) + bfhi(b.y);
                v[j] += y; } }
#pragma unroll
        for (int j = 0; j < 8; ++j) s += (v[j].x + v[j].y) + (v[j].z + v[j].w);
        const float mean = wave_sum(s) * (1.f / D); float s2 = 0.f;
#pragma unroll
        for (int j = 0; j < 8; ++j) { v[j] = v[j] - mean; s2 += (v[j].x * v[j].x + v[j].y * v[j].y) + (v[j].z * v[j].z + v[j].w * v[j].w); }
        const float rstd = 1.f / sqrtf(wave_sum(s2) * (1.f / D) + EPS);
#pragma unroll
        for (int j = 0; j < 8; ++j) { const f32x4 gg = *(const f32x4*)(g + 256 * j + 4 * F.lane), bv = *(const f32x4*)(bb + 256 * j + 4 * F.lane); v[j] = v[j] * rstd * gg + bv; }
        if (OUTF32 && wr) { GAS f32x4* orow = (GAS f32x4*)(args.out + (size_t)m * D) + F.lane;
#pragma unroll
            for (int j = 0; j < 8; ++j) orow[64 * j] = v[j]; }
        if (!OUTF32 && wr) store_row_bf16((bf16*)(ws + WS_XB) + (size_t)m * D, v, F.lane);
    };
    auto route = [&](const int m, const float (&lg)[16], const bool wr) {
            const float* br = args.in[I_BR];
            float aff[16], sel[16];
#pragma unroll
            for (int e = 0; e < 16; ++e) { aff[e] = sigmoidf_(lg[e]); sel[e] = aff[e] + br[e]; }
            float best = -3.0e38f; int bi1 = 0, bi2 = 1; float ba1 = 0.f, ba2_ = 0.f;
#pragma unroll
            for (int gq = 0; gq < 4; ++gq) {
                int i1 = 0; float s1 = sel[4 * gq];
#pragma unroll
                for (int j = 1; j < 4; ++j) if (sel[4 * gq + j] > s1) { s1 = sel[4 * gq + j]; i1 = j; }
                int i2 = -1; float s2v = -3.0e38f;
#pragma unroll
                for (int j = 0; j < 4; ++j) if (j != i1 && sel[4 * gq + j] > s2v) { s2v = sel[4 * gq + j]; i2 = j; }
                const float sc = s1 + s2v;
                float a1 = 0.f, a2 = 0.f;
#pragma unroll
                for (int j = 0; j < 4; ++j) { a1 = (j == i1) ? aff[4 * gq + j] : a1; a2 = (j == i2) ? aff[4 * gq + j] : a2; }
                if (sc > best) { best = sc; bi1 = 4 * gq + i1; bi2 = 4 * gq + i2; ba1 = a1; ba2_ = a2; }
            }
            if (F.lane == 0 && wr) {
                const float inv = 1.0f / (ba1 + ba2_);
                unsigned* cnt = (unsigned*)(F.ctl + CW_CNT) + layer * 16 * 64;
                const unsigned p1 = __hip_atomic_fetch_add(cnt + bi1 * 64, 1u, RLX_AGENT), p2 = __hip_atomic_fetch_add(cnt + bi2 * 64, 1u, RLX_AGENT);
                int* list = (int*)(ws + WS_LIST); float* wl = (float*)(ws + WS_WL);
                list[bi1 * 16384 + p1] = m; wl[bi1 * 16384 + p1] = ba1 * inv;
                list[bi2 * 16384 + p2] = m | (int)0x80000000; wl[bi2 * 16384 + p2] = ba2_ * inv;
            }
    };
    if (MODE == 0) {
        for (int m0 = gw; m0 < T; m0 += 2 * NGW) {
            const bool has1 = m0 + NGW < T; const int m1 = has1 ? m0 + NGW : m0;
            f32x4 v0[8], v1[8];
            ln_row(m0, v0, true); ln_row(m1, v1, has1);
            float lg0[16], lg1[16]; row_dot16x2<false>(v0, v1, (const LAS float*)F.lds, F.lane, lg0, lg1);
            route(m0, lg0, true); route(m1, lg1, has1);
        }
    } else {
        for (int m = gw; m < T; m += NGW) { f32x4 v[8]; ln_row(m, v, true); }
    }
}
__device__ __forceinline__ f32x4 mfma16(bf16x8 a, bf16x8 b, f32x4 c) { return __builtin_amdgcn_mfma_f32_16x16x32_bf16(a, b, c, 0, 0, 0); }
__device__ __forceinline__ bf16x8 lds_frag(const LAS bf16* M, int ld, int r0, int k0, int lane) { return *(const LAS bf16x8*)(M + (r0 + (lane & 15)) * ld + k0 + 8 * (lane >> 4)); }

constexpr int H0_AQ = 0, H0_AF = 1024, H0_AI = 2048, H0_AG = 3072, H0_BQ = 4096, H0_BK = 4608, H0_BV = 5120, H0_BG = 6144;
constexpr int LDK = 72, LDQ = 136;

template <int DV>
__device__ __forceinline__ void stage_vt(LAS bf16* VT, const bf16* V, int ldv, int tid) {
    constexpr int NS = 64 * DV / 512;
    const int e = tid % DV, sq = tid / DV;
    unsigned w[NS / 2];
#pragma unroll
    for (int i = 0; i < NS / 2; ++i) { const unsigned a = V[(size_t)(sq * NS + 2 * i) * ldv + e], b = V[(size_t)(sq * NS + 2 * i + 1) * ldv + e]; w[i] = a | (b << 16); }
#pragma unroll
    for (int i = 0; i < NS / 8; ++i) { u32x4 o; o.x = w[4 * i]; o.y = w[4 * i + 1]; o.z = w[4 * i + 2]; o.w = w[4 * i + 3]; *(LAS u32x4*)(VT + e * LDK + sq * NS + 8 * i) = o; }
}

template <int DV, bool IS_A>
__device__ __forceinline__ void ab_a_unit(const Args& args, Frame& F, int b, int n, int h) {
    unsigned char* ws = args.ws;
    const bf16* h0 = (const bf16*)(ws + WS_R1);
    const bf16* lab = (const bf16*)(ws + WS_LAB);
    const int t0 = b * SEQ + n * 64, tid = F.tid, lane = F.lane, w = F.wave;
    LAS bf16* KT = (LAS bf16*)F.lds;
    LAS bf16* VT = (LAS bf16*)(F.lds + 18432);
    LAS float* part = (LAS float*)(F.lds + 18432 + 36864);
    const int d = tid & 127, tq = tid >> 7;
    float lfv[16], kv[16]; float loc = 0.f;
#pragma unroll
    for (int i = 0; i < 16; ++i) { const size_t row = (size_t)(t0 + 16 * tq + i);
        if (IS_A) { lfv[i] = bf2f(h0[row * N_AB + H0_AF + h * 128 + d]); kv[i] = -expm1f(lfv[i]); }
        else { lfv[i] = bf2f(lab[row * 512 + h * 128 + d]); kv[i] = bf2f(h0[row * N_AB + H0_BK + h * 128 + d]); }
        loc += lfv[i]; }
    part[tq * 128 + d] = loc;
    stage_vt<DV>(VT, h0 + (size_t)t0 * N_AB + (IS_A ? H0_AI + h * 128 : H0_BV + h * 256), N_AB, tid);
    __syncthreads();
    float pre = 0.f, tot = 0.f;
#pragma unroll
    for (int j = 0; j < 4; ++j) { const float p = part[j * 128 + d]; tot += p; pre += (j < tq) ? p : 0.f; }
    { float bc = pre; unsigned wv[8];
#pragma unroll
        for (int i = 0; i < 16; i += 2) { bc += lfv[i]; const float k0 = kv[i] * __expf(tot - bc); bc += lfv[i + 1]; const float k1 = kv[i + 1] * __expf(tot - bc); wv[i >> 1] = pk2(k0, k1); }
        u32x4 o0, o1; o0.x = wv[0]; o0.y = wv[1]; o0.z = wv[2]; o0.w = wv[3]; o1.x = wv[4]; o1.y = wv[5]; o1.z = wv[6]; o1.w = wv[7];
        *(LAS u32x4*)(KT + d * LDK + 16 * tq) = o0; *(LAS u32x4*)(KT + d * LDK + 16 * tq + 8) = o1; }
    if (tq == 0) { float* G = (float*)(ws + (IS_A ? WS_GA : WS_GB)); G[(size_t)((b * NCH + n) * (IS_A ? 8 : 4) + h) * 128 + d] = __expf(tot); }
    __syncthreads();
    bf16* U = (bf16*)(ws + WS_R2) + (IS_A ? (size_t)((b * NCH + n) * 8 + h) * 128 * 128 : (size_t)64 * MiB / 2 + (size_t)((b * NCH + n) * 4 + h) * 256 * 128);
    const bf16x8 a0 = lds_frag(KT, LDK, 16 * w, 0, lane), a1 = lds_frag(KT, LDK, 16 * w, 32, lane);
#pragma unroll 4
    for (int et = 0; et < DV / 16; ++et) {
        f32x4 acc = {0.f, 0.f, 0.f, 0.f};
        acc = mfma16(a0, lds_frag(VT, LDK, 16 * et, 0, lane), acc);
        acc = mfma16(a1, lds_frag(VT, LDK, 16 * et, 32, lane), acc);
        u32x2 o; o.x = pk2(acc[0], acc[1]); o.y = pk2(acc[2], acc[3]);
        *(GAS u32x2*)(U + (size_t)(16 * et + (lane & 15)) * 128 + 16 * w + 4 * (lane >> 4)) = o;
    }
    __syncthreads();
}

__device__ __forceinline__ void ab_scan(const Args& args, Frame& F) {
    unsigned char* ws = args.ws;
    const int NT_A = BATCH * 8 * 128 * 16, NT_B = BATCH * 4 * 256 * 16;
    for (int gt = F.bid * 512 + F.tid; gt < NT_A + NT_B; gt += F.G * 512) {
        const bool isA = gt < NT_A; const int r = isA ? gt : gt - NT_A;
        const int d8 = r & 15; int e, h, b, H, DV;
        if (isA) { e = (r >> 4) & 127; h = (r >> 11) & 7; b = r >> 14; H = 8; DV = 128; } else { e = (r >> 4) & 255; h = (r >> 12) & 3; b = r >> 14; H = 4; DV = 256; }
        bf16* S = (bf16*)(ws + WS_R2) + (isA ? (size_t)0 : (size_t)64 * MiB / 2);
        const float* G = (const float*)(ws + (isA ? WS_GA : WS_GB));
        float st[8];
#pragma unroll
        for (int j = 0; j < 8; ++j) st[j] = 0.f;
#pragma unroll 4
        for (int n = 0; n < NCH; ++n) {
            GAS u32x4* p = (GAS u32x4*)(S + ((size_t)((b * NCH + n) * H + h) * DV + e) * 128 + 8 * d8);
            const float* gp = G + (size_t)((b * NCH + n) * H + h) * 128 + 8 * d8;
            const u32x4 u = *p; const f32x4 g0 = *(const f32x4*)gp, g1 = *(const f32x4*)(gp + 4);
            u32x4 o; o.x = pk2(st[0], st[1]); o.y = pk2(st[2], st[3]); o.z = pk2(st[4], st[5]); o.w = pk2(st[6], st[7]);
            *p = o;
            st[0] = g0.x * st[0] + bflo(u.x); st[1] = g0.y * st[1] + bfhi(u.x); st[2] = g0.z * st[2] + bflo(u.y); st[3] = g0.w * st[3] + bfhi(u.y);
            st[4] = g1.x * st[4] + bflo(u.z); st[5] = g1.y * st[5] + bfhi(u.z); st[6] = g1.z * st[6] + bflo(u.w); st[7] = g1.w * st[7] + bfhi(u.w);
        }
    }
}

template <int DV, bool IS_A>
__device__ __forceinline__ void ab_c_unit(const Args& args, Frame& F, int b, int n, int h) {
    unsigned char* ws = args.ws;
    const bf16* h0 = (const bf16*)(ws + WS_R1);
    const bf16* lab = (const bf16*)(ws + WS_LAB);
    const int t0 = b * SEQ + n * 64, tid = F.tid, lane = F.lane, w = F.wave, r16 = lane & 15, g4 = lane >> 4;
    LAS bf16* Qs = (LAS bf16*)F.lds;
    LAS bf16* Ks = (LAS bf16*)(F.lds + 17408);
    LAS bf16* P = (LAS bf16*)(F.lds + 34816);
    LAS bf16* VT = (LAS bf16*)(F.lds + 44032);
    LAS float* part = (LAS float*)(F.lds + 80896);
    LAS float* red = (LAS float*)(F.lds + 82944);
    const int d = tid & 127, tq = tid >> 7;
    float lfv[16], qv[16], kv[16]; float loc = 0.f;
#pragma unroll
    for (int i = 0; i < 16; ++i) { const size_t row = (size_t)(t0 + 16 * tq + i);
        if (IS_A) { lfv[i] = bf2f(h0[row * N_AB + H0_AF + h * 128 + d]); kv[i] = -expm1f(lfv[i]); qv[i] = bf2f(h0[row * N_AB + H0_AQ + h * 128 + d]); }
        else { lfv[i] = bf2f(lab[row * 512 + h * 128 + d]); kv[i] = bf2f(h0[row * N_AB + H0_BK + h * 128 + d]); qv[i] = bf2f(h0[row * N_AB + H0_BQ + h * 128 + d]); }
        loc += lfv[i]; }
    part[tq * 128 + d] = loc;
    stage_vt<DV>(VT, h0 + (size_t)t0 * N_AB + (IS_A ? H0_AI + h * 128 : H0_BV + h * 256), N_AB, tid);
    __syncthreads();
    { float pre = 0.f;
#pragma unroll
        for (int j = 0; j < 4; ++j) { const float p = part[j * 128 + d]; pre += (j < tq) ? p : 0.f; }
        float bc = pre;
#pragma unroll
        for (int i = 0; i < 16; ++i) { bc += lfv[i]; const int t = 16 * tq + i;
            Qs[t * LDQ + d] = (bf16)f2bf(qv[i] * __expf(bc)); Ks[t * LDQ + d] = (bf16)f2bf(kv[i] * __expf(fminf(-bc, 80.f))); } }
    __syncthreads();
    { const int mi = w >> 1;
#pragma unroll
        for (int q = 0; q < 2; ++q) { const int ni = 2 * (w & 1) + q; f32x4 acc = {0.f, 0.f, 0.f, 0.f};
            if (ni <= mi) {
#pragma unroll
                for (int ks = 0; ks < 4; ++ks) acc = mfma16(lds_frag(Qs, LDQ, 16 * mi, 32 * ks, lane), lds_frag(Ks, LDQ, 16 * ni, 32 * ks, lane), acc); }
            const int s = 16 * ni + r16;
#pragma unroll
            for (int j = 0; j < 4; ++j) { const int t = 16 * mi + 4 * g4 + j; P[t * LDK + s] = (bf16)f2bf((ni <= mi && s <= t) ? acc[j] : 0.f); } } }
    __syncthreads();
    constexpr int NE2 = DV / 32;
    const int mi = w & 3, e0 = (w >> 2) * (DV / 2);
    const bf16* S = (const bf16*)(ws + WS_R2) + (IS_A ? (size_t)((b * NCH + n) * 8 + h) * 128 * 128 : (size_t)64 * MiB / 2 + (size_t)((b * NCH + n) * 4 + h) * 256 * 128);
    f32x4 acc[NE2];
    { const bf16x8 p0 = lds_frag(P, LDK, 16 * mi, 0, lane), p1 = lds_frag(P, LDK, 16 * mi, 32, lane);
        bf16x8 qf[4];
#pragma unroll
        for (int ks = 0; ks < 4; ++ks) qf[ks] = lds_frag(Qs, LDQ, 16 * mi, 32 * ks, lane);
#pragma unroll
        for (int i = 0; i < NE2; ++i) { const int et0 = e0 + 16 * i; f32x4 a = {0.f, 0.f, 0.f, 0.f};
            a = mfma16(p0, lds_frag(VT, LDK, et0, 0, lane), a); a = mfma16(p1, lds_frag(VT, LDK, et0, 32, lane), a);
            if (n > 0) {
#pragma unroll
                for (int ks = 0; ks < 4; ++ks) { const bf16x8 sf = *(const GAS bf16x8*)(S + (size_t)(et0 + r16) * 128 + 32 * ks + 8 * g4); a = mfma16(qf[ks], sf, a); } }
            acc[i] = a; } }
    float ss[4];
#pragma unroll
    for (int j = 0; j < 4; ++j) { float s = 0.f;
#pragma unroll
        for (int i = 0; i < NE2; ++i) s += acc[i][j] * acc[i][j];
        s += __shfl_xor(s, 1); s += __shfl_xor(s, 2); s += __shfl_xor(s, 4); s += __shfl_xor(s, 8); ss[j] = s; }
    if (r16 == 0) {
#pragma unroll
        for (int j = 0; j < 4; ++j) red[w * 16 + 4 * g4 + j] = ss[j]; }
    __syncthreads();
    const float* gn = args.in[IS_A ? I_ANORM : I_BNORM];
    const int gcol = IS_A ? H0_AG + h * 128 : H0_BG + h * 256, ocol = IS_A ? h * 128 : 1024 + h * 256;
    bf16* mixed = (bf16*)(ws + WS_MIX);
#pragma unroll
    for (int j = 0; j < 4; ++j) { const float tot = red[w * 16 + 4 * g4 + j] + red[(w ^ 4) * 16 + 4 * g4 + j]; const float rstd = 1.0f / sqrtf(tot * (1.0f / DV) + EPS);
        const size_t row = (size_t)(t0 + 16 * mi + 4 * g4 + j);
#pragma unroll
        for (int i = 0; i < NE2; ++i) { const int e = e0 + 16 * i + r16; const float gate = bf2f(h0[row * N_AB + gcol + e]);
            mixed[row * D + ocol + e] = (bf16)f2bf(acc[i][j] * rstd * gn[e] * gate); } }
    __syncthreads();
}

__device__ __forceinline__ void ab_phase_a(const Args& args, Frame& F) {
    for (int u = F.bid; u < 3072; u += F.G) {
        if (u < 2048) { const int h = u & 7, n = (u >> 3) & 63, b = u >> 9; ab_a_unit<128, true>(args, F, b, n, h); }
        else { const int v = u - 2048; const int h = v & 3, n = (v >> 2) & 63, b = v >> 8; ab_a_unit<256, false>(args, F, b, n, h); }
    }
}
__device__ __forceinline__ void ab_phase_c(const Args& args, Frame& F) {
    for (int u = F.bid; u < 3072; u += F.G) {
        if (u < 2048) { const int h = u & 7, n = (u >> 3) & 63, b = u >> 9; ab_c_unit<128, true>(args, F, b, n, h); }
        else { const int v = u - 2048; const int h = v & 3, n = (v >> 2) & 63, b = v >> 8; ab_c_unit<256, false>(args, F, b, n, h); }
    }
}
__device__ __forceinline__ int swz128(int r, int c) { return r * 256 + ((((c >> 3) ^ r) & 15) << 4) + (c & 7) * 2; }
__device__ __forceinline__ bf16x8 frag128(const LAS unsigned char* tile, int r0, int k0, int lane) { const int r = r0 + (lane & 15), ch = (k0 >> 3) + (lane >> 4); return *(const LAS bf16x8*)(tile + r * 256 + (((ch ^ r) & 15) << 4)); }
__device__ __forceinline__ bf16x8 tfrag128(const LAS unsigned char* tile, int s0, int c0, int lane) {
    const int r16 = lane & 15, g4 = lane >> 4; const int row = s0 + 8 * g4 + (r16 >> 2), col = c0 + 4 * (r16 & 3);
    const s16x4 lo = __builtin_bit_cast(s16x4, __builtin_amdgcn_ds_read_tr16_b64_v4i16((LAS s16x4*)(tile + swz128(row, col))));
    const s16x4 hi = __builtin_bit_cast(s16x4, __builtin_amdgcn_ds_read_tr16_b64_v4i16((LAS s16x4*)(tile + swz128(row + 4, col))));
    return __builtin_shufflevector(lo, hi, 0, 1, 2, 3, 4, 5, 6, 7);
}
__device__ __forceinline__ void dma_tile128(LAS unsigned char* tile, const bf16* src, size_t pitch, int rows, int wave, int lane) {
    for (int ii = wave; ii < rows / 4; ii += 8) { const int row = 4 * ii + (lane >> 4), ch = ((lane & 15) ^ row) & 15;
        __builtin_amdgcn_global_load_lds((const unsigned*)(src + (size_t)row * pitch + ch * 8), (LAS unsigned*)(tile + ii * 1024), 16, 0, 0); }
}
#define BAR_LDS() do { asm volatile("s_waitcnt lgkmcnt(0)" ::: "memory"); __builtin_amdgcn_s_barrier(); asm volatile("" ::: "memory"); } while (0)
#define BAR_ALL() do { asm volatile("s_waitcnt vmcnt(0) lgkmcnt(0)" ::: "memory"); __builtin_amdgcn_s_barrier(); asm volatile("" ::: "memory"); } while (0)

__device__ __forceinline__ void ab_decode(int u, bool& isA, int& b, int& n, int& h) {
    if (u < 2048) { isA = true; h = u & 7; n = (u >> 3) & 63; b = u >> 9; } else { const int v = u - 2048; isA = false; h = v & 3; n = (v >> 2) & 63; b = v >> 8; }
}
__device__ __forceinline__ void ab_load_raw(const Args& args, int u, int tid, bool need_q, u32x4 (&R)[6]) {
    bool isA; int b, n, h; ab_decode(u, isA, b, n, h);
    const bf16* h0 = (const bf16*)(args.ws + WS_R1); const bf16* lab = (const bf16*)(args.ws + WS_LAB);
    const size_t t0 = (size_t)(b * SEQ + n * 64);
#pragma unroll
    for (int i = 0; i < 2; ++i) { const int cid = tid + 512 * i, row = cid >> 4, ch = cid & 15;
        const bf16* hrow = h0 + (t0 + row) * N_AB + h * 128 + ch * 8;
        R[i] = isA ? *(const GAS u32x4*)(hrow + H0_AF) : *(const GAS u32x4*)(lab + (t0 + row) * 512 + h * 128 + ch * 8);
        if (need_q) R[2 + i] = *(const GAS u32x4*)(hrow + (isA ? H0_AQ : H0_BQ));
        if (!isA) R[4 + i] = *(const GAS u32x4*)(hrow + H0_BK); else R[4 + i] = (u32x4){0u, 0u, 0u, 0u}; }
}
__device__ __forceinline__ void ab_store_raw(LAS unsigned char* LF, LAS unsigned char* Q, LAS unsigned char* K, int tid, bool need_q, bool isA, const u32x4 (&R)[6]) {
#pragma unroll
    for (int i = 0; i < 2; ++i) { const int cid = tid + 512 * i, row = cid >> 4, ch = cid & 15; const int off = row * 256 + (((ch ^ row) & 15) << 4);
        *(LAS u32x4*)(LF + off) = R[i]; if (need_q) *(LAS u32x4*)(Q + off) = R[2 + i]; if (!isA) *(LAS u32x4*)(K + off) = R[4 + i]; }
}

constexpr int C2_LF = 0, C2_Q = 16384, C2_K = 32768, C2_P = 49152, C2_V0 = 58368, C2_S0 = 74752, C2_S1 = 107520, C2_PART = 140288, C2_RED = 142336;
static_assert(C2_RED + 1024 <= LDS_BYTES - 1024, "phase (c) LDS map");

template <bool IS_A>
__device__ __forceinline__ void ab_c_unit2(const Args& args, Frame& F, int b, int n, int h) {
    unsigned char* ws = args.ws; const bf16* h0 = (const bf16*)(ws + WS_R1);
    const int t0 = b * SEQ + n * 64, tid = F.tid, lane = F.lane, w = F.wave, r16 = lane & 15, g4 = lane >> 4;
    LAS unsigned char* LF = F.lds + C2_LF; LAS unsigned char* Q = F.lds + C2_Q; LAS unsigned char* K = F.lds + C2_K;
    LAS bf16* P = (LAS bf16*)(F.lds + C2_P); LAS unsigned char* V0 = F.lds + C2_V0; LAS unsigned char* S0 = F.lds + C2_S0; LAS unsigned char* S1 = F.lds + C2_S1;
    LAS float* part = (LAS float*)(F.lds + C2_PART); LAS float* red = (LAS float*)(F.lds + C2_RED);
    constexpr int DV = IS_A ? 128 : 256;
    const bf16* Sg = (const bf16*)(ws + WS_R2) + (IS_A ? (size_t)((b * NCH + n) * 8 + h) * 128 * 128 : (size_t)64 * MiB / 2 + (size_t)((b * NCH + n) * 4 + h) * 256 * 128);
    const bf16* Vg = h0 + (size_t)t0 * N_AB + (IS_A ? H0_AI + h * 128 : H0_BV + h * 256);
    dma_tile128(V0, Vg, N_AB, 64, w, lane);
    if (n > 0) { dma_tile128(S0, Sg, 128, 128, w, lane); if (!IS_A) dma_tile128(S1, Sg + 128 * 128, 128, 128, w, lane); }
    const int d = tid & 127, tq = tid >> 7;
    float lfv[16]; float loc = 0.f;
#pragma unroll
    for (int i = 0; i < 16; ++i) { lfv[i] = bf2f(*(const LAS bf16*)(LF + swz128(16 * tq + i, d))); loc += lfv[i]; }
    part[tq * 128 + d] = loc;
    BAR_LDS();
    { float pre = 0.f;
#pragma unroll
        for (int j = 0; j < 4; ++j) { const float p = part[j * 128 + d]; pre += (j < tq) ? p : 0.f; }
        float bc = pre;
#pragma unroll
        for (int i = 0; i < 16; ++i) { bc += lfv[i]; const int off = swz128(16 * tq + i, d);
            const float qv = bf2f(*(const LAS bf16*)(Q + off)); const float kv = IS_A ? -expm1f(lfv[i]) : bf2f(*(const LAS bf16*)(K + off));
            *(LAS bf16*)(Q + off) = (bf16)f2bf(qv * __expf(bc)); *(LAS bf16*)(K + off) = (bf16)f2bf(kv * __expf(fminf(-bc, 80.f))); } }
    BAR_LDS();
    if (!IS_A) dma_tile128(LF, Vg + 128, N_AB, 64, w, lane);
    { const int mi = w >> 1;
#pragma unroll
        for (int q2 = 0; q2 < 2; ++q2) { const int ni = 2 * (w & 1) + q2; f32x4 acc = {0.f, 0.f, 0.f, 0.f};
            if (ni <= mi) {
#pragma unroll
                for (int ks = 0; ks < 4; ++ks) acc = mfma16(frag128(K, 16 * ni, 32 * ks, lane), frag128(Q, 16 * mi, 32 * ks, lane), acc); }
            const int t = 16 * mi + r16, s0 = 16 * ni + 4 * g4;
            float pv[4];
#pragma unroll
            for (int j = 0; j < 4; ++j) pv[j] = (ni <= mi && s0 + j <= t) ? acc[j] : 0.f;
            u32x2 o; o.x = pk2(pv[0], pv[1]); o.y = pk2(pv[2], pv[3]);
            *(LAS u32x2*)(P + t * LDK + s0) = o; } }
    const int mi = w & 3, eh = w >> 2;
    constexpr int NH = IS_A ? 1 : 2;
    const int gcol = IS_A ? H0_AG + h * 128 : H0_BG + h * 256, ocol = IS_A ? h * 128 : 1024 + h * 256;
    const size_t row = (size_t)(t0 + 16 * mi + r16);
    u32x2 gwv[NH][4];
#pragma unroll
    for (int hf = 0; hf < NH; ++hf)
#pragma unroll
        for (int i = 0; i < 4; ++i) gwv[hf][i] = *(const GAS u32x2*)(h0 + row * N_AB + gcol + 128 * hf + 64 * eh + 16 * i + 4 * g4);
    BAR_ALL();
    f32x4 acc[NH][4];
    { const bf16x8 p0 = lds_frag(P, LDK, 16 * mi, 0, lane), p1 = lds_frag(P, LDK, 16 * mi, 32, lane);
        bf16x8 qf[4];
#pragma unroll
        for (int ks = 0; ks < 4; ++ks) qf[ks] = frag128(Q, 16 * mi, 32 * ks, lane);
#pragma unroll
        for (int hf = 0; hf < NH; ++hf) { const LAS unsigned char* Vt = hf ? LF : V0; const LAS unsigned char* St = hf ? S1 : S0;
#pragma unroll
            for (int i = 0; i < 4; ++i) { const int e0 = 64 * eh + 16 * i; f32x4 a = {0.f, 0.f, 0.f, 0.f};
                a = mfma16(tfrag128(Vt, 0, e0, lane), p0, a); a = mfma16(tfrag128(Vt, 32, e0, lane), p1, a);
                if (n > 0) {
#pragma unroll
                    for (int ks = 0; ks < 4; ++ks) a = mfma16(frag128(St, e0, 32 * ks, lane), qf[ks], a); }
                acc[hf][i] = a; } } }
    float ss = 0.f;
#pragma unroll
    for (int hf = 0; hf < NH; ++hf)
#pragma unroll
        for (int i = 0; i < 4; ++i)
#pragma unroll
            for (int j = 0; j < 4; ++j) ss += acc[hf][i][j] * acc[hf][i][j];
    ss += __shfl_xor(ss, 16); ss += __shfl_xor(ss, 32);
    if (g4 == 0) red[eh * 64 + 16 * mi + r16] = ss;
    BAR_LDS();
    const float tot = red[16 * mi + r16] + red[64 + 16 * mi + r16]; const float rstd = 1.0f / sqrtf(tot * (1.0f / DV) + EPS);
    const float* gn = args.in[IS_A ? I_ANORM : I_BNORM];
    bf16* mixed = (bf16*)(ws + WS_MIX);
#pragma unroll
    for (int hf = 0; hf < NH; ++hf)
#pragma unroll
        for (int i = 0; i < 4; ++i) { const int e = 128 * hf + 64 * eh + 16 * i + 4 * g4;
            const u32x2 gw = gwv[hf][i]; const f32x4 gg = *(const f32x4*)(gn + e);
            u32x2 o; o.x = pk2(acc[hf][i][0] * rstd * gg.x * bflo(gw.x), acc[hf][i][1] * rstd * gg.y * bfhi(gw.x)); o.y = pk2(acc[hf][i][2] * rstd * gg.z * bflo(gw.y), acc[hf][i][3] * rstd * gg.w * bfhi(gw.y));
            *(GAS u32x2*)(mixed + row * D + ocol + e) = o; }
}

__device__ __forceinline__ void ab_phase_c2(const Args& args, Frame& F) {
    u32x4 R[6];
    int u = F.bid;
    if (u < 3072) ab_load_raw(args, u, F.tid, true, R);
    for (; u < 3072; u += F.G) {
        bool isA; int b, n, h; ab_decode(u, isA, b, n, h);
        BAR_ALL();
        ab_store_raw(F.lds + C2_LF, F.lds + C2_Q, F.lds + C2_K, F.tid, true, isA, R);
        if (u + F.G < 3072) ab_load_raw(args, u + F.G, F.tid, true, R);
        BAR_LDS();
        if (isA) ab_c_unit2<true>(args, F, b, n, h); else ab_c_unit2<false>(args, F, b, n, h);
    }
    BAR_ALL();
}

constexpr int A2_LF = 0, A2_K = 16384, A2_KT = 32768, A2_V0 = 51200, A2_V1 = 67584, A2_PART = 83968;
template <bool IS_A>
__device__ __forceinline__ void ab_a_unit2(const Args& args, Frame& F, int b, int n, int h) {
    unsigned char* ws = args.ws; const bf16* h0 = (const bf16*)(ws + WS_R1);
    const int t0 = b * SEQ + n * 64, tid = F.tid, lane = F.lane, w = F.wave;
    LAS unsigned char* LF = F.lds + A2_LF; LAS unsigned char* K = F.lds + A2_K; LAS bf16* KT = (LAS bf16*)(F.lds + A2_KT);
    LAS unsigned char* V0 = F.lds + A2_V0; LAS unsigned char* V1 = F.lds + A2_V1; LAS float* part = (LAS float*)(F.lds + A2_PART);
    constexpr int DV = IS_A ? 128 : 256;
    const bf16* Vg = h0 + (size_t)t0 * N_AB + (IS_A ? H0_AI + h * 128 : H0_BV + h * 256);
    dma_tile128(V0, Vg, N_AB, 64, w, lane);
    if (!IS_A) dma_tile128(V1, Vg + 128, N_AB, 64, w, lane);
    const int d = tid & 127, tq = tid >> 7;
    float lfv[16], kv[16]; float loc = 0.f;
#pragma unroll
    for (int i = 0; i < 16; ++i) { const int off = swz128(16 * tq + i, d); lfv[i] = bf2f(*(const LAS bf16*)(LF + off)); kv[i] = IS_A ? -expm1f(lfv[i]) : bf2f(*(const LAS bf16*)(K + off)); loc += lfv[i]; }
    part[tq * 128 + d] = loc;
    BAR_LDS();
    float pre = 0.f, tot = 0.f;
#pragma unroll
    for (int j = 0; j < 4; ++j) { const float p = part[j * 128 + d]; tot += p; pre += (j < tq) ? p : 0.f; }
    { float bc = pre; unsigned wv[8];
#pragma unroll
        for (int i = 0; i < 16; i += 2) { bc += lfv[i]; const float k0 = kv[i] * __expf(tot - bc); bc += lfv[i + 1]; const float k1 = kv[i + 1] * __expf(tot - bc); wv[i >> 1] = pk2(k0, k1); }
        u32x4 o0, o1; o0.x = wv[0]; o0.y = wv[1]; o0.z = wv[2]; o0.w = wv[3]; o1.x = wv[4]; o1.y = wv[5]; o1.z = wv[6]; o1.w = wv[7];
        *(LAS u32x4*)(KT + d * LDK + 16 * tq) = o0; *(LAS u32x4*)(KT + d * LDK + 16 * tq + 8) = o1; }
    if (tq == 0) { float* G = (float*)(ws + (IS_A ? WS_GA : WS_GB)); G[(size_t)((b * NCH + n) * (IS_A ? 8 : 4) + h) * 128 + d] = __expf(tot); }
    BAR_ALL();
    bf16* U = (bf16*)(ws + WS_R2) + (IS_A ? (size_t)((b * NCH + n) * 8 + h) * 128 * 128 : (size_t)64 * MiB / 2 + (size_t)((b * NCH + n) * 4 + h) * 256 * 128);
    const bf16x8 a0 = lds_frag(KT, LDK, 16 * w, 0, lane), a1 = lds_frag(KT, LDK, 16 * w, 32, lane);
#pragma unroll 4
    for (int et = 0; et < DV / 16; ++et) { const LAS unsigned char* Vt = (et < 8) ? V0 : V1; const int c0 = (et & 7) * 16;
        f32x4 acc = {0.f, 0.f, 0.f, 0.f};
        acc = mfma16(a0, tfrag128(Vt, 0, c0, lane), acc);
        acc = mfma16(a1, tfrag128(Vt, 32, c0, lane), acc);
        u32x2 o; o.x = pk2(acc[0], acc[1]); o.y = pk2(acc[2], acc[3]);
        *(GAS u32x2*)(U + (size_t)(16 * et + (lane & 15)) * 128 + 16 * w + 4 * (lane >> 4)) = o; }
}
__device__ __forceinline__ void ab_phase_a2(const Args& args, Frame& F) {
    u32x4 R[6];
    int u = F.bid;
    if (u < 3072) ab_load_raw(args, u, F.tid, false, R);
    for (; u < 3072; u += F.G) {
        bool isA; int b, n, h; ab_decode(u, isA, b, n, h);
        BAR_ALL();
        ab_store_raw(F.lds + A2_LF, F.lds + A2_LF, F.lds + A2_K, F.tid, false, isA, R);
        if (u + F.G < 3072) ab_load_raw(args, u + F.G, F.tid, false, R);
        BAR_LDS();
        if (isA) ab_a_unit2<true>(args, F, b, n, h); else ab_a_unit2<false>(args, F, b, n, h);
    }
    BAR_ALL();
}
#ifndef PROBE_SKIP
#define PROBE_SKIP 0
#endif
constexpr int H1_CQ = 0, H1_CKV = 1024, H1_IQ = 1280, H1_DQ = 2304, H1_DK = 2816, H1_DV = 3328, H1_DOG = 4352;
constexpr int SM_IK = 0, SM_IW = 64, SM_DI = 80, SM_DF = 84;
constexpr size_t SCORES_PER_BATCH = (size_t)4096 * 64 * 65 / 2;
__device__ __forceinline__ size_t score_row_off(int t) { const size_t c = (size_t)(t >> 6), r = (size_t)(t & 63); return 2048 * c * (c + 1) + 64 * r * (c + 1); }

__device__ __forceinline__ void dsa_prep_rows(const Args& args, Frame& F) {
    unsigned char* ws = args.ws; const bf16* h1 = (const bf16*)(ws + WS_R1); bf16* ckvn = (bf16*)(ws + WS_CKVN);
    const float* g = args.in[I_CKVG];
    const int gw = F.bid * 8 + F.wave, NGW = F.G * 8;
    for (int m = gw; m < T; m += NGW) {
        const u32x2 v = *(const GAS u32x2*)(h1 + (size_t)m * N_CD + H1_CKV + 4 * F.lane);
        const float a = bflo(v.x), b = bfhi(v.x), c = bflo(v.y), d = bfhi(v.y);
        const float ss = wave_sum(a * a + b * b + c * c + d * d); const float rs = 1.0f / sqrtf(ss * (1.0f / 256.f) + EPS);
        const f32x4 gg = *(const f32x4*)(g + 4 * F.lane);
        u32x2 o; o.x = pk2(a * rs * gg.x, b * rs * gg.y); o.y = pk2(c * rs * gg.z, d * rs * gg.w);
        *(GAS u32x2*)(ckvn + (size_t)m * 256 + 4 * F.lane) = o;
    }
}

__device__ __forceinline__ void dsa_indexer(const Args& args, Frame& F) {
    unsigned char* ws = args.ws; const bf16* h1 = (const bf16*)(ws + WS_R1); const float* small = (const float*)(ws + WS_SMALL);
    float* scores = (float*)(ws + WS_R2);
    LAS bf16* KS = (LAS bf16*)F.lds;
    const int lane = F.lane, w = F.wave, r16 = lane & 15, g4 = lane >> 4;
    const int u_lo = (int)((long)F.bid * (4 * 272) / F.G), u_hi = (int)((long)(F.bid + 1) * (4 * 272) / F.G);
    int u = u_lo;
    while (u < u_hi) {
        const int b = u / 272; int v = u % 272; int qt = 0;
        { int p = 0; while ((p + 1) * (p + 2) <= v) ++p; v -= p * (p + 1); if (v < p + 1) { qt = 2 * p; } else { qt = 2 * p + 1; v -= p + 1; } }
        const int seg0 = v; const int nsq = (qt >> 1) + 1;
        int nseg = nsq - seg0; if (nseg > u_hi - u) nseg = u_hi - u;
        const int q0 = qt * 128;
        const int tq = q0 + 16 * w + r16; const size_t qrow = (size_t)(b * SEQ + tq);
        bf16x8 qf[16][2]; float wv[16];
#pragma unroll
        for (int hh = 0; hh < 16; ++hh) {
#pragma unroll
            for (int ks = 0; ks < 2; ++ks) qf[hh][ks] = *(const GAS bf16x8*)(h1 + qrow * N_CD + H1_IQ + hh * 64 + ks * 32 + 8 * g4);
            wv[hh] = small[qrow * 128 + SM_IW + hh] * 0.25f; }
        const size_t rowbase = (size_t)b * SCORES_PER_BATCH + score_row_off(tq);
        const int rowlen = 64 * ((tq >> 6) + 1);
#pragma unroll 1
        for (int sg = 0; sg < nseg; ++sg) {
            const int s0 = (seg0 + sg) * 256;
            __syncthreads();
#pragma unroll 2
            for (int i = F.tid; i < 256 * 16; i += 512) { const int s = i >> 4, c4 = (i & 15) * 4; const f32x4 kv = *(const f32x4*)(small + (size_t)(b * SEQ + s0 + s) * 128 + SM_IK + c4);
                u32x2 o; o.x = pk2(kv.x, kv.y); o.y = pk2(kv.z, kv.w); *(LAS u32x2*)(KS + s * LDK + c4) = o; }
            __syncthreads();
#pragma unroll 1
            for (int kt = 0; kt < 16; ++kt) {
                if (s0 + 16 * kt > q0 + 16 * w + 15) break;
                const bf16x8 k0 = lds_frag(KS, LDK, 16 * kt, 0, lane), k1 = lds_frag(KS, LDK, 16 * kt, 32, lane);
                f32x4 sc = {0.f, 0.f, 0.f, 0.f};
#pragma unroll
                for (int hh = 0; hh < 16; ++hh) { f32x4 a = {0.f, 0.f, 0.f, 0.f}; a = mfma16(k0, qf[hh][0], a); a = mfma16(k1, qf[hh][1], a);
#pragma unroll
                    for (int j = 0; j < 4; ++j) sc[j] += wv[hh] * fmaxf(a[j], 0.f); }
                const int sk = s0 + 16 * kt + 4 * g4;
                if (sk < rowlen) *(GAS f32x4*)(scores + rowbase + sk) = sc;
            }
        }
        u += nseg;
    }
}

#ifndef PROBE_TOPK_NOHIST
#define PROBE_TOPK_NOHIST 0
#endif
#ifndef PROBE_TOPK_NOEMIT
#define PROBE_TOPK_NOEMIT 0
#endif
template <int NB>
__device__ __forceinline__ void topk_scan(LAS unsigned* hist, int lane, int need, int& bin, int& above, int& cnt) {
    unsigned c[NB]; unsigned tot = 0u;
#pragma unroll
    for (int q = 0; q < NB / 4; ++q) { const u32x4 v = *(const LAS u32x4*)(hist + NB * lane + 4 * q); c[4 * q] = v.x; c[4 * q + 1] = v.y; c[4 * q + 2] = v.z; c[4 * q + 3] = v.w; tot += (v.x + v.y) + (v.z + v.w); }
#pragma unroll
    for (int q = 0; q < NB / 4; ++q) *(LAS u32x4*)(hist + NB * lane + 4 * q) = (u32x4){0u, 0u, 0u, 0u};
    unsigned inc = tot;
#pragma unroll
    for (int o = 1; o < 64; o <<= 1) { const unsigned u = __shfl_down(inc, o); if (lane + o < 64) inc += u; }
    unsigned run = inc - tot; int fb = -1; unsigned fa = 0u, fc = 0u;
#pragma unroll
    for (int jj = NB - 1; jj >= 0; --jj) { const unsigned cj = c[jj]; const bool hit = (run < (unsigned)need) && (run + cj >= (unsigned)need); fb = hit ? jj : fb; fa = hit ? run : fa; fc = hit ? cj : fc; run += cj; }
    const unsigned long long m = __ballot(fb >= 0); const int L = (int)__builtin_ctzll(m);
    bin = __shfl(NB * lane + fb, L); above = (int)__shfl(fa, L); cnt = (int)__shfl(fc, L);
}
__device__ __forceinline__ void topk_keys16(const float* sr, int t, int lane, int c, unsigned (&key)[16]) {
#pragma unroll
    for (int j = 0; j < 16; ++j) { const int i = 16 * c + j; const int s = 64 * i + lane; unsigned k = 0u;
        if (64 * i <= t) { const unsigned bits = __builtin_bit_cast(unsigned, sr[s]); k = (bits & 0x80000000u) ? ~bits : (bits | 0x80000000u); if (s > t) k = 0u; }
        key[j] = k; }
}
__device__ __forceinline__ void topk_row(const float* sr, int t, int lane, LAS unsigned* hist, unsigned short* out) {
    const int nchunk = (t >> 10) + 1;
    int bin, above, cnt; unsigned tau; int need_eq = 0x7fffffff;
#if PROBE_TOPK_NOHIST
    tau = 0xC0000000u; if (false) {
#endif
#pragma unroll 1
    for (int c = 0; c < nchunk; ++c) { unsigned key[16]; topk_keys16(sr, t, lane, c, key);
#pragma unroll
        for (int j = 0; j < 16; ++j) __hip_atomic_fetch_add(hist + (key[j] >> 21), 1u, __ATOMIC_RELAXED, __HIP_MEMORY_SCOPE_WORKGROUP); }
    topk_scan<32>(hist, lane, 256, bin, above, cnt);
    tau = (unsigned)bin << 21; int need = 256 - above;
    if (need != cnt) {
        const unsigned p1 = (unsigned)bin;
#pragma unroll 1
        for (int c = 0; c < nchunk; ++c) { unsigned key[16]; topk_keys16(sr, t, lane, c, key);
#pragma unroll
            for (int j = 0; j < 16; ++j) if ((key[j] >> 21) == p1) __hip_atomic_fetch_add(hist + ((key[j] >> 10) & 2047u), 1u, __ATOMIC_RELAXED, __HIP_MEMORY_SCOPE_WORKGROUP); }
        topk_scan<32>(hist, lane, need, bin, above, cnt);
        tau |= (unsigned)bin << 10; need -= above;
        if (need != cnt) {
            const unsigned p2 = tau >> 10;
#pragma unroll 1
            for (int c = 0; c < nchunk; ++c) { unsigned key[16]; topk_keys16(sr, t, lane, c, key);
#pragma unroll
                for (int j = 0; j < 16; ++j) if ((key[j] >> 10) == p2) __hip_atomic_fetch_add(hist + (key[j] & 1023u), 1u, __ATOMIC_RELAXED, __HIP_MEMORY_SCOPE_WORKGROUP); }
            topk_scan<16>(hist, lane, need, bin, above, cnt);
            tau |= (unsigned)bin; need_eq = need - above;
        }
    }
#if PROBE_TOPK_NOHIST
    }
#endif
    int pos = 0, eqseen = 0;
    if (PROBE_TOPK_NOEMIT) return;
    const unsigned long long lt_mask = (1ull << lane) - 1ull;
#pragma unroll 1
    for (int c = 0; c < nchunk; ++c) { unsigned key[16]; topk_keys16(sr, t, lane, c, key);
#pragma unroll
        for (int j = 0; j < 16; ++j) {
            const bool gt = key[j] > tau, eq = key[j] == tau;
            const unsigned long long meq = __ballot(eq);
            const bool take = gt || (eq && (eqseen + __builtin_popcountll(meq & lt_mask) < need_eq));
            const unsigned long long mt = __ballot(take);
            if (take && (!PROBE_TOPK_NOHIST || pos + __builtin_popcountll(mt & lt_mask) < 256)) out[pos + __builtin_popcountll(mt & lt_mask)] = (unsigned short)(64 * (16 * c + j) + lane);
            pos += __builtin_popcountll(mt); eqseen += __builtin_popcountll(meq);
        } }
}
__device__ __forceinline__ bool topk_row_fast(const float* sr, int t, int lane, LAS unsigned* hist, LAS unsigned* memb, unsigned short* out) {
    const int nchunk = (t >> 10) + 1;
    float v[64];
#pragma unroll
    for (int c = 0; c < 4; ++c) {
        if (c < nchunk) {
#pragma unroll
            for (int j = 0; j < 16; ++j) { const int i = 16 * c + j; float x = -INFINITY; if (64 * i <= t) x = sr[64 * i + lane]; v[i] = x; }
        } else {
#pragma unroll
            for (int j = 0; j < 16; ++j) v[16 * c + j] = -INFINITY;
        }
    }
    float lo = v[0], hi = v[0];
#pragma unroll
    for (int o = 1; o < 64; o <<= 1) { lo = fminf(lo, __shfl_xor(lo, o)); hi = fmaxf(hi, __shfl_xor(hi, o)); }
    const float dd = hi - lo; lo -= 0.75f * dd; hi += 0.75f * dd;
    const float inv = (hi > lo) ? 2047.5f / (hi - lo) : 0.f;
#define TOPK_BIN(x, s) (((s) <= t) ? (int)fminf(fmaxf(((x) - lo) * inv, 0.f), 2047.f) : -1)
#pragma unroll
    for (int c = 0; c < 4; ++c) if (c < nchunk) {
#pragma unroll
        for (int j = 0; j < 16; ++j) { const int i = 16 * c + j; const int b = TOPK_BIN(v[i], 64 * i + lane); if (b >= 0) __hip_atomic_fetch_add(hist + b, 1u, __ATOMIC_RELAXED, __HIP_MEMORY_SCOPE_WORKGROUP); }
    }
    int B, above, cnt;
    topk_scan<32>(hist, lane, 256, B, above, cnt);
    if (cnt > 64) return false;
    const int need2 = 256 - above;
    const unsigned long long lt_mask = (1ull << lane) - 1ull;
    int pos = 0, nm = 0;
#pragma unroll
    for (int c = 0; c < 4; ++c) if (c < nchunk) {
#pragma unroll
        for (int j = 0; j < 16; ++j) { const int i = 16 * c + j; const int s = 64 * i + lane; const int b = TOPK_BIN(v[i], s);
            const unsigned long long mg = __ballot(b > B);
            if (b > B) out[pos + __builtin_popcountll(mg & lt_mask)] = (unsigned short)s;
            pos += __builtin_popcountll(mg);
            const unsigned long long me = __ballot(b == B);
            if (me != 0ull) { if (b == B) { const int slot = nm + __builtin_popcountll(me & lt_mask); const unsigned bits = __builtin_bit_cast(unsigned, v[i]);
                    memb[slot] = (bits & 0x80000000u) ? ~bits : (bits | 0x80000000u); memb[64 + slot] = (unsigned)s; }
                nm += __builtin_popcountll(me); }
        }
    }
#undef TOPK_BIN
    const unsigned mk = (lane < nm) ? memb[lane] : 0u, mi = (lane < nm) ? memb[64 + lane] : 0xffffffffu;
    int rank = 0;
    for (int q = 0; q < nm; ++q) { const unsigned kq = __builtin_amdgcn_readlane(mk, q), iq = __builtin_amdgcn_readlane(mi, q); rank += (kq > mk || (kq == mk && iq < mi)) ? 1 : 0; }
    if (lane < nm && rank < need2) out[above + rank] = (unsigned short)mi;
    return true;
}
__device__ __forceinline__ void dsa_topk(const Args& args, Frame& F) {
    unsigned char* ws = args.ws; const float* scores = (const float*)(ws + WS_R2); unsigned short* idx = (unsigned short*)(ws + WS_IDX);
    const int lane = F.lane; const int gw = F.bid * 8 + F.wave, NGW = F.G * 8;
    LAS unsigned* hist = (LAS unsigned*)(F.lds + F.wave * 8192);
    LAS unsigned* memb = (LAS unsigned*)(F.lds + 65536 + F.wave * 512);
    __syncthreads();
    for (int i = lane; i < 2048; i += 64) hist[i] = 0u;
    for (int rr = gw; rr < T; rr += NGW) {
        const int b = rr >> 12, jj = rr & 4095; const int t = (jj & 1) ? 4095 - (jj >> 1) : (jj >> 1); const int row = b * SEQ + t;
        unsigned short* out = idx + (size_t)row * 256;
        if (t < 256) {
#pragma unroll
            for (int i = 0; i < 4; ++i) { const int s = 64 * i + lane; out[s] = (unsigned short)(s <= t ? s : 0); }
            continue;
        }
        const float* sr = scores + (size_t)b * SCORES_PER_BATCH + score_row_off(t);
        if (!topk_row_fast(sr, t, lane, hist, memb, out)) topk_row(sr, t, lane, hist, out);
    }
}

#ifndef PROBE_ONETILE
#define PROBE_ONETILE 0
#endif
#ifndef PROBE_NOSTORE
#define PROBE_NOSTORE 0
#endif
#ifndef PROBE_NOGATHER
#define PROBE_NOGATHER 0
#endif
__device__ __forceinline__ void pl16(float& a, float& b) { asm volatile("s_nop 1\n\tv_permlane16_swap_b32 %0, %1" : "+v"(a), "+v"(b)); }
__device__ __forceinline__ void pl32(float& a, float& b) { asm volatile("s_nop 1\n\tv_permlane32_swap_b32 %0, %1" : "+v"(a), "+v"(b)); }
__device__ __forceinline__ float xmax16(float x) { float a = x, b = x; pl16(a, b); return fmaxf(a, b); }
__device__ __forceinline__ float xmax32(float x) { float a = x, b = x; pl32(a, b); return fmaxf(a, b); }
__device__ __forceinline__ float xadd16(float x) { float a = x, b = x; pl16(a, b); return a + b; }
__device__ __forceinline__ float xadd32(float x) { float a = x, b = x; pl32(a, b); return a + b; }
__device__ __forceinline__ s16x4 lds_tr(const LAS bf16* p) { return __builtin_bit_cast(s16x4, __builtin_amdgcn_ds_read_tr16_b64_v4i16((LAS s16x4*)p)); }
__device__ __forceinline__ void dsa_attention(const Args& args, Frame& F, bf16* obuf) {
    unsigned char* ws = args.ws; const bf16* ckvn = (const bf16*)(ws + WS_CKVN); bf16* qo = (bf16*)args.out; const unsigned short* idx = (const unsigned short*)(ws + WS_IDX);
    const int lane = F.lane, w = F.wave, r16 = lane & 15, g4 = lane >> 4;
    constexpr int LDV = 264;
    LAS bf16* KV = (LAS bf16*)(F.lds + w * (32 * LDV * 2));
    LAS float* rel = (LAS float*)(F.lds + 8 * 32 * LDV * 2);
    LAS unsigned char* bkt = (LAS unsigned char*)(F.lds + 8 * 32 * LDV * 2 + 1024);
    LAS unsigned char* bkey = (LAS unsigned char*)(F.lds + 8 * 32 * LDV * 2 + 1024 + 128 + w * 256);
    __syncthreads();
    if (F.tid < 256) rel[F.tid] = args.in[I_REL][F.tid];
    if (F.tid < 128) { const int n = F.tid; int bk = n; if (n >= 16) { int lg = 16 + (int)(__logf((float)n / 16.0f) / 2.0794415416798357f * 16.0f); bk = lg < 31 ? lg : 31; } bkt[n] = (unsigned char)bk; }
    __syncthreads();
    const bool g8 = (F.G & 7) == 0 && F.G >= 8;
    const int nwb = g8 ? (F.G / 8) * 2 * 8 : F.G * 8;
    const int wib = g8 ? ((F.bid >> 3) * 2 + (F.bid & 1)) * 8 + w : F.bid * 8 + w;
    const int bsel = g8 ? ((F.bid & 7) >> 1) : -1;
    const int nrows = g8 ? SEQ : T;
    const LAS bf16* tr_lo = KV + (4 * g4 + (r16 >> 2)) * LDV + 4 * (r16 & 3);
    const LAS bf16* tr_hi = tr_lo + 16 * LDV;
    for (int rr0 = wib; rr0 < nrows; rr0 += nwb) {
        const int b = g8 ? bsel : (rr0 >> 12); const int jj = rr0 & 4095; const int t = (jj & 1) ? 4095 - (jj >> 1) : (jj >> 1); const int row = b * SEQ + t;
        const int nsel = t < 255 ? t + 1 : 256;
        int myidx[4];
#pragma unroll
        for (int i = 0; i < 4; ++i) myidx[i] = idx[(size_t)row * 256 + 64 * i + lane];
#pragma unroll
        for (int i = 0; i < 4; ++i) { int dist = t - myidx[i]; dist = dist < 0 ? 0 : dist; bkey[64 * i + lane] = (dist < 128) ? bkt[dist] : (unsigned char)31; }
        bf16x8 qf[8];
#pragma unroll
        for (int ks = 0; ks < 8; ++ks) qf[ks] = *(const GAS bf16x8*)(qo + (size_t)row * D + (r16 & 7) * 256 + 32 * ks + 8 * g4);
        f32x4 o[16];
#pragma unroll
        for (int i = 0; i < 16; ++i) o[i] = (f32x4){0.f, 0.f, 0.f, 0.f};
        float mrun = -3.0e38f, lrun = 0.f;
        const int ntile = PROBE_ONETILE ? 1 : ((nsel + 31) >> 5);
        const bf16* kvb = ckvn + (size_t)(b * SEQ) * 256 + 8 * (lane & 31);
        u32x4 G[16];
        {
#pragma unroll
            for (int i = 0; i < 16; ++i) { const int kidx = __shfl(myidx[0], 2 * i + (lane >> 5)); G[i] = *(const GAS u32x4*)(kvb + (size_t)(PROBE_NOGATHER ? (kidx & 31) : kidx) * 256); } }
#pragma unroll 1
        for (int kt = 0; kt < ntile; ++kt) {
            const int src = (kt & 1) * 32;
            const int ireg = (kt >> 1) == 0 ? myidx[0] : (kt >> 1) == 1 ? myidx[1] : (kt >> 1) == 2 ? myidx[2] : myidx[3];
#pragma unroll
            for (int i = 0; i < 16; ++i) *(LAS u32x4*)(KV + (2 * i + (lane >> 5)) * LDV + 8 * (lane & 31)) = G[i];
            if (kt + 1 < ntile) {
                const int src2 = ((kt + 1) & 1) * 32;
                const int ireg2 = ((kt + 1) >> 1) == 0 ? myidx[0] : ((kt + 1) >> 1) == 1 ? myidx[1] : ((kt + 1) >> 1) == 2 ? myidx[2] : myidx[3];
#pragma unroll
                for (int i = 0; i < 16; ++i) { const int kidx = __shfl(ireg2, src2 + 2 * i + (lane >> 5)); G[i] = *(const GAS u32x4*)(kvb + (size_t)(PROBE_NOGATHER ? (kidx & 31) : kidx) * 256); }
            }
            f32x4 s0 = {0.f, 0.f, 0.f, 0.f}, s1 = {0.f, 0.f, 0.f, 0.f};
#pragma unroll
            for (int ks = 0; ks < 8; ++ks) { s0 = mfma16(lds_frag(KV, LDV, 0, 32 * ks, lane), qf[ks], s0); s1 = mfma16(lds_frag(KV, LDV, 16, 32 * ks, lane), qf[ks], s1); }
            float lg[8];
#pragma unroll
            for (int j = 0; j < 8; ++j) { const int kl = (j < 4 ? 4 * g4 + j : 16 + 4 * g4 + (j - 4)); const int kk = 32 * kt + kl; const int bk = (int)bkey[kk];
                const float v = (j < 4 ? s0[j] : s1[j - 4]) + rel[bk * 8 + (r16 & 7)];
                lg[j] = (kk < nsel) ? v : -3.0e38f; }
            float mx = lg[0];
#pragma unroll
            for (int j = 1; j < 8; ++j) mx = fmaxf(mx, lg[j]);
            mx = xmax16(mx); mx = xmax32(mx);
            const bool grow = mx > mrun;
            const float mnew = grow ? mx : mrun; const float corr = grow ? __expf(mrun - mnew) : 1.0f;
            float p[8], ps = 0.f;
#pragma unroll
            for (int j = 0; j < 8; ++j) { p[j] = (lg[j] > -1.0e38f) ? __expf(lg[j] - mnew) : 0.f; ps += p[j]; }
            ps = xadd16(ps); ps = xadd32(ps);
            lrun = lrun * corr + ps; mrun = mnew;
            bf16x8 pf; { u32x4 pw; pw.x = pk2(p[0], p[1]); pw.y = pk2(p[2], p[3]); pw.z = pk2(p[4], p[5]); pw.w = pk2(p[6], p[7]); pf = __builtin_bit_cast(bf16x8, pw); }
            if (__any(grow)) {
                float cr[4];
#pragma unroll
                for (int j = 0; j < 4; ++j) cr[j] = __shfl(corr, (4 * g4 + j) & 7);
#pragma unroll
                for (int nt = 0; nt < 16; ++nt)
#pragma unroll
                    for (int j = 0; j < 4; ++j) o[nt][j] *= cr[j];
            }
#pragma unroll
            for (int nt = 0; nt < 16; ++nt) {
                const s16x4 lo = lds_tr(tr_lo + 16 * nt), hi = lds_tr(tr_hi + 16 * nt);
                bf16x8 vf; vf[0] = lo[0]; vf[1] = lo[1]; vf[2] = lo[2]; vf[3] = lo[3]; vf[4] = hi[0]; vf[5] = hi[1]; vf[6] = hi[2]; vf[7] = hi[3];
                o[nt] = mfma16(pf, vf, o[nt]);
            }
        }
        float linv[4];
#pragma unroll
        for (int j = 0; j < 4; ++j) linv[j] = 1.0f / __shfl(lrun, (4 * g4 + j) & 7);
        if (g4 < 2 && !PROBE_NOSTORE) {
#pragma unroll
            for (int nt = 0; nt < 16; ++nt)
#pragma unroll
                for (int j = 0; j < 4; ++j) obuf[(size_t)row * D + (4 * g4 + j) * 256 + 16 * nt + r16] = (bf16)f2bf(o[nt][j] * linv[j]);
        }
    }
}
__device__ __forceinline__ float ml_wave_incl_scan_add(float v, int lane) {
#pragma unroll
    for (int o = 1; o < 64; o <<= 1) { const float u = __shfl_up(v, o); if (lane >= o) v += u; }
    return v;
}
__device__ __forceinline__ float ml_wave_incl_scan_max(float v, int lane) {
#pragma unroll
    for (int o = 1; o < 64; o <<= 1) { const float u = __shfl_up(v, o); if (lane >= o) v = fmaxf(v, u); }
    return v;
}
constexpr size_t ML_A = 0, ML_BL = 4096, ML_MP = 8192;

__device__ __forceinline__ void ml_conv16(const bf16* h1, int b, int s0, int col, const float (&w4)[4], float (&out)[16]) {
    float x[19];
#pragma unroll
    for (int i = 0; i < 19; ++i) { const int s = s0 - 3 + i; x[i] = (s >= 0) ? bf2f(h1[(size_t)(b * SEQ + s) * N_CD + col]) : 0.f; }
#pragma unroll
    for (int i = 0; i < 16; ++i) { const float c = w4[0] * x[i] + w4[1] * x[i + 1] + w4[2] * x[i + 2] + w4[3] * x[i + 3]; out[i] = siluf_(c); }
}

__device__ __forceinline__ void ml_a_unit(const Args& args, Frame& F, int b, int n, int h) {
    unsigned char* ws = args.ws; const bf16* h1 = (const bf16*)(ws + WS_R1); const float* small = (const float*)(ws + WS_SMALL);
    const int t0 = b * SEQ + n * 64, tid = F.tid, lane = F.lane, w = F.wave;
    LAS bf16* KT = (LAS bf16*)F.lds;
    LAS bf16* VT = (LAS bf16*)(F.lds + 18432);
    LAS float* part = (LAS float*)(F.lds + 55296);
    LAS float* uu = (LAS float*)(F.lds + 57344);
    const float* gb = args.in[I_GATEB];
    if (w == 0) {
        const float ig = small[(size_t)(t0 + lane) * 128 + SM_DI + h] + gb[h];
        const float lf = log_sigmoid_(small[(size_t)(t0 + lane) * 128 + SM_DF + h] + gb[4 + h]);
        const float bc = ml_wave_incl_scan_add(lf, lane); const float bl = __shfl(bc, 63);
        const float lu = bl - bc + ig; const float a = wave_max(lu);
        uu[lane] = __expf(lu - a);
        if (lane == 0) { float* sc = (float*)(ws + WS_MLSC); const int si = (b * NCH + n) * 4 + h; sc[ML_A / 4 + si] = a; sc[ML_BL / 4 + si] = bl; }
    }
    stage_vt<256>(VT, h1 + (size_t)t0 * N_CD + H1_DV + h * 256, N_CD, tid);
    __syncthreads();
    const int d = tid & 127, tq = tid >> 7;
    { const float* cw = args.in[I_CONVW]; const int ch = 512 + h * 128 + d; float w4[4];
#pragma unroll
        for (int j = 0; j < 4; ++j) w4[j] = cw[j * 1024 + ch];
        float kc[16]; ml_conv16(h1, b, n * 64 + 16 * tq, H1_DK + h * 128 + d, w4, kc);
        float loc = 0.f; unsigned wv[8];
#pragma unroll
        for (int i = 0; i < 16; i += 2) { const float k0 = kc[i] * 0.08838834764831845f * uu[16 * tq + i], k1 = kc[i + 1] * 0.08838834764831845f * uu[16 * tq + i + 1]; loc += k0 + k1; wv[i >> 1] = pk2(k0, k1); }
        u32x4 o0, o1; o0.x = wv[0]; o0.y = wv[1]; o0.z = wv[2]; o0.w = wv[3]; o1.x = wv[4]; o1.y = wv[5]; o1.z = wv[6]; o1.w = wv[7];
        *(LAS u32x4*)(KT + d * LDK + 16 * tq) = o0; *(LAS u32x4*)(KT + d * LDK + 16 * tq + 8) = o1;
        part[tq * 128 + d] = loc; }
    __syncthreads();
    if (tid < 128) { float* nl = (float*)(ws + WS_MLN); nl[(size_t)((b * NCH + n) * 4 + h) * 128 + tid] = part[tid] + part[128 + tid] + part[256 + tid] + part[384 + tid]; }
    bf16* U = (bf16*)(ws + WS_R2) + (size_t)((b * NCH + n) * 4 + h) * 256 * 128;
    const bf16x8 a0 = lds_frag(KT, LDK, 16 * w, 0, lane), a1 = lds_frag(KT, LDK, 16 * w, 32, lane);
#pragma unroll 4
    for (int et = 0; et < 16; ++et) {
        f32x4 acc = {0.f, 0.f, 0.f, 0.f};
        acc = mfma16(a0, lds_frag(VT, LDK, 16 * et, 0, lane), acc);
        acc = mfma16(a1, lds_frag(VT, LDK, 16 * et, 32, lane), acc);
        u32x2 o; o.x = pk2(acc[0], acc[1]); o.y = pk2(acc[2], acc[3]);
        *(GAS u32x2*)(U + (size_t)(16 * et + (lane & 15)) * 128 + 16 * w + 4 * (lane >> 4)) = o;
    }
    __syncthreads();
}

__device__ __forceinline__ void ml_scan(const Args& args, Frame& F) {
    unsigned char* ws = args.ws; float* sc = (float*)(ws + WS_MLSC);
    const int NTC = BATCH * 4 * 256 * 16, NTN = BATCH * 4 * 128;
    for (int gt = 64 * (F.wave * F.G + F.bid) + F.lane; gt < NTC + NTN; gt += F.G * 512) {
        if (gt < NTC) {
            const int d8 = gt & 15, e = (gt >> 4) & 255, h = (gt >> 12) & 3, b = gt >> 14;
            bf16* S = (bf16*)args.out + (size_t)33554432;
            float st[8]; float m = 0.f;
#pragma unroll
            for (int j = 0; j < 8; ++j) st[j] = 0.f;
#pragma unroll 4
            for (int n = 0; n < NCH; ++n) { const int si = (b * NCH + n) * 4 + h;
                GAS u32x4* p = (GAS u32x4*)(S + ((size_t)si * 256 + e) * 128 + 8 * d8);
                const u32x4 u = *p; const float a = sc[ML_A / 4 + si], bl = sc[ML_BL / 4 + si];
                u32x4 o; o.x = pk2(st[0], st[1]); o.y = pk2(st[2], st[3]); o.z = pk2(st[4], st[5]); o.w = pk2(st[6], st[7]);
                *p = o;
                const float mn = fmaxf(bl + m, a); const float dec = __expf(bl + m - mn), inw = __expf(a - mn); m = mn;
                st[0] = dec * st[0] + inw * bflo(u.x); st[1] = dec * st[1] + inw * bfhi(u.x); st[2] = dec * st[2] + inw * bflo(u.y); st[3] = dec * st[3] + inw * bfhi(u.y);
                st[4] = dec * st[4] + inw * bflo(u.z); st[5] = dec * st[5] + inw * bfhi(u.z); st[6] = dec * st[6] + inw * bflo(u.w); st[7] = dec * st[7] + inw * bfhi(u.w);
            }
        } else {
            const int r = gt - NTC; const int d = r & 127, h = (r >> 7) & 3, b = r >> 9;
            float* nl = (float*)(ws + WS_MLN); float st = 0.f, m = 0.f;
            for (int n = 0; n < NCH; ++n) { const int si = (b * NCH + n) * 4 + h;
                const float u = nl[(size_t)si * 128 + d]; const float a = sc[ML_A / 4 + si], bl = sc[ML_BL / 4 + si];
                nl[(size_t)si * 128 + d] = st; if (d == 0) sc[ML_MP / 4 + si] = m;
                const float mn = fmaxf(bl + m, a); st = __expf(bl + m - mn) * st + __expf(a - mn) * u; m = mn; }
        }
    }
}

__device__ __forceinline__ void ml_c_unit(const Args& args, Frame& F, int b, int n, int h) {
    unsigned char* ws = args.ws; const bf16* h1 = (const bf16*)(ws + WS_R1); const float* small = (const float*)(ws + WS_SMALL);
    const int t0 = b * SEQ + n * 64, tid = F.tid, lane = F.lane, w = F.wave, r16 = lane & 15, g4 = lane >> 4;
    LAS bf16* Qs = (LAS bf16*)F.lds;
    LAS bf16* Ks = (LAS bf16*)(F.lds + 17408);
    LAS bf16* P = (LAS bf16*)(F.lds + 34816);
    LAS bf16* VT = (LAS bf16*)(F.lds + 44032);
    LAS bf16* NT = (LAS bf16*)(F.lds + 80896);
    LAS float* red = (LAS float*)(F.lds + 85248);
    LAS float* bcs = (LAS float*)(F.lds + 85760);
    LAS float* igs = (LAS float*)(F.lds + 86016);
    LAS float* mts = (LAS float*)(F.lds + 86272);
    LAS float* psum = (LAS float*)(F.lds + 86528);
    const float* gb = args.in[I_GATEB];
    const int si = (b * NCH + n) * 4 + h;
    const float mprev = ((const float*)(ws + WS_MLSC))[ML_MP / 4 + si];
    if (w == 0) {
        const float ig = small[(size_t)(t0 + lane) * 128 + SM_DI + h] + gb[h];
        const float lf = log_sigmoid_(small[(size_t)(t0 + lane) * 128 + SM_DF + h] + gb[4 + h]);
        const float bc = ml_wave_incl_scan_add(lf, lane);
        const float gmb = ig - bc;
        const float pm = ml_wave_incl_scan_max(gmb, lane);
        bcs[lane] = bc; igs[lane] = gmb; mts[lane] = bc + fmaxf(pm, mprev);
    }
    if (w == 1) { const float* nl = (const float*)(ws + WS_MLN);
        for (int i = lane; i < 16 * LDQ; i += 64) { const int rr = i / LDQ, cc = i % LDQ; NT[i] = (bf16)((rr == 0 && cc < 128) ? f2bf(nl[(size_t)si * 128 + cc]) : 0u); } }
    stage_vt<256>(VT, h1 + (size_t)t0 * N_CD + H1_DV + h * 256, N_CD, tid);
    { const int d = tid & 127, tq = tid >> 7; const float* cw = args.in[I_CONVW]; float w4[4]; float qc[16];
#pragma unroll
        for (int j = 0; j < 4; ++j) w4[j] = cw[j * 1024 + h * 128 + d];
        ml_conv16(h1, b, n * 64 + 16 * tq, H1_DQ + h * 128 + d, w4, qc);
#pragma unroll
        for (int i = 0; i < 16; ++i) Qs[(16 * tq + i) * LDQ + d] = (bf16)f2bf(qc[i]);
#pragma unroll
        for (int j = 0; j < 4; ++j) w4[j] = cw[j * 1024 + 512 + h * 128 + d];
        ml_conv16(h1, b, n * 64 + 16 * tq, H1_DK + h * 128 + d, w4, qc);
#pragma unroll
        for (int i = 0; i < 16; ++i) Ks[(16 * tq + i) * LDQ + d] = (bf16)f2bf(qc[i] * 0.08838834764831845f); }
    __syncthreads();
    { const int mi = w >> 1; float rs[4] = {0.f, 0.f, 0.f, 0.f};
#pragma unroll
        for (int q = 0; q < 2; ++q) { const int ni = 2 * (w & 1) + q; f32x4 acc = {0.f, 0.f, 0.f, 0.f};
            if (ni <= mi) {
#pragma unroll
                for (int ks = 0; ks < 4; ++ks) acc = mfma16(lds_frag(Qs, LDQ, 16 * mi, 32 * ks, lane), lds_frag(Ks, LDQ, 16 * ni, 32 * ks, lane), acc); }
            const int s = 16 * ni + r16; const float gs = igs[s];
#pragma unroll
            for (int j = 0; j < 4; ++j) { const int t = 16 * mi + 4 * g4 + j; float v = 0.f;
                if (ni <= mi && s <= t) v = acc[j] * __expf(bcs[t] + gs - mts[t]);
                const unsigned vb = f2bf(v); P[t * LDK + s] = (bf16)vb; rs[j] += v; } }
#pragma unroll
        for (int j = 0; j < 4; ++j) { float s = rs[j]; s += __shfl_xor(s, 1); s += __shfl_xor(s, 2); s += __shfl_xor(s, 4); s += __shfl_xor(s, 8); if (r16 == 0) psum[(w & 1) * 64 + 16 * mi + 4 * g4 + j] = s; } }
    __syncthreads();
    const int mi = w & 3, e0 = (w >> 2) * 128;
    const bf16* C = (const bf16*)(ws + WS_R2) + (size_t)si * 256 * 128;
    f32x4 acc1[8], acc2[8]; f32x4 accn = {0.f, 0.f, 0.f, 0.f};
    { const bf16x8 p0 = lds_frag(P, LDK, 16 * mi, 0, lane), p1 = lds_frag(P, LDK, 16 * mi, 32, lane);
        bf16x8 qf[4];
#pragma unroll
        for (int ks = 0; ks < 4; ++ks) qf[ks] = lds_frag(Qs, LDQ, 16 * mi, 32 * ks, lane);
#pragma unroll
        for (int ks = 0; ks < 4; ++ks) accn = mfma16(qf[ks], lds_frag(NT, LDQ, 0, 32 * ks, lane), accn);
#pragma unroll
        for (int i = 0; i < 8; ++i) { const int et0 = e0 + 16 * i; f32x4 a = {0.f, 0.f, 0.f, 0.f}, c = {0.f, 0.f, 0.f, 0.f};
            a = mfma16(p0, lds_frag(VT, LDK, et0, 0, lane), a); a = mfma16(p1, lds_frag(VT, LDK, et0, 32, lane), a);
            if (n > 0) {
#pragma unroll
                for (int ks = 0; ks < 4; ++ks) { const bf16x8 sf = *(const GAS bf16x8*)(C + (size_t)(et0 + r16) * 128 + 32 * ks + 8 * g4); c = mfma16(qf[ks], sf, c); } }
            acc1[i] = a; acc2[i] = c; } }
    float hv[8][4]; float ss[4];
#pragma unroll
    for (int j = 0; j < 4; ++j) { const int t = 16 * mi + 4 * g4 + j;
        const float mt = mts[t]; const float wi = __expf(bcs[t] + mprev - mt);
        const float qn_inter = __shfl(accn[j], 16 * g4);
        const float qn = psum[t] + psum[64 + t] + wi * qn_inter;
        const float den = fmaxf(fabsf(qn), __expf(-mt)); const float inv = 1.0f / den; float s = 0.f;
#pragma unroll
        for (int i = 0; i < 8; ++i) { const float v = (acc1[i][j] + wi * acc2[i][j]) * inv; hv[i][j] = v; s += v * v; }
        s += __shfl_xor(s, 1); s += __shfl_xor(s, 2); s += __shfl_xor(s, 4); s += __shfl_xor(s, 8); ss[j] = s; }
    if (r16 == 0) {
#pragma unroll
        for (int j = 0; j < 4; ++j) red[w * 16 + 4 * g4 + j] = ss[j]; }
    __syncthreads();
    const float* gn = args.in[I_DNORM]; bf16* mixed = (bf16*)(ws + WS_MIX);
#pragma unroll
    for (int j = 0; j < 4; ++j) { const float tot = red[w * 16 + 4 * g4 + j] + red[(w ^ 4) * 16 + 4 * g4 + j]; const float rstd = 1.0f / sqrtf(tot * (1.0f / 256.f) + EPS);
        const size_t row = (size_t)(t0 + 16 * mi + 4 * g4 + j);
#pragma unroll
        for (int i = 0; i < 8; ++i) { const int e = e0 + 16 * i + r16; const float gate = bf2f(h1[row * N_CD + H1_DOG + h * 256 + e]);
            mixed[row * D + 1024 + h * 256 + e] = (bf16)f2bf(hv[i][j] * rstd * gn[e] * gate); } }
    __syncthreads();
}
__device__ __forceinline__ void ml_phase_a(const Args& args, Frame& F) { for (int u = F.bid; u < 1024; u += F.G) { const int h = u & 3, n = (u >> 2) & 63, b = u >> 8; ml_a_unit(args, F, b, n, h); } }
__device__ __forceinline__ void ml_phase_c(const Args& args, Frame& F) { for (int u = F.bid; u < 1024; u += F.G) { const int h = u & 3, n = (u >> 2) & 63, b = u >> 8; ml_c_unit(args, F, b, n, h); } }
__device__ __forceinline__ void ml_load_raw(const Args& args, int u, int tid, bool need_q, u32x4 (&R)[6]) {
    const int h = u & 3, n = (u >> 2) & 63, b = u >> 8;
    const bf16* h1 = (const bf16*)(args.ws + WS_R1); const size_t t0 = (size_t)(b * SEQ + n * 64);
#pragma unroll
    for (int i = 0; i < 2; ++i) { const int cid = tid + 512 * i, row = cid >> 4, ch = cid & 15; const bf16* hrow = h1 + (t0 + row) * N_CD + h * 128 + ch * 8;
        if (need_q) R[i] = *(const GAS u32x4*)(hrow + H1_DQ); R[2 + i] = *(const GAS u32x4*)(hrow + H1_DK); }
    R[4] = (u32x4){0u, 0u, 0u, 0u}; R[5] = (u32x4){0u, 0u, 0u, 0u};
    if (tid < 48 && n > 0) { const int row = tid >> 4, ch = tid & 15; const bf16* hrow = h1 + (t0 - 3 + row) * N_CD + h * 128 + ch * 8;
        if (need_q) R[4] = *(const GAS u32x4*)(hrow + H1_DQ); R[5] = *(const GAS u32x4*)(hrow + H1_DK); }
}
__device__ __forceinline__ void ml_store_raw(LAS unsigned char* Q, LAS unsigned char* K, LAS unsigned char* HQ, LAS unsigned char* HK, int tid, bool need_q, const u32x4 (&R)[6]) {
#pragma unroll
    for (int i = 0; i < 2; ++i) { const int cid = tid + 512 * i, row = cid >> 4, ch = cid & 15; const int off = row * 256 + (((ch ^ row) & 15) << 4);
        if (need_q) *(LAS u32x4*)(Q + off) = R[i]; *(LAS u32x4*)(K + off) = R[2 + i]; }
    if (tid < 48) { if (need_q) *(LAS u32x4*)(HQ + tid * 16) = R[4]; *(LAS u32x4*)(HK + tid * 16) = R[5]; }
}
__device__ __forceinline__ void ml_conv16_lds(const LAS unsigned char* X, const LAS unsigned char* HX, int tq, int d, const float (&w4)[4], float (&out)[16]) {
    float x[19];
#pragma unroll
    for (int i = 0; i < 19; ++i) { const int r = 16 * tq - 3 + i; x[i] = (r >= 0) ? bf2f(*(const LAS bf16*)(X + swz128(r, d))) : bf2f(*(const LAS bf16*)(HX + ((r + 3) * 128 + d) * 2)); }
#pragma unroll
    for (int i = 0; i < 16; ++i) { const float c = w4[0] * x[i] + w4[1] * x[i + 1] + w4[2] * x[i + 2] + w4[3] * x[i + 3]; out[i] = siluf_(c); }
}
constexpr int M2_Q = 0, M2_K = 16384, M2_P = 32768, M2_V0 = 41984, M2_V1 = 58368, M2_S0 = 74752, M2_S1 = 107520, M2_NT = 140288, M2_HQ = 140544, M2_HK = 141312,
              M2_BCS = 142080, M2_IGS = 142336, M2_MTS = 142592, M2_RED = 142848, M2_PSUM = 143360;
static_assert(M2_NT + 4096 <= LDS_BYTES - 1024 && M2_PSUM + 512 <= LDS_BYTES - 1024, "mlstm (c) LDS map");

__device__ __forceinline__ void ml_c_unit2(const Args& args, Frame& F, int b, int n, int h) {
    unsigned char* ws = args.ws; const bf16* h1 = (const bf16*)(ws + WS_R1); const float* small = (const float*)(ws + WS_SMALL);
    const int t0 = b * SEQ + n * 64, tid = F.tid, lane = F.lane, w = F.wave, r16 = lane & 15, g4 = lane >> 4;
    LAS unsigned char* Q = F.lds + M2_Q; LAS unsigned char* K = F.lds + M2_K; LAS bf16* P = (LAS bf16*)(F.lds + M2_P);
    LAS unsigned char* V0 = F.lds + M2_V0; LAS unsigned char* V1 = F.lds + M2_V1; LAS unsigned char* S0 = F.lds + M2_S0; LAS unsigned char* S1 = F.lds + M2_S1;
    LAS unsigned char* NT = F.lds + M2_NT; LAS unsigned char* HQ = F.lds + M2_HQ; LAS unsigned char* HK = F.lds + M2_HK;
    LAS float* bcs = (LAS float*)(F.lds + M2_BCS); LAS float* igs = (LAS float*)(F.lds + M2_IGS); LAS float* mts = (LAS float*)(F.lds + M2_MTS);
    LAS float* red = (LAS float*)(F.lds + M2_RED); LAS float* psum = (LAS float*)(F.lds + M2_PSUM);
    const float* gb = args.in[I_GATEB];
    const int si = (b * NCH + n) * 4 + h;
    const float mprev = ((const float*)(ws + WS_MLSC))[ML_MP / 4 + si];
    const bf16* Cg = (const bf16*)args.out + (size_t)33554432 + (size_t)si * 256 * 128;
    const bf16* Vg = h1 + (size_t)t0 * N_CD + H1_DV + h * 256;
    dma_tile128(V0, Vg, N_CD, 64, w, lane); dma_tile128(V1, Vg + 128, N_CD, 64, w, lane);
    if (n > 0) { dma_tile128(S0, Cg, 128, 128, w, lane); dma_tile128(S1, Cg + 128 * 128, 128, 128, w, lane); }
    if (w == 0) {
        const float ig = small[(size_t)(t0 + lane) * 128 + SM_DI + h] + gb[h];
        const float lf = log_sigmoid_(small[(size_t)(t0 + lane) * 128 + SM_DF + h] + gb[4 + h]);
        const float bc = ml_wave_incl_scan_add(lf, lane);
        const float gmb = ig - bc;
        const float pm = ml_wave_incl_scan_max(gmb, lane);
        bcs[lane] = bc; igs[lane] = gmb; mts[lane] = bc + fmaxf(pm, mprev);
    }
    if (w == 1) { const float* nl = (const float*)(ws + WS_MLN); const f32x2 nv = *(const f32x2*)(nl + (size_t)si * 128 + 2 * lane); *(LAS unsigned*)(NT + 4 * lane) = pk2(nv.x, nv.y); }
    { const int d = tid & 127, tq = tid >> 7; const float* cw = args.in[I_CONVW]; float w4[4]; float qc[16], kc[16];
#pragma unroll
        for (int j = 0; j < 4; ++j) w4[j] = cw[j * 1024 + h * 128 + d];
        ml_conv16_lds(Q, HQ, tq, d, w4, qc);
#pragma unroll
        for (int j = 0; j < 4; ++j) w4[j] = cw[j * 1024 + 512 + h * 128 + d];
        ml_conv16_lds(K, HK, tq, d, w4, kc);
        BAR_LDS();
#pragma unroll
        for (int i = 0; i < 16; ++i) { const int off = swz128(16 * tq + i, d); *(LAS bf16*)(Q + off) = (bf16)f2bf(qc[i]); *(LAS bf16*)(K + off) = (bf16)f2bf(kc[i] * 0.08838834764831845f); } }
    BAR_LDS();
    { const int mi = w >> 1; float rs = 0.f; const int t = 16 * mi + r16; const float bt = bcs[t] - mts[t];
#pragma unroll
        for (int q2 = 0; q2 < 2; ++q2) { const int ni = 2 * (w & 1) + q2; f32x4 acc = {0.f, 0.f, 0.f, 0.f};
            if (ni <= mi) {
#pragma unroll
                for (int ks = 0; ks < 4; ++ks) acc = mfma16(frag128(K, 16 * ni, 32 * ks, lane), frag128(Q, 16 * mi, 32 * ks, lane), acc); }
            const int s0 = 16 * ni + 4 * g4; float pv[4];
#pragma unroll
            for (int j = 0; j < 4; ++j) { float v = 0.f; if (ni <= mi && s0 + j <= t) v = acc[j] * __expf(bt + igs[s0 + j]); pv[j] = v; rs += v; }
            u32x2 o; o.x = pk2(pv[0], pv[1]); o.y = pk2(pv[2], pv[3]);
            *(LAS u32x2*)(P + t * LDK + s0) = o; }
        rs += __shfl_xor(rs, 16); rs += __shfl_xor(rs, 32);
        if (g4 == 0) psum[(w & 1) * 64 + t] = rs; }
    BAR_ALL();
    const int mi = w & 3, eh = w >> 2; const int t = 16 * mi + r16;
    f32x4 acc1[2][4], acc2[2][4]; f32x4 accn = {0.f, 0.f, 0.f, 0.f};
    { const bf16x8 p0 = lds_frag(P, LDK, 16 * mi, 0, lane), p1 = lds_frag(P, LDK, 16 * mi, 32, lane);
        bf16x8 qf[4];
#pragma unroll
        for (int ks = 0; ks < 4; ++ks) qf[ks] = frag128(Q, 16 * mi, 32 * ks, lane);
#pragma unroll
        for (int ks = 0; ks < 4; ++ks) accn = mfma16(frag128(NT, 0, 32 * ks, lane), qf[ks], accn);
#pragma unroll
        for (int hf = 0; hf < 2; ++hf) { const LAS unsigned char* Vt = hf ? V1 : V0; const LAS unsigned char* St = hf ? S1 : S0;
#pragma unroll
            for (int i = 0; i < 4; ++i) { const int e0 = 64 * eh + 16 * i; f32x4 a = {0.f, 0.f, 0.f, 0.f}, c = {0.f, 0.f, 0.f, 0.f};
                a = mfma16(tfrag128(Vt, 0, e0, lane), p0, a); a = mfma16(tfrag128(Vt, 32, e0, lane), p1, a);
                if (n > 0) {
#pragma unroll
                    for (int ks = 0; ks < 4; ++ks) c = mfma16(frag128(St, e0, 32 * ks, lane), qf[ks], c); }
                acc1[hf][i] = a; acc2[hf][i] = c; } } }
    const float mt = mts[t]; const float wi = __expf(bcs[t] + mprev - mt);
    const float qn_inter = __shfl(accn[0], r16);
    const float qn = psum[t] + psum[64 + t] + wi * qn_inter;
    const float inv = 1.0f / fmaxf(fabsf(qn), __expf(-mt));
    float ss = 0.f;
#pragma unroll
    for (int hf = 0; hf < 2; ++hf)
#pragma unroll
        for (int i = 0; i < 4; ++i)
#pragma unroll
            for (int j = 0; j < 4; ++j) { const float v = (acc1[hf][i][j] + wi * acc2[hf][i][j]) * inv; acc1[hf][i][j] = v; ss += v * v; }
    ss += __shfl_xor(ss, 16); ss += __shfl_xor(ss, 32);
    if (g4 == 0) red[eh * 64 + t] = ss;
    BAR_LDS();
    const float tot = red[t] + red[64 + t]; const float rstd = 1.0f / sqrtf(tot * (1.0f / 256.f) + EPS);
    const float* gn = args.in[I_DNORM]; bf16* mixed = (bf16*)(ws + WS_MIX);
    const size_t row = (size_t)(t0 + t);
#pragma unroll
    for (int hf = 0; hf < 2; ++hf)
#pragma unroll
        for (int i = 0; i < 4; ++i) { const int e = 128 * hf + 64 * eh + 16 * i + 4 * g4;
            const u32x2 gw = *(const GAS u32x2*)(h1 + row * N_CD + H1_DOG + h * 256 + e); const f32x4 gg = *(const f32x4*)(gn + e);
            u32x2 o; o.x = pk2(acc1[hf][i][0] * rstd * gg.x * bflo(gw.x), acc1[hf][i][1] * rstd * gg.y * bfhi(gw.x)); o.y = pk2(acc1[hf][i][2] * rstd * gg.z * bflo(gw.y), acc1[hf][i][3] * rstd * gg.w * bfhi(gw.y));
            *(GAS u32x2*)(mixed + row * D + 1024 + h * 256 + e) = o; }
}
__device__ __forceinline__ void ml_phase_c2(const Args& args, Frame& F) {
    u32x4 R[6];
    int u = F.bid;
    if (u < 1024) ml_load_raw(args, u, F.tid, true, R);
    for (; u < 1024; u += F.G) {
        const int h = u & 3, n = (u >> 2) & 63, b = u >> 8;
        BAR_ALL();
        ml_store_raw(F.lds + M2_Q, F.lds + M2_K, F.lds + M2_HQ, F.lds + M2_HK, F.tid, true, R);
        if (u + F.G < 1024) ml_load_raw(args, u + F.G, F.tid, true, R);
        BAR_LDS();
        ml_c_unit2(args, F, b, n, h);
    }
    BAR_ALL();
}

constexpr int MA_K = 0, MA_KT = 16384, MA_V0 = 34816, MA_V1 = 51200, MA_HK = 67584, MA_PART = 68352, MA_UU = 70400;
__device__ __forceinline__ void ml_a_unit2(const Args& args, Frame& F, int b, int n, int h) {
    unsigned char* ws = args.ws; const bf16* h1 = (const bf16*)(ws + WS_R1); const float* small = (const float*)(ws + WS_SMALL);
    const int t0 = b * SEQ + n * 64, tid = F.tid, lane = F.lane, w = F.wave;
    LAS unsigned char* K = F.lds + MA_K; LAS bf16* KT = (LAS bf16*)(F.lds + MA_KT); LAS unsigned char* V0 = F.lds + MA_V0; LAS unsigned char* V1 = F.lds + MA_V1;
    LAS unsigned char* HK = F.lds + MA_HK; LAS float* part = (LAS float*)(F.lds + MA_PART); LAS float* uu = (LAS float*)(F.lds + MA_UU);
    const float* gb = args.in[I_GATEB];
    const bf16* Vg = h1 + (size_t)t0 * N_CD + H1_DV + h * 256;
    dma_tile128(V0, Vg, N_CD, 64, w, lane); dma_tile128(V1, Vg + 128, N_CD, 64, w, lane);
    if (w == 0) {
        const float ig = small[(size_t)(t0 + lane) * 128 + SM_DI + h] + gb[h];
        const float lf = log_sigmoid_(small[(size_t)(t0 + lane) * 128 + SM_DF + h] + gb[4 + h]);
        const float bc = ml_wave_incl_scan_add(lf, lane); const float bl = __shfl(bc, 63);
        const float lu = bl - bc + ig; const float a = wave_max(lu);
        uu[lane] = __expf(lu - a);
        if (lane == 0) { float* sc = (float*)(ws + WS_MLSC); const int si = (b * NCH + n) * 4 + h; sc[ML_A / 4 + si] = a; sc[ML_BL / 4 + si] = bl; }
    }
    const int d = tid & 127, tq = tid >> 7;
    float kc[16];
    { const float* cw = args.in[I_CONVW]; float w4[4];
#pragma unroll
        for (int j = 0; j < 4; ++j) w4[j] = cw[j * 1024 + 512 + h * 128 + d];
        ml_conv16_lds(K, HK, tq, d, w4, kc); }
    BAR_LDS();
    { float loc = 0.f; unsigned wv[8];
#pragma unroll
        for (int i = 0; i < 16; i += 2) { const float k0 = kc[i] * 0.08838834764831845f * uu[16 * tq + i], k1 = kc[i + 1] * 0.08838834764831845f * uu[16 * tq + i + 1]; loc += k0 + k1; wv[i >> 1] = pk2(k0, k1); }
        u32x4 o0, o1; o0.x = wv[0]; o0.y = wv[1]; o0.z = wv[2]; o0.w = wv[3]; o1.x = wv[4]; o1.y = wv[5]; o1.z = wv[6]; o1.w = wv[7];
        *(LAS u32x4*)(KT + d * LDK + 16 * tq) = o0; *(LAS u32x4*)(KT + d * LDK + 16 * tq + 8) = o1;
        part[tq * 128 + d] = loc; }
    BAR_ALL();
    if (tid < 128) { float* nl = (float*)(ws + WS_MLN); nl[(size_t)((b * NCH + n) * 4 + h) * 128 + tid] = part[tid] + part[128 + tid] + part[256 + tid] + part[384 + tid]; }
    bf16* U = (bf16*)args.out + (size_t)33554432 + (size_t)((b * NCH + n) * 4 + h) * 256 * 128;
    const bf16x8 a0 = lds_frag(KT, LDK, 16 * w, 0, lane), a1 = lds_frag(KT, LDK, 16 * w, 32, lane);
#pragma unroll 4
    for (int et = 0; et < 16; ++et) { const LAS unsigned char* Vt = (et < 8) ? V0 : V1; const int c0 = (et & 7) * 16;
        f32x4 acc = {0.f, 0.f, 0.f, 0.f};
        acc = mfma16(a0, tfrag128(Vt, 0, c0, lane), acc);
        acc = mfma16(a1, tfrag128(Vt, 32, c0, lane), acc);
        u32x2 o; o.x = pk2(acc[0], acc[1]); o.y = pk2(acc[2], acc[3]);
        *(GAS u32x2*)(U + (size_t)(16 * et + (lane & 15)) * 128 + 16 * w + 4 * (lane >> 4)) = o; }
}
__device__ __forceinline__ void ml_phase_a2(const Args& args, Frame& F) {
    u32x4 R[6];
    int u = F.bid;
    if (u < 1024) ml_load_raw(args, u, F.tid, false, R);
    for (; u < 1024; u += F.G) {
        const int h = u & 3, n = (u >> 2) & 63, b = u >> 8;
        BAR_ALL();
        ml_store_raw(F.lds + MA_K, F.lds + MA_K, F.lds + MA_HK, F.lds + MA_HK, F.tid, false, R);
        if (u + F.G < 1024) ml_load_raw(args, u + F.G, F.tid, false, R);
        BAR_LDS();
        ml_a_unit2(args, F, b, n, h);
    }
    BAR_ALL();
}
constexpr int N_PHASES = 20;
constexpr int LDS_TAB_OFF = LDS_BYTES - 1024, LDS_BARW_OFF = LDS_BYTES - 512;

__device__ __forceinline__ void moe_table(Frame& F, int layer) {
    volatile LAS int* tab = (volatile LAS int*)(F.lds + LDS_TAB_OFF);
    __syncthreads();
    if (F.tid == 0) { int acc = 0;
        for (int e = 0; e < 16; ++e) { const int c = (int)__hip_atomic_load((unsigned*)(F.ctl + CW_CNT) + (layer * 16 + e) * 64, RLX_AGENT); tab[e] = acc; tab[32 + e] = c; acc += (c + 255) >> 8; }
        tab[16] = acc; }
    __syncthreads();
}

__global__ void __launch_bounds__(512, 2) hybrid_fwd(Args args) {
    extern __shared__ __attribute__((aligned(16))) unsigned char lds_raw[];
    Frame F;
    F.lds = (LAS unsigned char*)lds_raw;
    F.tid = threadIdx.x; F.lane = F.tid & 63; F.wave = __builtin_amdgcn_readfirstlane(F.tid >> 6);
    F.G = gridDim.x; F.bid = blockIdx.x;
    unsigned char* ws = args.ws;
    F.ctl = (gu32*)(ws + WS_CTL);
    if (F.tid < 256) ((LAS unsigned*)(F.lds + LDS_TAB_OFF))[F.tid] = 0u;
    __syncthreads();
    XcdBarrier bar; bar.bar = (unsigned*)(F.ctl + CW_BAR); bar.x = 0; bar.st = nullptr;
    if (args.use_bar) bar = xcd_barrier_post((unsigned*)(F.ctl + CW_BAR), (volatile LAS unsigned*)(F.lds + LDS_BARW_OFF));
    const int lo = args.ph_lo, hi = args.ph_hi;
#ifndef PH_MASK
#define PH_MASK 0xffffffu
#endif
#define IN(k) (((PH_MASK >> (k)) & 1u) && lo <= (k) && (k) < hi)
#define SEAM(k) do { if (IN(k) && IN((k) + 1)) xcd_barrier(bar); } while (0)
#ifndef DIAG_OC_MODE
#define DIAG_OC_MODE 0
#endif
#ifndef DIAG_OC_SCALE
#define DIAG_OC_SCALE 0.f
#endif
#ifndef PROBE_SKIP
#define PROBE_SKIP 0
#endif
#ifndef PROBE_DUP
#define PROBE_DUP -1
#endif
#define REP(k) for (int _r = 0; _r < ((PROBE_DUP == (k)) ? 2 : 1); ++_r)
#define REPBAR(k) do { if (PROBE_DUP == (k) && _r == 0) xcd_barrier(bar); } while (0)
    const volatile LAS int* tab = (const volatile LAS int*)(F.lds + LDS_TAB_OFF);

    if (IN(0)) REP(0) { p0_prologue(args, F); REPBAR(0); } SEAM(0);
    if (IN(1)) REP(1) { pg8::StaticOrder S; S.init((const bf16*)(ws + WS_XB), D, (const bf16*)(ws + WS_WINAB), D, T, N_AB, F.G, F.bid);
        pg8::EpiAB E{(bf16*)(ws + WS_R1), (const float*)(ws + WS_LB)};
        pg8::gemm_phase<pg8::EpiAB, pg8::StaticOrder, false>(F.lds, D, S, E); REPBAR(1); } SEAM(1);
    if (IN(2)) REP(2) { ab_phase_a2(args, F); REPBAR(2); } SEAM(2);
    if (IN(3)) REP(3) { ab_scan(args, F); REPBAR(3); } SEAM(3);
    if (IN(4)) REP(4) { ab_phase_c2(args, F); REPBAR(4); } SEAM(4);
    if (IN(5)) REP(5) { pg8::StaticOrder S; S.init((const bf16*)(ws + WS_MIX), D, (const bf16*)(ws + WS_WOUTAB), D, T, D, F.G, F.bid);
        pg8::EpiBf16 E{(bf16*)(ws + WS_TMP), D};
        pg8::gemm_phase<pg8::EpiBf16, pg8::StaticOrder, false>(F.lds, D, S, E); REPBAR(5); } SEAM(5);
    if (IN(6)) REP(6) { ln_phase<0, true, false>(args, F, 0, args.in[I_X]); REPBAR(6); } SEAM(6);
    if (IN(7)) REP(7) { moe_table(F, 0);
        pg8::MoeOrder S{(const char*)(ws + WS_XB), (const char*)(ws + WS_W13), D, D, 4, F.G, F.bid, 1024, tab, (const int*)(ws + WS_LIST), true};
        pg8::EpiMoe1 E{(bf16*)(ws + WS_MIX), (const float*)(ws + WS_WL), tab};
        pg8::gemm_phase<pg8::EpiMoe1, pg8::MoeOrder, true>(F.lds, D, S, E); REPBAR(7); } SEAM(7);
    if (IN(8)) REP(8) { moe_table(F, 0);
        pg8::MoeOrder S{(const char*)(ws + WS_MIX), (const char*)(ws + WS_W2T), DEXP, DEXP, 8, F.G, F.bid, 2048, tab, (const int*)(ws + WS_LIST), false};
        pg8::EpiMoe2 E{(bf16*)(ws + WS_R2), (const int*)(ws + WS_LIST), tab};
        pg8::gemm_phase<pg8::EpiMoe2, pg8::MoeOrder, false>(F.lds, DEXP, S, E); REPBAR(8); } SEAM(8);
    if (IN(9)) REP(9) { ln_phase<1, false, false>(args, F, 0, nullptr); REPBAR(9); } SEAM(9);
    if (IN(10)) REP(10) { pg8::StaticOrder S; S.init((const bf16*)(ws + WS_XB), D, (const bf16*)(ws + WS_WINCD), D, T, N_CD, F.G, F.bid);
        pg8::EpiCD E{(bf16*)(ws + WS_R1), (float*)(ws + WS_SMALL)};
        pg8::gemm_phase<pg8::EpiCD, pg8::StaticOrder, false>(F.lds, D, S, E); REPBAR(10); } SEAM(10);
    if (IN(11)) REP(11) {
        { pg8::HeadOrder S{(const char*)(ws + WS_R1), (const char*)(ws + WS_WUK), N_CD, 256, 128, F.G, F.bid};
          pg8::EpiHead E{(bf16*)args.out, D, 256, 2, 0, 0.f};
          pg8::gemm_phase<pg8::EpiHead, pg8::HeadOrder, false>(F.lds, 256 + args.pad, S, E); }
        if (!(PROBE_SKIP & 1)) dsa_indexer(args, F);
        ml_phase_a2(args, F); REPBAR(11); } SEAM(11);
    if (IN(12)) REP(12) { dsa_prep_rows(args, F); if (!(PROBE_SKIP & 2)) dsa_topk(args, F); ml_scan(args, F); REPBAR(12); } SEAM(12);
    if (IN(13)) REP(13) { if (!(PROBE_SKIP & 4)) dsa_attention(args, F, _r == 0 ? (bf16*)args.out : (bf16*)(ws + WS_MIX)); ml_phase_c2(args, F); REPBAR(13); } SEAM(13);
    if (IN(14)) REP(14) { pg8::HeadOrder S{(const char*)args.out, (const char*)(ws + WS_WUV), D, 256, 256, F.G, F.bid};
        pg8::EpiHead E{(bf16*)(ws + WS_MIX), D, 128, 1, DIAG_OC_MODE, DIAG_OC_SCALE};
        pg8::gemm_phase<pg8::EpiHead, pg8::HeadOrder, false>(F.lds, 256 + args.pad, S, E); REPBAR(14); } SEAM(14);
    if (IN(15)) REP(15) { pg8::StaticOrder S; S.init((const bf16*)(ws + WS_MIX), D, (const bf16*)(ws + WS_WOUTCD), D, T, D, F.G, F.bid);
        pg8::EpiBf16 E{(bf16*)(ws + WS_TMP), D};
        pg8::gemm_phase<pg8::EpiBf16, pg8::StaticOrder, false>(F.lds, D, S, E); REPBAR(15); } SEAM(15);
    if (IN(16)) REP(16) { ln_phase<0, false, false>(args, F, 1, nullptr); REPBAR(16); } SEAM(16);
    if (IN(17)) REP(17) { moe_table(F, 1);
        pg8::MoeOrder S{(const char*)(ws + WS_XB), (const char*)(ws + WS_W13), D, D, 4, F.G, F.bid, 1024, tab, (const int*)(ws + WS_LIST), true};
        pg8::EpiMoe1 E{(bf16*)(ws + WS_MIX), (const float*)(ws + WS_WL), tab};
        pg8::gemm_phase<pg8::EpiMoe1, pg8::MoeOrder, true>(F.lds, D, S, E); REPBAR(17); } SEAM(17);
    if (IN(18)) REP(18) { moe_table(F, 1);
        pg8::MoeOrder S{(const char*)(ws + WS_MIX), (const char*)(ws + WS_W2T), DEXP, DEXP, 8, F.G, F.bid, 2048, tab, (const int*)(ws + WS_LIST), false};
        pg8::EpiMoe2 E{(bf16*)(ws + WS_R2), (const int*)(ws + WS_LIST), tab};
        pg8::gemm_phase<pg8::EpiMoe2, pg8::MoeOrder, false>(F.lds, DEXP, S, E); REPBAR(18); } SEAM(18);
    if (IN(19)) { ln_phase<1, false, true>(args, F, 1, nullptr); }
#undef IN
#undef SEAM
}

#ifndef MK_ONE_LAUNCH
#define MK_ONE_LAUNCH 1
#endif
extern "C" void kernel_launch(void* const* d_in, const int* in_sizes, int n_in, void* d_out, int out_size, void* d_ws, size_t ws_size, hipStream_t stream) {
    static int grid = 0;
    if (grid == 0) {
        if (n_in != 24 || in_sizes[0] != T * D || out_size != T * D || ws_size < WS_END) { fprintf(stderr, "kernel_launch: unexpected shapes (n_in %d, in0 %d, out %d, ws %zu < %zu); nothing launched\n", n_in, n_in > 0 ? in_sizes[0] : -1, out_size, ws_size, (size_t)WS_END); grid = -1; return; }
        int dev = 0, cus = 0, per_cu = 0;
        if (hipGetDevice(&dev) != hipSuccess || hipDeviceGetAttribute(&cus, hipDeviceAttributeMultiprocessorCount, dev) != hipSuccess) { grid = -1; return; }
        if (hipFuncSetAttribute((const void*)hybrid_fwd, hipFuncAttributeMaxDynamicSharedMemorySize, LDS_BYTES) != hipSuccess) { fprintf(stderr, "kernel_launch: hipFuncSetAttribute failed\n"); grid = -1; return; }
        if (hipOccupancyMaxActiveBlocksPerMultiprocessor(&per_cu, (const void*)hybrid_fwd, 512, LDS_BYTES) != hipSuccess || per_cu < 1) fprintf(stderr, "kernel_launch: occupancy query reports %d\n", per_cu);
        (void)hipGetLastError();
        grid = cus;
    }
    if (grid < 0) return;
    if (hipMemsetAsync((char*)d_ws + WS_CTL, 0, CTL_ZERO_BYTES, stream) != hipSuccess) return;
    Args a{};
    for (int i = 0; i < 24; ++i) a.in[i] = (const float*)d_in[i];
    a.out = (float*)d_out; a.ws = (unsigned char*)d_ws; a.pad = 0;
#if MK_ONE_LAUNCH
    a.ph_lo = 0; a.ph_hi = N_PHASES; a.use_bar = 1;
    hipLaunchKernelGGL(hybrid_fwd, dim3(grid), dim3(512), LDS_BYTES, stream, a);
#else
    a.use_bar = 0;
    for (int p = 0; p < N_PHASES; ++p) { a.ph_lo = p; a.ph_hi = p + 1; hipLaunchKernelGGL(hybrid_fwd, dim3(grid), dim3(512), LDS_BYTES, stream, a); }
#endif
}
```

```cpp
#include <hip/hip_runtime.h>
#include <cstdio>
#include <cstdint>

#define LAS __attribute__((address_space(3)))
#define GAS __attribute__((address_space(1)))
typedef unsigned short bf16;
typedef short bf16x8 __attribute__((ext_vector_type(8)));
typedef short s16x4 __attribute__((ext_vector_type(4)));
typedef float f32x4 __attribute__((ext_vector_type(4)));
typedef float f32x2 __attribute__((ext_vector_type(2)));
typedef unsigned u32x4 __attribute__((ext_vector_type(4)));
typedef unsigned u32x2 __attribute__((ext_vector_type(2)));
typedef GAS unsigned gu32;

constexpr int BATCH = 4, SEQ = 4096, T = BATCH * SEQ, D = 2048, NCH = SEQ / 64;
constexpr int N_AB = 7168, PSRC_AB = 7184;
constexpr int N_CD = 5632, PSRC_CD = 5464;
constexpr int NE = 16, DEXP = 512;
constexpr float DN_ALPHA = 1.4142135623730951f;
constexpr float EPS = 1e-5f;

constexpr size_t MiB = 1u << 20;
constexpr size_t WS_CTL = 0, CTL_ZERO_BYTES = 128 * 1024;
constexpr size_t WS_LB = 1 * MiB;
constexpr size_t WS_MLSC = 1 * MiB + 65536;
constexpr size_t WS_GA = 2 * MiB;
constexpr size_t WS_GB = 3 * MiB;
constexpr size_t WS_MLN = 4 * MiB;
constexpr size_t WS_LIST = 5 * MiB;
constexpr size_t WS_WL = 6 * MiB;
constexpr size_t WS_SMALL = 8 * MiB;
constexpr size_t WS_LAB = 16 * MiB;
constexpr size_t WS_IDX = 32 * MiB;
constexpr size_t WS_CKVN = 40 * MiB;
constexpr size_t WS_W = 48 * MiB;
constexpr size_t WS_WINAB = WS_W, WS_WOUTAB = WS_W + 28 * MiB, WS_WINCD = WS_W + 36 * MiB, WS_WOUTCD = WS_W + 58 * MiB, WS_WUK = WS_W + 66 * MiB, WS_WUV = WS_W + 67 * MiB;
constexpr size_t WS_XB = 116 * MiB;
constexpr size_t WS_MIX = 180 * MiB;
constexpr size_t WS_R1 = 244 * MiB;
constexpr size_t WS_TMP = WS_R1, WS_W13 = WS_R1 + 128 * MiB, WS_W2T = WS_R1 + 192 * MiB;
constexpr size_t WS_R2 = 468 * MiB;
constexpr size_t WS_END = 598 * MiB;
constexpr int CW_TMO = 0, CW_CODE = 1;
constexpr int CW_BAR = 4096;
constexpr int CW_CNT = 16384;
static_assert((CW_CNT + 2 * 16 * 64) * 4 <= (int)CTL_ZERO_BYTES && (CW_BAR + 3456) * 4 <= (int)CTL_ZERO_BYTES, "control words inside the cleared region");

constexpr int RING_BYTES = 131072;
constexpr int LDSCTL_OFF = RING_BYTES, MISC_OFF = LDSCTL_OFF + 320;
constexpr int LDS_BYTES = 147456;

#define RLX_AGENT __ATOMIC_RELAXED, __HIP_MEMORY_SCOPE_AGENT
#define LDS_WAIT() asm volatile("s_waitcnt lgkmcnt(0)" ::: "memory")
#define VM_WAIT() asm volatile("s_waitcnt vmcnt(0)" ::: "memory")
__device__ __forceinline__ unsigned f2bf(float f) { unsigned u = __builtin_bit_cast(unsigned, f); return (u + 0x7fffu + ((u >> 16) & 1u)) >> 16; }
__device__ __forceinline__ unsigned pk2(float lo, float hi) { return f2bf(lo) | (f2bf(hi) << 16); }
__device__ __forceinline__ float bf2f(unsigned b) { return __builtin_bit_cast(float, b << 16); }
__device__ __forceinline__ float bflo(unsigned w) { return __builtin_bit_cast(float, w << 16); }
__device__ __forceinline__ float bfhi(unsigned w) { return __builtin_bit_cast(float, w & 0xffff0000u); }
__device__ __forceinline__ unsigned cvt_pk_bf16(float lo, float hi) { unsigned r; asm volatile("v_cvt_pk_bf16_f32 %0, %1, %2" : "=v"(r) : "v"(lo), "v"(hi)); return r; }
__device__ __forceinline__ float sigmoidf_(float v) { return __builtin_amdgcn_rcpf(1.0f + __expf(-v)); }
__device__ __forceinline__ float siluf_(float v) { return v * __builtin_amdgcn_rcpf(1.0f + __expf(-v)); }
__device__ __forceinline__ float wave_sum(float v) {
#pragma unroll
    for (int o = 1; o < 64; o <<= 1) v += __shfl_xor(v, o);
    return v;
}
__device__ __forceinline__ float wave_max(float v) {
#pragma unroll
    for (int o = 1; o < 64; o <<= 1) v = fmaxf(v, __shfl_xor(v, o));
    return v;
}
namespace pg8 {
constexpr int BM = 256, BK = 64, HALF = 128, HTB = HALF * BK * 2, STAGE_BYTES = 8 * HTB, NXCD = 8, WGM = 8;
__host__ __device__ __forceinline__ int lds_byte(int r, int c) { const int st = (r >> 4) * 2 + (c >> 5), rr = r & 15, cc = c & 31, ob = rr * 64 + cc * 2; return st * 1024 + (ob ^ (((ob >> 9) & 1) << 5)); }
__host__ __device__ __forceinline__ void stage_rc(int b, int& R, int& C) { const int st = b / 1024, sb = b % 1024, swz = sb ^ (((sb >> 9) & 1) << 5); R = (st >> 1) * 16 + swz / 64; C = (st & 1) * 32 + (swz % 64) / 2; }
__host__ __device__ __forceinline__ int perm32(int rho) { const int n = rho >> 4, i = rho & 15; return 8 * (i >> 2) + 4 * n + (i & 3); }

struct Unit { int pm, pn, ex; };

struct StaticOrder {
    const char* A; const char* Bt; int lda, ldb;
    int nM, nN, nwg, G, c;
    __device__ void init(const bf16* A_, int lda_, const bf16* Bt_, int ldb_, int M, int N, int G_, int c_) { A = (const char*)A_; Bt = (const char*)Bt_; lda = lda_; ldb = ldb_; nM = M / BM; nN = N / BM; nwg = nM * nN; G = G_; c = c_; }
    __device__ bool next(int i, Unit& u) const {
        const long L = (long)i * G + c; if (L >= nwg) return false;
        int wgid = (int)L; { const int q = nwg / NXCD, r = nwg % NXCD, xcd = wgid % NXCD, off = wgid / NXCD; wgid = (xcd < r ? xcd * (q + 1) : r * (q + 1) + (xcd - r) * q) + off; }
        const int nig = WGM * nN, gid = wgid / nig, fm = gid * WGM, gsz = (nM - fm) < WGM ? (nM - fm) : WGM;
        u.pm = fm + ((wgid % nig) % gsz); u.pn = (wgid % nig) / gsz; u.ex = 0; return true;
    }
    __device__ __forceinline__ const char* a_base(const Unit& u) const { return A + (size_t)u.pm * BM * lda * 2; }
    __device__ __forceinline__ const char* b_base(const Unit& u) const { return Bt + (size_t)u.pn * BM * ldb * 2; }
    __device__ __forceinline__ unsigned a_rowoff(const Unit&, int) const { return 0u; }
};

template <class Epi, class Sched, bool GATHER = false>
__device__ __forceinline__ void gemm_phase(LAS unsigned char* lds, const int K, const Sched& S, const Epi& E) {
    const int tid = threadIdx.x, wid = __builtin_amdgcn_readfirstlane(tid >> 6), lane = tid & 63, wr = wid >> 2, wc = wid & 3, fr = lane & 15, fq = lane >> 4;
    const int nt = K / BK;
    const int lda = S.lda, ldb = S.ldb;
    int Rst[2], Cst[2];
    unsigned voffA[2], voffB[2];
#pragma unroll
    for (int i = 0; i < 2; ++i) { int R, C; stage_rc(tid * 16 + i * 8192, R, C); Rst[i] = R; Cst[i] = C; const int Rb = Epi::PERM ? ((R & ~31) + perm32(R & 31)) : R;
        voffA[i] = (unsigned)(R * lda + C) * 2u; voffB[i] = (unsigned)(Rb * ldb + C) * 2u; }
    const size_t kstep = (size_t)(BK * 2);
    const size_t hstepA = (size_t)HALF * lda * 2, hstepB = (size_t)HALF * ldb * 2;
    const unsigned ldsw = (unsigned)wid * 1024u;
    const int aoff = lds_byte(wr * 64 + fr, fq * 8), boff = lds_byte(wc * 32 + fr, fq * 8);
    unsigned vc[2][2], vn[2][2];
#define PG8_SA(b, h) (((b) * 2 + (h)) * HTB)
#define PG8_SB(b, h) ((4 + (b) * 2 + (h)) * HTB)
#define PG8_STAGE_B(bufoff, gbase) do { _Pragma("unroll") for (int _i = 0; _i < 2; ++_i) \
        __builtin_amdgcn_global_load_lds((const unsigned*)((const char*)(gbase) + voffB[_i]), (LAS unsigned*)(lds + (bufoff) + ldsw + _i * 8192), 16, 0, 0); } while (0)
#define PG8_STAGE_A(bufoff, gbase, h, vs) do { _Pragma("unroll") for (int _i = 0; _i < 2; ++_i) { \
        const char* _p = GATHER ? ((const char*)(gbase) + (vs)[h][_i]) : ((const char*)(gbase) + (h) * hstepA + voffA[_i]); \
        __builtin_amdgcn_global_load_lds((const unsigned*)_p, (LAS unsigned*)(lds + (bufoff) + ldsw + _i * 8192), 16, 0, 0); } } while (0)
#define PG8_LDA(dst, b, h) do { _Pragma("unroll") for (int m = 0; m < 4; ++m) _Pragma("unroll") for (int k = 0; k < 2; ++k) dst[m][k] = *(const LAS bf16x8*)(lds + PG8_SA(b, h) + aoff + m * 2048 + k * 1024); } while (0)
#define PG8_LDB(dst, b, h) do { _Pragma("unroll") for (int n = 0; n < 2; ++n) _Pragma("unroll") for (int k = 0; k < 2; ++k) dst[n][k] = *(const LAS bf16x8*)(lds + PG8_SB(b, h) + boff + n * 2048 + k * 1024); } while (0)
#define PG8_MMA(ai, bj, At, Bt) do { __builtin_amdgcn_s_setprio(1); _Pragma("unroll") for (int m = 0; m < 4; ++m) _Pragma("unroll") for (int n = 0; n < 2; ++n) _Pragma("unroll") for (int k = 0; k < 2; ++k) \
        acc[ai][bj][m][n] = __builtin_amdgcn_mfma_f32_16x16x32_bf16(Bt[n][k], At[m][k], acc[ai][bj][m][n], 0, 0, 0); __builtin_amdgcn_s_setprio(0); } while (0)
#define PG8_WAIT_V(n) asm volatile("s_waitcnt vmcnt(" #n ")" ::: "memory")
#define PG8_WAIT_L(n) asm volatile("s_waitcnt lgkmcnt(" #n ")" ::: "memory")
#define PG8_BAR __builtin_amdgcn_s_barrier()
#define PG8_SCHED __builtin_amdgcn_sched_barrier(0)
#define PG8_LOADV(dst, u) do { if constexpr (GATHER) { _Pragma("unroll") for (int _h = 0; _h < 2; ++_h) _Pragma("unroll") for (int _i = 0; _i < 2; ++_i) \
        dst[_h][_i] = S.a_rowoff(u, _h * HALF + Rst[_i]) + (unsigned)Cst[_i] * 2u; } } while (0)
    Unit cur, nxt; int ui = 0;
    if (!S.next(0, cur)) return;
    f32x4 acc[2][2][4][2];
#pragma unroll
    for (int a = 0; a < 2; ++a)
#pragma unroll
        for (int b = 0; b < 2; ++b)
#pragma unroll
            for (int m = 0; m < 4; ++m)
#pragma unroll
                for (int n = 0; n < 2; ++n) acc[a][b][m][n] = (f32x4){0.f, 0.f, 0.f, 0.f};
    bf16x8 At[4][2], B0[2][2], B1[2][2];
    const char* cA = S.a_base(cur); const char* cB = S.b_base(cur);
    PG8_LOADV(vc, cur);
#pragma unroll
    for (int _h = 0; _h < 2; ++_h)
#pragma unroll
        for (int _i = 0; _i < 2; ++_i) vn[_h][_i] = GATHER ? vc[_h][_i] : 0u;
    PG8_STAGE_B(PG8_SB(0, 0), cB); PG8_STAGE_B(PG8_SB(0, 1), cB + hstepB); PG8_STAGE_A(PG8_SA(0, 0), cA, 0, vc); PG8_STAGE_A(PG8_SA(0, 1), cA, 1, vc);
    if (wr == 1) PG8_BAR;
    PG8_WAIT_V(2); PG8_BAR;
    PG8_STAGE_B(PG8_SB(1, 0), cB + kstep); PG8_STAGE_A(PG8_SA(1, 0), cA + kstep, 0, vc); PG8_STAGE_B(PG8_SB(1, 1), cB + hstepB + kstep);
    PG8_WAIT_V(6); PG8_BAR;
    for (;;) {
        const bool has_next = S.next(ui + 1, nxt);
        const char* nA = has_next ? S.a_base(nxt) : cA; const char* nB = has_next ? S.b_base(nxt) : cB;
        if constexpr (GATHER) { if (has_next) { PG8_LOADV(vn, nxt); } else {
#pragma unroll
            for (int _h = 0; _h < 2; ++_h)
#pragma unroll
                for (int _i = 0; _i < 2; ++_i) vn[_h][_i] = vc[_h][_i]; }
            asm volatile("s_waitcnt vmcnt(0)" :: "v"(vn[0][0]), "v"(vn[0][1]), "v"(vn[1][0]), "v"(vn[1][1]) : "memory"); }
        for (int t = 0; t < nt; t += 2) {
            const bool last = (t == nt - 2);
            const char* a1 = cA + (size_t)(t + 1) * kstep;
            const char* a2 = last ? nA : cA + (size_t)(t + 2) * kstep; const char* b2 = last ? nB : cB + (size_t)(t + 2) * kstep;
            const char* a3 = a2 + kstep; const char* b3 = b2 + kstep;
            unsigned vs[2][2];
#pragma unroll
            for (int _h = 0; _h < 2; ++_h)
#pragma unroll
                for (int _i = 0; _i < 2; ++_i) vs[_h][_i] = GATHER ? (last ? vn[_h][_i] : vc[_h][_i]) : 0u;
            PG8_LDB(B0, 0, 0); PG8_LDB(B1, 0, 1); PG8_SCHED; PG8_LDA(At, 0, 0); PG8_STAGE_A(PG8_SA(1, 1), a1, 1, vc);
            PG8_WAIT_V(8); PG8_WAIT_L(0); PG8_BAR; PG8_MMA(0, 0, At, B0); PG8_MMA(0, 1, At, B1); PG8_BAR; PG8_SCHED;
            PG8_LDA(At, 0, 1); PG8_STAGE_B(PG8_SB(0, 0), b2); PG8_STAGE_B(PG8_SB(0, 1), b2 + hstepB); PG8_STAGE_A(PG8_SA(0, 0), a2, 0, vs);
            PG8_WAIT_V(8); PG8_WAIT_L(0); PG8_BAR; PG8_MMA(1, 0, At, B0); PG8_MMA(1, 1, At, B1); PG8_BAR; PG8_SCHED;
            PG8_LDB(B0, 1, 0); PG8_LDB(B1, 1, 1); PG8_SCHED; PG8_LDA(At, 1, 0); PG8_STAGE_A(PG8_SA(0, 1), a2, 1, vs);
            PG8_WAIT_V(8); PG8_WAIT_L(0); PG8_BAR; PG8_MMA(0, 0, At, B0); PG8_MMA(0, 1, At, B1); PG8_BAR; PG8_SCHED;
            PG8_LDA(At, 1, 1); PG8_STAGE_B(PG8_SB(1, 0), b3); PG8_STAGE_B(PG8_SB(1, 1), b3 + hstepB); PG8_STAGE_A(PG8_SA(1, 0), a3, 0, vs);
            PG8_WAIT_V(8); PG8_WAIT_L(0); PG8_BAR; PG8_MMA(1, 0, At, B0); PG8_MMA(1, 1, At, B1); PG8_BAR; PG8_SCHED;
        }
        if (wr == 0) PG8_BAR;
        E(acc, cur, wr, wc, fr, fq);
        if (!has_next) break;
#pragma unroll
        for (int a = 0; a < 2; ++a)
#pragma unroll
            for (int b = 0; b < 2; ++b)
#pragma unroll
                for (int m = 0; m < 4; ++m)
#pragma unroll
                    for (int n = 0; n < 2; ++n) acc[a][b][m][n] = (f32x4){0.f, 0.f, 0.f, 0.f};
        cur = nxt; cA = nA; cB = nB; ++ui;
#pragma unroll
        for (int _h = 0; _h < 2; ++_h)
#pragma unroll
            for (int _i = 0; _i < 2; ++_i) vc[_h][_i] = vn[_h][_i];
        if (wr == 1) PG8_BAR;
    }
    PG8_WAIT_V(0);
    PG8_BAR;
#undef PG8_SA
#undef PG8_SB
#undef PG8_STAGE_A
#undef PG8_STAGE_B
#undef PG8_LDA
#undef PG8_LDB
#undef PG8_MMA
#undef PG8_WAIT_V
#undef PG8_WAIT_L
#undef PG8_BAR
#undef PG8_SCHED
#undef PG8_LOADV
}
}
namespace pg8 {
struct EpiF32 {
    static constexpr bool PERM = false;
    float* C; int ldc;
    __device__ __forceinline__ void operator()(const f32x4 (&acc)[2][2][4][2], const Unit& u, int wr, int wc, int fr, int fq) const {
        const int row0 = u.pm * BM + wr * 64 + fr, col0 = u.pn * BM + wc * 32 + 4 * fq;
#pragma unroll
        for (int ai = 0; ai < 2; ++ai)
#pragma unroll
            for (int m = 0; m < 4; ++m) { float* rowp = C + (size_t)(row0 + ai * HALF + m * 16) * ldc + col0;
#pragma unroll
                for (int bj = 0; bj < 2; ++bj)
#pragma unroll
                    for (int n = 0; n < 2; ++n) *(f32x4*)(rowp + bj * HALF + n * 16) = acc[ai][bj][m][n]; }
    }
};
__device__ __forceinline__ float epi_act(int mode, float v, float aux) {
    if (mode == 1) return siluf_(v);
    if (mode == 2) return v * aux;
    if (mode == 3) return __logf(aux + (1.0f - aux) * sigmoidf_(v));
    if (mode == 4) return sigmoidf_(v);
    if (mode == 5) return 0.f;
    return v;
}
__device__ __forceinline__ void store_bf16_tile(const f32x4 (&acc)[2][2][4][2], bf16* O, int ldc, int row0, int col0, int mode, float auxs, const float* auxv  , int nbj) {
    f32x4 av[2][2];
#pragma unroll
    for (int bj = 0; bj < 2; ++bj)
#pragma unroll
        for (int n = 0; n < 2; ++n) av[bj][n] = auxv ? *(const f32x4*)(auxv + bj * HALF + 4 * n) : (f32x4){auxs, auxs, auxs, auxs};
#pragma unroll
    for (int ai = 0; ai < 2; ++ai)
#pragma unroll
        for (int m = 0; m < 4; ++m) { bf16* rowp = O + (size_t)(row0 + ai * HALF + m * 16) * ldc + col0;
#pragma unroll
            for (int bj = 0; bj < 2; ++bj) { if (bj < nbj) { f32x4 v0 = acc[ai][bj][m][0], v1 = acc[ai][bj][m][1];
                if (mode != 0) {
#pragma unroll
                    for (int j = 0; j < 4; ++j) { v0[j] = epi_act(mode, v0[j], av[bj][0][j]); v1[j] = epi_act(mode, v1[j], av[bj][1][j]); } }
                u32x4 w; w.x = cvt_pk_bf16(v0[0], v0[1]); w.y = cvt_pk_bf16(v0[2], v0[3]); w.z = cvt_pk_bf16(v1[0], v1[1]); w.w = cvt_pk_bf16(v1[2], v1[3]);
                *(u32x4*)(rowp + bj * HALF) = w; } } }
}
struct EpiBf16 {
    static constexpr bool PERM = true;
    bf16* O; int ldc;
    __device__ __forceinline__ void operator()(const f32x4 (&acc)[2][2][4][2], const Unit& u, int wr, int wc, int fr, int fq) const {
        store_bf16_tile(acc, O, ldc, u.pm * BM + wr * 64 + fr, u.pn * BM + wc * 32 + 8 * fq, 0, 0.f, nullptr, 2);
    }
};
struct EpiAB {
    static constexpr bool PERM = true;
    bf16* O; const float* lb;
    __device__ __forceinline__ void operator()(const f32x4 (&acc)[2][2][4][2], const Unit& u, int wr, int wc, int fr, int fq) const {
        const int pn = u.pn; int mode = 0; float auxs = 0.f; const float* auxv = nullptr;
        const int cl = wc * 32 + 8 * fq;
        if (pn < 4) mode = 1;
        else if (pn < 8) { mode = 3; auxv = lb + (pn - 4) * BM + cl; }
        else if (pn < 12) mode = 0;
        else if (pn < 16) mode = 1;
        else if (pn < 18) { mode = 2; auxs = 0.08838834764831845f; }
        else if (pn < 24) mode = 0;
        else mode = 1;
        store_bf16_tile(acc, O, N_AB, u.pm * BM + wr * 64 + fr, pn * BM + cl, mode, auxs, auxv, 2);
    }
};
struct EpiCD {
    static constexpr bool PERM = true;
    bf16* O; float* small;
    __device__ __forceinline__ void operator()(const f32x4 (&acc)[2][2][4][2], const Unit& u, int wr, int wc, int fr, int fq) const {
        const int pn = u.pn; const int cl = wc * 32 + 8 * fq; const int row0 = u.pm * BM + wr * 64 + fr;
        if (pn == 21) {
#pragma unroll
            for (int ai = 0; ai < 2; ++ai)
#pragma unroll
                for (int m = 0; m < 4; ++m) { float* rowp = small + (size_t)(row0 + ai * HALF + m * 16) * 128 + cl;
                    *(f32x4*)(rowp) = acc[ai][0][m][0]; *(f32x4*)(rowp + 4) = acc[ai][0][m][1]; }
            return;
        }
        int mode = 0; float auxs = 0.f;
        if (pn >= 5 && pn < 9) { mode = 2; auxs = 0.125f; }
        else if (pn >= 17) mode = 4;
        store_bf16_tile(acc, O, N_CD, row0, pn * BM + cl, mode, auxs, nullptr, 2);
    }
};
struct EpiHead {
    static constexpr bool PERM = true;
    bf16* O; int ldc; int colstride; int nbj; int mode; float auxs;
    __device__ __forceinline__ void operator()(const f32x4 (&acc)[2][2][4][2], const Unit& u, int wr, int wc, int fr, int fq) const {
        store_bf16_tile(acc, O, ldc, u.pm * BM + wr * 64 + fr, u.ex * colstride + wc * 32 + 8 * fq, mode, auxs, nullptr, nbj);
    }
};
struct HeadOrder {
    const char* A; const char* Bt; int lda, ldb; int acol; int G, c;
    __device__ bool next(int i, Unit& u) const { const int L = i * G + c; if (L >= 64 * 8) return false; u.pm = L >> 3; u.ex = L & 7; u.pn = 0; return true; }
    __device__ __forceinline__ const char* a_base(const Unit& u) const { return A + ((size_t)u.pm * BM * lda + (size_t)u.ex * acol) * 2; }
    __device__ __forceinline__ const char* b_base(const Unit& u) const { return Bt + (size_t)u.ex * BM * ldb * 2; }
    __device__ __forceinline__ unsigned a_rowoff(const Unit&, int) const { return 0u; }
};
struct MoeOrder {
    const char* A; const char* Bt; int lda, ldb; int NT; int G, c; int brows;
    const volatile LAS int* tab; const int* list;
    bool gather;
    __device__ bool next(int i, Unit& u) const {
        const int cx = ((G & 7) == 0) ? (c & 7) * (G >> 3) + (c >> 3) : c;
        const int L = i * G + cx; const int total = tab[16] * NT; if (L >= total) return false;
        const int mg = L / NT; u.pn = L - mg * NT; int e = 0;
#pragma unroll
        for (int j = 1; j < 16; ++j) e += (mg >= tab[j]) ? 1 : 0;
        u.ex = e; u.pm = mg; return true;
    }
    __device__ __forceinline__ const char* a_base(const Unit& u) const { return gather ? A : A + (size_t)u.pm * BM * lda * 2; }
    __device__ __forceinline__ const char* b_base(const Unit& u) const { return Bt + ((size_t)u.ex * brows + (size_t)u.pn * BM) * ldb * 2; }
    __device__ __forceinline__ unsigned a_rowoff(const Unit& u, int r) const {
        const int lr = (u.pm - tab[u.ex]) * BM + r; const int ne = tab[32 + u.ex];
        const int tok = (lr < ne) ? (list[u.ex * 16384 + lr] & 0x7fffffff) : 0;
        return (unsigned)tok * (unsigned)(lda * 2);
    }
};
struct EpiMoe1 {
    static constexpr bool PERM = true;
    bf16* hid; const float* wl; const volatile LAS int* tab;
    __device__ __forceinline__ void operator()(const f32x4 (&acc)[2][2][4][2], const Unit& u, int wr, int wc, int fr, int fq) const {
        const int e = u.ex, lr0 = (u.pm - tab[e]) * BM + wr * 64 + fr, ne = tab[32 + e];
        const int col0 = u.pn * 128 + wc * 32 + 8 * fq;
#pragma unroll
        for (int ai = 0; ai < 2; ++ai)
#pragma unroll
            for (int m = 0; m < 4; ++m) { const int lr = lr0 + ai * HALF + m * 16;
                if (lr < ne) { const float w = wl[e * 16384 + lr];
                    f32x4 a0 = acc[ai][0][m][0], a1 = acc[ai][0][m][1], b0 = acc[ai][1][m][0], b1 = acc[ai][1][m][1];
#pragma unroll
                    for (int j = 0; j < 4; ++j) { a0[j] = siluf_(a0[j]) * b0[j] * w; a1[j] = siluf_(a1[j]) * b1[j] * w; }
                    u32x4 o; o.x = cvt_pk_bf16(a0[0], a0[1]); o.y = cvt_pk_bf16(a0[2], a0[3]); o.z = cvt_pk_bf16(a1[0], a1[1]); o.w = cvt_pk_bf16(a1[2], a1[3]);
                    *(u32x4*)(hid + (size_t)(u.pm * BM + wr * 64 + fr + ai * HALF + m * 16) * DEXP + col0) = o; } }
    }
};
struct EpiMoe2 {
    static constexpr bool PERM = true;
    bf16* ys; const int* list; const volatile LAS int* tab;
    __device__ __forceinline__ void operator()(const f32x4 (&acc)[2][2][4][2], const Unit& u, int wr, int wc, int fr, int fq) const {
        const int e = u.ex, lr0 = (u.pm - tab[e]) * BM + wr * 64 + fr, ne = tab[32 + e];
        const int col0 = u.pn * BM + wc * 32 + 8 * fq;
#pragma unroll
        for (int ai = 0; ai < 2; ++ai)
#pragma unroll
            for (int m = 0; m < 4; ++m) { const int lr = lr0 + ai * HALF + m * 16;
                if (lr < ne) { const int ent = list[e * 16384 + lr]; const int tok = ent & 0x7fffffff, slot = (ent >> 31) & 1;
                    bf16* rowp = ys + ((size_t)slot * T + tok) * D + col0;
#pragma unroll
                    for (int bj = 0; bj < 2; ++bj) { const f32x4 v0 = acc[ai][bj][m][0], v1 = acc[ai][bj][m][1];
                        u32x4 o; o.x = cvt_pk_bf16(v0[0], v0[1]); o.y = cvt_pk_bf16(v0[2], v0[3]); o.z = cvt_pk_bf16(v1[0], v1[1]); o.w = cvt_pk_bf16(v1[2], v1[3]);
                        *(u32x4*)(rowp + bj * HALF) = o; } } }
    }
};
}
#define XB_TMO      128
#define XB_XCNT(j)  (256  + 64 * (j))
#define XB_XSUB(j)  (1280 + 64 * (j))
#define XB_XGEN(j)  (2304 + 64 * (j))
#define XB_TOP      3328
#define XB_TOPGEN   3392
#define XCD_BAR_WORDS 3456
#define XB_SPIN_CAP (1u << 22)

__device__ __forceinline__ unsigned xb_ld(unsigned* p)              { return __hip_atomic_load(p, __ATOMIC_RELAXED, __HIP_MEMORY_SCOPE_AGENT); }
__device__ __forceinline__ unsigned xb_add(unsigned* p, unsigned v) { return __hip_atomic_fetch_add(p, v, __ATOMIC_RELAXED, __HIP_MEMORY_SCOPE_AGENT); }
__device__ __forceinline__ unsigned xb_xcc_id() { return (unsigned)__builtin_amdgcn_s_getreg((3 << 11) | 20) & 0xFu; }
#define XB_SPIN(cond, bar) do { unsigned _sp = 0; while (cond) { __builtin_amdgcn_s_sleep(1); \
    if ((++_sp & 255u) == 0u) { if (xb_ld(&(bar)[XB_TMO])) break; if (_sp > XB_SPIN_CAP) { atomicAdd(&(bar)[XB_TMO], 1u); break; } } } } while (0)

struct XcdBarrier { unsigned* bar; unsigned x; volatile LAS unsigned* st; };

__device__ __forceinline__ XcdBarrier xcd_barrier_post(unsigned* bar, volatile LAS unsigned* st) {
    XcdBarrier b; b.bar = bar; b.x = xb_xcc_id(); b.st = st;
    if (threadIdx.x == 0) (void)xb_add(&bar[XB_XCNT(b.x)], 1u);
    return b;
}
__device__ __forceinline__ void xcd_barrier_complete(unsigned* bar, unsigned x, unsigned& nloc, unsigned& nx) {
    const unsigned G = gridDim.x * gridDim.y * gridDim.z;
    unsigned sum, cnt, mine, sp = 0u;
    for (;;) {
        sum = 0u; cnt = 0u; mine = 0u;
#pragma unroll
        for (unsigned j = 0; j < 16; ++j) { const unsigned c = xb_ld(&bar[XB_XCNT(j)]); sum += c; cnt += (c > 0u) ? 1u : 0u; mine = (j == x) ? c : mine; }
        if (sum == G) break;
        __builtin_amdgcn_s_sleep(1);
        if ((++sp & 255u) == 0u) { if (xb_ld(&bar[XB_TMO])) break; if (sp > XB_SPIN_CAP) { atomicAdd(&bar[XB_TMO], 1u); break; } }
    }
    nloc = mine > 0u ? mine : 1u; nx = cnt > 0u ? cnt : 1u;
}
__device__ __forceinline__ void xcd_barrier(const XcdBarrier& b) {
    asm volatile("s_waitcnt vmcnt(0)" ::: "memory");
    __syncthreads();
    if (threadIdx.x == 0) {
        unsigned* bar = b.bar;
        __builtin_amdgcn_s_waitcnt(0);
        unsigned nloc = b.st[0], nx = b.st[1];
        if (nloc == 0u) { xcd_barrier_complete(bar, b.x, nloc, nx); b.st[0] = nloc; b.st[1] = nx; }
        const unsigned old = xb_add(&bar[XB_XSUB(b.x)], 1u);
        const unsigned gen = old / nloc;
        if (old + 1u == (gen + 1u) * nloc) {
            __builtin_amdgcn_fence(__ATOMIC_RELEASE, "agent");
            asm volatile("s_waitcnt vmcnt(0)" ::: "memory");
            const unsigned og = xb_add(&bar[XB_TOP], 1u);
            const unsigned tg = og / nx;
            if (og + 1u == (tg + 1u) * nx) xb_add(&bar[XB_TOPGEN], 1u);
            else XB_SPIN(xb_ld(&bar[XB_TOPGEN]) == tg, bar);
            __builtin_amdgcn_fence(__ATOMIC_ACQUIRE, "agent");
            xb_add(&bar[XB_XGEN(b.x)], 1u);
            asm volatile("s_waitcnt vmcnt(0)" ::: "memory");
        } else {
            XB_SPIN(xb_ld(&bar[XB_XGEN(b.x)]) == gen, bar);
            __builtin_amdgcn_fence(__ATOMIC_ACQUIRE, "agent");
            asm volatile("s_waitcnt vmcnt(0)" ::: "memory");
        }
    }
    __syncthreads();
}

struct Args {
    const float* in[24]; float* out; unsigned char* ws; int ph_lo, ph_hi, use_bar, pad;
};
enum InIdx { I_X = 0, I_WINAB, I_WOUTAB, I_LBLOG, I_ANORM, I_WA2, I_BA2, I_BNORM, I_WINCD, I_WOUTCD, I_CKVG, I_WUK, I_WUV, I_CONVW, I_GATEB, I_DNORM, I_REL, I_WR, I_BR, I_W1, I_W3, I_W2, I_LNG, I_LNB };

struct Frame {
    LAS unsigned char* lds;
    gu32* ctl;
    int tid, lane, wave, G, bid;
    const float* const* in; float* out; unsigned char* ws;
};
#ifndef PROBE_REPCONV
#define PROBE_REPCONV 0
#endif
template <class SrcFn>
__device__ __forceinline__ void transpose_item(const SrcFn& src, int Kdst, bf16* WT, LAS float* scr, int kb, int nb, int lane) {
    const int k0 = 64 * kb, n0 = 32 * nb;
    float v[32];
#pragma unroll
    for (int i = 0; i < 32; ++i) v[i] = src(k0 + 2 * i + (lane >> 5), n0 + (lane & 31));
#pragma unroll
    for (int i = 0; i < 32; ++i) scr[(2 * i + (lane >> 5)) * 33 + (lane & 31)] = v[i];
    LDS_WAIT(); asm volatile("" ::: "memory");
    const int c = lane & 7;
#pragma unroll
    for (int j = 0; j < 4; ++j) { const int n = (lane >> 3) + 8 * j; const LAS float* s = scr + (8 * c) * 33 + n;
        u32x4 o; o.x = pk2(s[0 * 33], s[1 * 33]); o.y = pk2(s[2 * 33], s[3 * 33]); o.z = pk2(s[4 * 33], s[5 * 33]); o.w = pk2(s[6 * 33], s[7 * 33]);
        *(GAS u32x4*)(WT + (size_t)(n0 + n) * Kdst + k0 + 8 * c) = o; }
    LDS_WAIT(); asm volatile("" ::: "memory");
}
constexpr int TT_LD = 264;
template <class AddrFn>
__device__ __forceinline__ void wgt_load(const AddrFn& addr, int k0, int wave, int lane, f32x4 (&v)[8]) {
#pragma unroll
    for (int i = 0; i < 8; ++i) v[i] = *(const GAS f32x4*)addr(k0 + 8 * wave + i, 4 * lane);
}
__device__ __forceinline__ void wgt_emit(LAS bf16* tile, const f32x4 (&v)[8], bf16* WT, int Kdst, int k0, int n0, int wave, int lane) {
#pragma unroll
    for (int i = 0; i < 8; ++i) { u32x2 o; o.x = pk2(v[i].x, v[i].y); o.y = pk2(v[i].z, v[i].w); *(LAS u32x2*)(tile + (8 * wave + i) * TT_LD + 4 * lane) = o; }
    asm volatile("s_waitcnt lgkmcnt(0)" ::: "memory"); __builtin_amdgcn_s_barrier(); asm volatile("" ::: "memory");
    const int r16 = lane & 15, g4 = lane >> 4;
#pragma unroll
    for (int j = 0; j < 4; ++j) { const int it = wave * 4 + j, cg = it >> 1, hh = it & 1;
        const LAS bf16* p = tile + (32 * hh + 8 * g4 + (r16 >> 2)) * TT_LD + 16 * cg + 4 * (r16 & 3);
        const s16x4 lo = __builtin_bit_cast(s16x4, __builtin_amdgcn_ds_read_tr16_b64_v4i16((LAS s16x4*)p));
        const s16x4 hi = __builtin_bit_cast(s16x4, __builtin_amdgcn_ds_read_tr16_b64_v4i16((LAS s16x4*)(p + 4 * TT_LD)));
        const bf16x8 o = __builtin_shufflevector(lo, hi, 0, 1, 2, 3, 4, 5, 6, 7);
        *(GAS bf16x8*)(WT + (size_t)(n0 + 16 * cg + r16) * Kdst + k0 + 32 * hh + 8 * g4) = o; }
}
struct TItem { const float* p0; const float* p1; int pitch; bf16* WT; int Kdst, k0, n0; };
struct TAddr { const float* p0; const float* p1; int pitch;
    __device__ __forceinline__ const float* operator()(int k, int n4) const { return (n4 < 128 ? p0 : p1) + (size_t)k * pitch + (n4 & 127); } };
template <class Decode>
__device__ __forceinline__ void wgt_run(const Decode& decode, int nit, Frame& F) {
    LAS bf16* tile0 = (LAS bf16*)F.lds; LAS bf16* tile1 = (LAS bf16*)(F.lds + 64 * TT_LD * 2);
    f32x4 v[8], v2[8];
    int it = F.bid; int par = 0;
    TItem cur; if (it < nit) { cur = decode(it); wgt_load(TAddr{cur.p0, cur.p1, cur.pitch}, cur.k0, F.wave, F.lane, v); }
    while (it < nit) {
        const int nx = it + F.G; TItem nxt = cur;
        if (nx < nit) { nxt = decode(nx); wgt_load(TAddr{nxt.p0, nxt.p1, nxt.pitch}, nxt.k0, F.wave, F.lane, v2); }
        wgt_emit(par ? tile1 : tile0, v, cur.WT, cur.Kdst, cur.k0, cur.n0, F.wave, F.lane);
#pragma unroll
        for (int i = 0; i < 8; ++i) v[i] = v2[i];
        cur = nxt; it = nx; par ^= 1;
    }
}
__device__ __forceinline__ int cd_src_col(int n) {
    if (n < 2304) return n;
    if (n < 2816) return 2384 + (n - 2304);
    if (n < 3328) return 2896 + (n - 2816);
    if (n < 4352) return 3408 + (n - 3328);
    if (n < 5376) return 4440 + (n - 4352);
    if (n < 5440) return 2304 + (n - 5376);
    if (n < 5456) return 2368 + (n - 5440);
    if (n < 5460) return 4432 + (n - 5456);
    if (n < 5464) return 4436 + (n - 5460);
    return -1;
}
__device__ __forceinline__ void load_w16_T(LAS float* WT, const float* W, int ld, int col0, int tid) {
#pragma unroll 4
    for (int i = tid; i < 2048 * 4; i += 512) { const int k = i >> 2, e4 = (i & 3) * 4; const f32x4 w = *(const f32x4*)(W + (size_t)k * ld + col0 + e4);
        WT[(e4 + 0) * 2048 + k] = w.x; WT[(e4 + 1) * 2048 + k] = w.y; WT[(e4 + 2) * 2048 + k] = w.z; WT[(e4 + 3) * 2048 + k] = w.w; }
}
template <bool WBF16>
__device__ __forceinline__ void row_dot16(const f32x4 (&v)[8], const LAS void* WTv, int lane, float (&out)[16]) {
    float s[16];
#pragma unroll
    for (int e = 0; e < 16; ++e) { float a = 0.f;
        if (WBF16) { const LAS bf16* WT = (const LAS bf16*)WTv;
#pragma unroll
            for (int j = 0; j < 8; ++j) { const u32x2 w = *(const LAS u32x2*)(WT + e * 2048 + 256 * j + 4 * lane); a += (v[j].x * bflo(w.x) + v[j].y * bfhi(w.x)) + (v[j].z * bflo(w.y) + v[j].w * bfhi(w.y)); } }
        else { const LAS float* WT = (const LAS float*)WTv;
#pragma unroll
            for (int j = 0; j < 8; ++j) { const f32x4 w = *(const LAS f32x4*)(WT + e * 2048 + 256 * j + 4 * lane); a += (v[j].x * w.x + v[j].y * w.y) + (v[j].z * w.z + v[j].w * w.w); } }
        s[e] = a; __builtin_amdgcn_sched_barrier(0); }
#define RD_STEP(N, XOR) { const bool hi_ = (lane & (XOR)) != 0; _Pragma("unroll") for (int j = 0; j < (N); ++j) { const float send = hi_ ? s[j] : s[(N) + j]; const float keep = hi_ ? s[(N) + j] : s[j]; s[j] = keep + __shfl_xor(send, (XOR)); } }
    RD_STEP(8, 32) RD_STEP(4, 16) RD_STEP(2, 8) RD_STEP(1, 4)
#undef RD_STEP
    float r = s[0]; r += __shfl_xor(r, 2); r += __shfl_xor(r, 1);
#pragma unroll
    for (int e = 0; e < 16; ++e) out[e] = __builtin_bit_cast(float, __builtin_amdgcn_readlane(__builtin_bit_cast(int, r), (((e >> 3) & 1) << 5) | (((e >> 2) & 1) << 4) | (((e >> 1) & 1) << 3) | ((e & 1) << 2)));
}
template <bool WBF16>
__device__ __forceinline__ void row_dot16x2(const f32x4 (&v0)[8], const f32x4 (&v1)[8], const LAS void* WTv, int lane, float (&out0)[16], float (&out1)[16]) {
    float s[16], q[16];
#pragma unroll
    for (int e = 0; e < 16; ++e) { float a = 0.f, b = 0.f;
        if (WBF16) { const LAS bf16* WT = (const LAS bf16*)WTv;
#pragma unroll
            for (int j = 0; j < 8; ++j) { const u32x2 w = *(const LAS u32x2*)(WT + e * 2048 + 256 * j + 4 * lane); const float w0 = bflo(w.x), w1 = bfhi(w.x), w2 = bflo(w.y), w3 = bfhi(w.y);
                a += (v0[j].x * w0 + v0[j].y * w1) + (v0[j].z * w2 + v0[j].w * w3); b += (v1[j].x * w0 + v1[j].y * w1) + (v1[j].z * w2 + v1[j].w * w3); } }
        else { const LAS float* WT = (const LAS float*)WTv;
#pragma unroll
            for (int j = 0; j < 8; ++j) { const f32x4 w = *(const LAS f32x4*)(WT + e * 2048 + 256 * j + 4 * lane);
                a += (v0[j].x * w.x + v0[j].y * w.y) + (v0[j].z * w.z + v0[j].w * w.w); b += (v1[j].x * w.x + v1[j].y * w.y) + (v1[j].z * w.z + v1[j].w * w.w); } }
        s[e] = a; q[e] = b; __builtin_amdgcn_sched_barrier(0); }
#define RD_STEP2(N, XOR) { const bool hi_ = (lane & (XOR)) != 0; _Pragma("unroll") for (int j = 0; j < (N); ++j) { \
        { const float send = hi_ ? s[j] : s[(N) + j]; const float keep = hi_ ? s[(N) + j] : s[j]; s[j] = keep + __shfl_xor(send, (XOR)); } \
        { const float send = hi_ ? q[j] : q[(N) + j]; const float keep = hi_ ? q[(N) + j] : q[j]; q[j] = keep + __shfl_xor(send, (XOR)); } } }
    RD_STEP2(8, 32) RD_STEP2(4, 16) RD_STEP2(2, 8) RD_STEP2(1, 4)
#undef RD_STEP2
    float r = s[0]; r += __shfl_xor(r, 2); r += __shfl_xor(r, 1);
    float r2 = q[0]; r2 += __shfl_xor(r2, 2); r2 += __shfl_xor(r2, 1);
#pragma unroll
    for (int e = 0; e < 16; ++e) { const int sl = (((e >> 3) & 1) << 5) | (((e >> 2) & 1) << 4) | (((e >> 1) & 1) << 3) | ((e & 1) << 2);
        out0[e] = __builtin_bit_cast(float, __builtin_amdgcn_readlane(__builtin_bit_cast(int, r), sl)); out1[e] = __builtin_bit_cast(float, __builtin_amdgcn_readlane(__builtin_bit_cast(int, r2), sl)); }
}
__device__ __forceinline__ void store_row_bf16(bf16* orow, const f32x4 (&v)[8], int lane) {
    GAS unsigned long long* o8 = (GAS unsigned long long*)orow + lane;
#pragma unroll
    for (int j = 0; j < 8; ++j) o8[64 * j] = (unsigned long long)pk2(v[j].x, v[j].y) | ((unsigned long long)pk2(v[j].z, v[j].w) << 32);
}
__device__ __forceinline__ float log_sigmoid_(float z) { return -(fmaxf(-z, 0.f) + __logf(1.0f + __expf(-fabsf(z)))); }

__device__ __forceinline__ void p0_prologue(const Args& args, Frame& F) {
    LAS float* scr = (LAS float*)(F.lds + F.wave * 16384);
    const int gw = F.bid * 8 + F.wave, NGW = F.G * 8;
    unsigned char* ws = args.ws;
    { const int gt = F.bid * 512 + F.tid; if (gt < 1024) { const float a = args.in[I_LBLOG][gt], b = args.in[I_LBLOG][1024 + gt]; const float m = fmaxf(a, b); const float ea = __expf(a - m), eb = __expf(b - m); ((float*)(ws + WS_LB))[gt] = ea / (ea + eb); } }
    {
        const float* wab = args.in[I_WINAB]; const float* woab = args.in[I_WOUTAB]; const float* wcd = args.in[I_WINCD]; const float* wocd = args.in[I_WOUTCD];
        constexpr int J0 = 32 * 28, J1 = 32 * 8, J2 = 32 * 21, J3 = 32 * 8;
        for (int rep_ = 0; rep_ < ((PROBE_REPCONV & 2) ? 2 : 1); ++rep_)
        wgt_run([&](int it) { TItem t; int r = it;
            if (r < J0) { const int kb = r / 28, nb = r % 28; t.p0 = wab + 256 * nb; t.p1 = t.p0 + 128; t.pitch = PSRC_AB; t.WT = (bf16*)(ws + WS_WINAB); t.Kdst = 2048; t.k0 = 64 * kb; t.n0 = 256 * nb; return t; } r -= J0;
            if (r < J1) { const int kb = r / 8, nb = r % 8; t.p0 = woab + 256 * nb; t.p1 = t.p0 + 128; t.pitch = 2048; t.WT = (bf16*)(ws + WS_WOUTAB); t.Kdst = 2048; t.k0 = 64 * kb; t.n0 = 256 * nb; return t; } r -= J1;
            if (r < J2) { const int kb = r / 21, nb = r % 21; t.p0 = wcd + cd_src_col(256 * nb); t.p1 = t.p0 + 128; t.pitch = PSRC_CD; t.WT = (bf16*)(ws + WS_WINCD); t.Kdst = 2048; t.k0 = 64 * kb; t.n0 = 256 * nb; return t; } r -= J2;
            { const int kb = r / 8, nb = r % 8; t.p0 = wocd + 256 * nb; t.p1 = t.p0 + 128; t.pitch = 2048; t.WT = (bf16*)(ws + WS_WOUTCD); t.Kdst = 2048; t.k0 = 64 * kb; t.n0 = 256 * nb; return t; }
        }, J0 + J1 + J2 + J3, F);
        __syncthreads();
    }
    constexpr int I2 = 32 * 8, I4 = 4 * 64, I5 = 4 * 64;
    constexpr int NIT = I2 + I4 + I5;
    for (int it = gw; it < NIT; it += NGW) {
        int r = it;
        if (r < I2) { const float* W = args.in[I_WINCD]; transpose_item([&](int k, int n) { const int sc = cd_src_col(n); return sc >= 0 ? W[(size_t)k * PSRC_CD + sc] : 0.f; }, 2048, (bf16*)(ws + WS_WINCD), scr, r / 8, 168 + r % 8, F.lane); continue; } r -= I2;
        if (r < I4) { const float* W = args.in[I_WUK];
            transpose_item([&](int k, int n) { const int h = n >> 8, c = n & 255; return k < 128 ? W[(size_t)c * 1024 + h * 128 + k] * 0.08838834764831845f : 0.f; }, 256, (bf16*)(ws + WS_WUK), scr, r / 64, r % 64, F.lane); continue; } r -= I4;
        { const float* W = args.in[I_WUV];
            transpose_item([&](int k, int n) { const int h = n >> 8, d = n & 255; return d < 128 ? W[(size_t)k * 1024 + h * 128 + d] : 0.f; }, 256, (bf16*)(ws + WS_WUV), scr, r / 64, r % 64, F.lane); }
    }
    __syncthreads();
    LAS bf16* WT = (LAS bf16*)F.lds;
    LAS float* wa2 = (LAS float*)(F.lds + 65536);
#pragma unroll 4
    for (int i = F.tid; i < 2048 * 4; i += 512) { const int k = i >> 2, e4 = (i & 3) * 4; const f32x4 w = *(const f32x4*)(args.in[I_WINAB] + (size_t)k * PSRC_AB + 7168 + e4);
        WT[(e4 + 0) * 2048 + k] = (bf16)f2bf(w.x); WT[(e4 + 1) * 2048 + k] = (bf16)f2bf(w.y); WT[(e4 + 2) * 2048 + k] = (bf16)f2bf(w.z); WT[(e4 + 3) * 2048 + k] = (bf16)f2bf(w.w); }
    for (int i = F.tid; i < 16 * 128; i += 512) *(LAS f32x4*)(wa2 + 4 * i) = *(const f32x4*)(args.in[I_WA2] + 4 * i);
    __syncthreads();
    const float* ba2 = args.in[I_BA2];
    for (int rep_ = 0; rep_ < ((PROBE_REPCONV & 4) ? 2 : 1); ++rep_)
    for (int m = gw; m < T; m += NGW) {
        const GAS f32x4* xr = (const GAS f32x4*)(args.in[I_X] + (size_t)m * D) + F.lane;
        f32x4 v[8];
#pragma unroll
        for (int j = 0; j < 8; ++j) v[j] = xr[64 * j];
        store_row_bf16((bf16*)(ws + WS_XB) + (size_t)m * D, v, F.lane);
        float ba[16]; row_dot16<true>(v, WT, F.lane, ba);
        f32x4 z0 = *(const f32x4*)(ba2 + 8 * F.lane), z1 = *(const f32x4*)(ba2 + 8 * F.lane + 4);
#pragma unroll
        for (int r = 0; r < 16; ++r) { const f32x4 w0 = *(const LAS f32x4*)(wa2 + r * 512 + 8 * F.lane), w1 = *(const LAS f32x4*)(wa2 + r * 512 + 8 * F.lane + 4); z0 += w0 * ba[r]; z1 += w1 * ba[r]; }
        u32x4 o; o.x = pk2(log_sigmoid_(z0.x) * 0.0625f, log_sigmoid_(z0.y) * 0.0625f); o.y = pk2(log_sigmoid_(z0.z) * 0.0625f, log_sigmoid_(z0.w) * 0.0625f);
        o.z = pk2(log_sigmoid_(z1.x) * 0.0625f, log_sigmoid_(z1.y) * 0.0625f); o.w = pk2(log_sigmoid_(z1.z) * 0.0625f, log_sigmoid_(z1.w) * 0.0625f);
        *(GAS u32x4*)((bf16*)(ws + WS_LAB) + (size_t)m * 512 + 8 * F.lane) = o;
    }
}

template <int MODE, bool XF32, bool OUTF32>
__device__ __forceinline__ void ln_phase(const Args& args, Frame& F, int layer, const float* xin) {
    unsigned char* ws = args.ws;
    const int gw = F.bid * 8 + F.wave, NGW = F.G * 8;
    if (MODE == 0) {
        LAS float* scr = (LAS float*)(F.lds + F.wave * 16384);
        const float* w1 = args.in[I_W1] + (size_t)layer * NE * 2048 * 512; const float* w3 = args.in[I_W3] + (size_t)layer * NE * 2048 * 512; const float* w2 = args.in[I_W2] + (size_t)layer * NE * 512 * 2048;
        constexpr int IA = 16 * 32 * 4, IB = 16 * 8 * 8;
        for (int rep_ = 0; rep_ < ((PROBE_REPCONV & 1) ? 2 : 1); ++rep_)
        wgt_run([&](int it) { TItem t;
            if (it < IA) { const int e = it >> 7, r = it & 127, kb = r >> 2, pn = r & 3;
                t.p0 = w1 + (size_t)e * 2048 * 512 + 128 * pn; t.p1 = w3 + (size_t)e * 2048 * 512 + 128 * pn; t.pitch = 512; t.WT = (bf16*)(ws + WS_W13) + (size_t)e * 1024 * 2048; t.Kdst = 2048; t.k0 = 64 * kb; t.n0 = 256 * pn; return t; }
            const int r0 = it - IA; const int e = r0 >> 6, r = r0 & 63, kb = r >> 3, nb = r & 7;
            t.p0 = w2 + (size_t)e * 512 * 2048 + 256 * nb; t.p1 = t.p0 + 128; t.pitch = 2048; t.WT = (bf16*)(ws + WS_W2T) + (size_t)e * 2048 * 512; t.Kdst = 512; t.k0 = 64 * kb; t.n0 = 256 * nb; return t;
        }, IA + IB, F);
        (void)scr;
        __syncthreads();
        load_w16_T((LAS float*)F.lds, args.in[I_WR], 16, 0, F.tid);
        __syncthreads();
    }
    const float* g = args.in[I_LNG] + (layer * 2 + MODE) * D; const float* bb = args.in[I_LNB] + (layer * 2 + MODE) * D;
    const bf16* tmp = (const bf16*)(ws + WS_TMP);
    const bf16* xbin = (const bf16*)(ws + WS_XB);
    const bf16* ys = (const bf16*)(ws + WS_R2);
    auto ln_row = [&](const int m, f32x4 (&v)[8], const bool wr) {
        float s = 0.f;
        if (XF32) { const GAS f32x4* xr = (const GAS f32x4*)(xin + (size_t)m * D) + F.lane;
#pragma unroll
            for (int j = 0; j < 8; ++j) v[j] = xr[64 * j] * DN_ALPHA; }
        else { const GAS u32x2* xr = (const GAS u32x2*)(xbin + (size_t)m * D) + F.lane;
#pragma unroll
            for (int j = 0; j < 8; ++j) { const u32x2 a = xr[64 * j]; v[j] = (f32x4){bflo(a.x), bfhi(a.x), bflo(a.y), bfhi(a.y)} * DN_ALPHA; } }
        if (MODE == 0) { const GAS u32x2* tr = (const GAS u32x2*)(tmp + (size_t)m * D) + F.lane;
#pragma unroll
            for (int j = 0; j < 8; ++j) { const u32x2 a = tr[64 * j]; v[j] += (f32x4){bflo(a.x), bfhi(a.x), bflo(a.y), bfhi(a.y)}; } }
        else { const GAS u32x2* y0 = (const GAS u32x2*)(ys + (size_t)m * D) + F.lane; const GAS u32x2* y1 = (const GAS u32x2*)(ys + ((size_t)T + m) * D) + F.lane;
#pragma unroll
            for (int j = 0; j < 8; ++j) { const u32x2 a = y0[64 * j], b = y1[64 * j]; f32x4 y; y.x = bflo(a.x) + bflo(b.x); y.y = bfhi(a.x) + bfhi(b.x); y.z = bflo(a.y) + bflo(b.y); y.w = bfhi(a.y) + bfhi(b.y);
                v[j] += y; } }
#pragma unroll
        for (int j = 0; j < 8; ++j) s += (v[j].x + v[j].y) + (v[j].z + v[j].w);
        const float mean = wave_sum(s) * (1.f / D); float s2 = 0.f;
#pragma unroll
        for (int j = 0; j < 8; ++j) { v[j] = v[j] - mean; s2 += (v[j].x * v[j].x + v[j].y * v[j].y) + (v[j].z * v[j].z + v[j].w * v[j].w); }
        const float rstd = 1.f / sqrtf(wave_sum(s2) * (1.f / D) + EPS);
#pragma unroll
        for (int j = 0; j < 8; ++j) { const f32x4 gg = *(const f32x4*)(g + 256 * j + 4 * F.lane), bv = *(const f32x4*)(bb + 256 * j + 4 * F.lane); v[j] = v[j] * rstd * gg + bv; }
        if (OUTF32 && wr) { GAS f32x4* orow = (GAS f32x4*)(args.out + (size_t)m * D) + F.lane;
#pragma unroll
            for (int j = 0; j < 8; ++j) orow[64 * j] = v[j]; }
        if (!OUTF32 && wr) store_row_bf16((bf16*)(ws + WS_XB) + (size_t)m * D, v, F.lane);
    };
    auto route = [&](const int m, const float (&lg)[16], const bool wr) {
            const float* br = args.in[I_BR];
            float aff[16], sel[16];
#pragma unroll
            for (int e = 0; e < 16; ++e) { aff[e] = sigmoidf_(lg[e]); sel[e] = aff[e] + br[e]; }
            float best = -3.0e38f; int bi1 = 0, bi2 = 1; float ba1 = 0.f, ba2_ = 0.f;
#pragma unroll
            for (int gq = 0; gq < 4; ++gq) {
                int i1 = 0; float s1 = sel[4 * gq];
#pragma unroll
                for (int j = 1; j < 4; ++j) if (sel[4 * gq + j] > s1) { s1 = sel[4 * gq + j]; i1 = j; }
                int i2 = -1; float s2v = -3.0e38f;
#pragma unroll
                for (int j = 0; j < 4; ++j) if (j != i1 && sel[4 * gq + j] > s2v) { s2v = sel[4 * gq + j]; i2 = j; }
                const float sc = s1 + s2v;
                float a1 = 0.f, a2 = 0.f;
#pragma unroll
                for (int j = 0; j < 4; ++j) { a1 = (j == i1) ? aff[4 * gq + j] : a1; a2 = (j == i2) ? aff[4 * gq + j] : a2; }
                if (sc > best) { best = sc; bi1 = 4 * gq + i1; bi2 = 4 * gq + i2; ba1 = a1; ba2_ = a2; }
            }
            if (F.lane == 0 && wr) {
                const float inv = 1.0f / (ba1 + ba2_);
                unsigned* cnt = (unsigned*)(F.ctl + CW_CNT) + layer * 16 * 64;
                const unsigned p1 = __hip_atomic_fetch_add(cnt + bi1 * 64, 1u, RLX_AGENT), p2 = __hip_atomic_fetch_add(cnt + bi2 * 64, 1u, RLX_AGENT);
                int* list = (int*)(ws + WS_LIST); float* wl = (float*)(ws + WS_WL);
                list[bi1 * 16384 + p1] = m; wl[bi1 * 16384 + p1] = ba1 * inv;
                list[bi2 * 16384 + p2] = m | (int)0x80000000; wl[bi2 * 16384 + p2] = ba2_ * inv;
            }
    };
    if (MODE == 0) {
        for (int m0 = gw; m0 < T; m0 += 2 * NGW) {
            const bool has1 = m0 + NGW < T; const int m1 = has1 ? m0 + NGW : m0;
            f32x4 v0[8], v1[8];
            ln_row(m0, v0, true); ln_row(m1, v1, has1);
            float lg0[16], lg1[16]; row_dot16x2<false>(v0, v1, (const LAS float*)F.lds, F.lane, lg0, lg1);
            route(m0, lg0, true); route(m1, lg1, has1);
        }
    } else {
        for (int m = gw; m < T; m += NGW) { f32x4 v[8]; ln_row(m, v, true); }
    }
}
__device__ __forceinline__ f32x4 mfma16(bf16x8 a, bf16x8 b, f32x4 c) { return __builtin_amdgcn_mfma_f32_16x16x32_bf16(a, b, c, 0, 0, 0); }
__device__ __forceinline__ bf16x8 lds_frag(const LAS bf16* M, int ld, int r0, int k0, int lane) { return *(const LAS bf16x8*)(M + (r0 + (lane & 15)) * ld + k0 + 8 * (lane >> 4)); }

constexpr int H0_AQ = 0, H0_AF = 1024, H0_AI = 2048, H0_AG = 3072, H0_BQ = 4096, H0_BK = 4608, H0_BV = 5120, H0_BG = 6144;
constexpr int LDK = 72, LDQ = 136;

template <int DV>
__device__ __forceinline__ void stage_vt(LAS bf16* VT, const bf16* V, int ldv, int tid) {
    constexpr int NS = 64 * DV / 512;
    const int e = tid % DV, sq = tid / DV;
    unsigned w[NS / 2];
#pragma unroll
    for (int i = 0; i < NS / 2; ++i) { const unsigned a = V[(size_t)(sq * NS + 2 * i) * ldv + e], b = V[(size_t)(sq * NS + 2 * i + 1) * ldv + e]; w[i] = a | (b << 16); }
#pragma unroll
    for (int i = 0; i < NS / 8; ++i) { u32x4 o; o.x = w[4 * i]; o.y = w[4 * i + 1]; o.z = w[4 * i + 2]; o.w = w[4 * i + 3]; *(LAS u32x4*)(VT + e * LDK + sq * NS + 8 * i) = o; }
}

template <int DV, bool IS_A>
__device__ __forceinline__ void ab_a_unit(const Args& args, Frame& F, int b, int n, int h) {
    unsigned char* ws = args.ws;
    const bf16* h0 = (const bf16*)(ws + WS_R1);
    const bf16* lab = (const bf16*)(ws + WS_LAB);
    const int t0 = b * SEQ + n * 64, tid = F.tid, lane = F.lane, w = F.wave;
    LAS bf16* KT = (LAS bf16*)F.lds;
    LAS bf16* VT = (LAS bf16*)(F.lds + 18432);
    LAS float* part = (LAS float*)(F.lds + 18432 + 36864);
    const int d = tid & 127, tq = tid >> 7;
    float lfv[16], kv[16]; float loc = 0.f;
#pragma unroll
    for (int i = 0; i < 16; ++i) { const size_t row = (size_t)(t0 + 16 * tq + i);
        if (IS_A) { lfv[i] = bf2f(h0[row * N_AB + H0_AF + h * 128 + d]); kv[i] = -expm1f(lfv[i]); }
        else { lfv[i] = bf2f(lab[row * 512 + h * 128 + d]); kv[i] = bf2f(h0[row * N_AB + H0_BK + h * 128 + d]); }
        loc += lfv[i]; }
    part[tq * 128 + d] = loc;
    stage_vt<DV>(VT, h0 + (size_t)t0 * N_AB + (IS_A ? H0_AI + h * 128 : H0_BV + h * 256), N_AB, tid);
    __syncthreads();
    float pre = 0.f, tot = 0.f;
#pragma unroll
    for (int j = 0; j < 4; ++j) { const float p = part[j * 128 + d]; tot += p; pre += (j < tq) ? p : 0.f; }
    { float bc = pre; unsigned wv[8];
#pragma unroll
        for (int i = 0; i < 16; i += 2) { bc += lfv[i]; const float k0 = kv[i] * __expf(tot - bc); bc += lfv[i + 1]; const float k1 = kv[i + 1] * __expf(tot - bc); wv[i >> 1] = pk2(k0, k1); }
        u32x4 o0, o1; o0.x = wv[0]; o0.y = wv[1]; o0.z = wv[2]; o0.w = wv[3]; o1.x = wv[4]; o1.y = wv[5]; o1.z = wv[6]; o1.w = wv[7];
        *(LAS u32x4*)(KT + d * LDK + 16 * tq) = o0; *(LAS u32x4*)(KT + d * LDK + 16 * tq + 8) = o1; }
    if (tq == 0) { float* G = (float*)(ws + (IS_A ? WS_GA : WS_GB)); G[(size_t)((b * NCH + n) * (IS_A ? 8 : 4) + h) * 128 + d] = __expf(tot); }
    __syncthreads();
    bf16* U = (bf16*)(ws + WS_R2) + (IS_A ? (size_t)((b * NCH + n) * 8 + h) * 128 * 128 : (size_t)64 * MiB / 2 + (size_t)((b * NCH + n) * 4 + h) * 256 * 128);
    const bf16x8 a0 = lds_frag(KT, LDK, 16 * w, 0, lane), a1 = lds_frag(KT, LDK, 16 * w, 32, lane);
#pragma unroll 4
    for (int et = 0; et < DV / 16; ++et) {
        f32x4 acc = {0.f, 0.f, 0.f, 0.f};
        acc = mfma16(a0, lds_frag(VT, LDK, 16 * et, 0, lane), acc);
        acc = mfma16(a1, lds_frag(VT, LDK, 16 * et, 32, lane), acc);
        u32x2 o; o.x = pk2(acc[0], acc[1]); o.y = pk2(acc[2], acc[3]);
        *(GAS u32x2*)(U + (size_t)(16 * et + (lane & 15)) * 128 + 16 * w + 4 * (lane >> 4)) = o;
    }
    __syncthreads();
}

__device__ __forceinline__ void ab_scan(const Args& args, Frame& F) {
    unsigned char* ws = args.ws;
    const int NT_A = BATCH * 8 * 128 * 16, NT_B = BATCH * 4 * 256 * 16;
    for (int gt = F.bid * 512 + F.tid; gt < NT_A + NT_B; gt += F.G * 512) {
        const bool isA = gt < NT_A; const int r = isA ? gt : gt - NT_A;
        const int d8 = r & 15; int e, h, b, H, DV;
        if (isA) { e = (r >> 4) & 127; h = (r >> 11) & 7; b = r >> 14; H = 8; DV = 128; } else { e = (r >> 4) & 255; h = (r >> 12) & 3; b = r >> 14; H = 4; DV = 256; }
        bf16* S = (bf16*)(ws + WS_R2) + (isA ? (size_t)0 : (size_t)64 * MiB / 2);
        const float* G = (const float*)(ws + (isA ? WS_GA : WS_GB));
        float st[8];
#pragma unroll
        for (int j = 0; j < 8; ++j) st[j] = 0.f;
#pragma unroll 4
        for (int n = 0; n < NCH; ++n) {
            GAS u32x4* p = (GAS u32x4*)(S + ((size_t)((b * NCH + n) * H + h) * DV + e) * 128 + 8 * d8);
            const float* gp = G + (size_t)((b * NCH + n) * H + h) * 128 + 8 * d8;
            const u32x4 u = *p; const f32x4 g0 = *(const f32x4*)gp, g1 = *(const f32x4*)(gp + 4);
            u32x4 o; o.x = pk2(st[0], st[1]); o.y = pk2(st[2], st[3]); o.z = pk2(st[4], st[5]); o.w = pk2(st[6], st[7]);
            *p = o;
            st[0] = g0.x * st[0] + bflo(u.x); st[1] = g0.y * st[1] + bfhi(u.x); st[2] = g0.z * st[2] + bflo(u.y); st[3] = g0.w * st[3] + bfhi(u.y);
            st[4] = g1.x * st[4] + bflo(u.z); st[5] = g1.y * st[5] + bfhi(u.z); st[6] = g1.z * st[6] + bflo(u.w); st[7] = g1.w * st[7] + bfhi(u.w);
        }
    }
}

template <int DV, bool IS_A>
__device__ __forceinline__ void ab_c_unit(const Args& args, Frame& F, int b, int n, int h) {
    unsigned char* ws = args.ws;
    const bf16* h0 = (const bf16*)(ws + WS_R1);
    const bf16* lab = (const bf16*)(ws + WS_LAB);
    const int t0 = b * SEQ + n * 64, tid = F.tid, lane = F.lane, w = F.wave, r16 = lane & 15, g4 = lane >> 4;
    LAS bf16* Qs = (LAS bf16*)F.lds;
    LAS bf16* Ks = (LAS bf16*)(F.lds + 17408);
    LAS bf16* P = (LAS bf16*)(F.lds + 34816);
    LAS bf16* VT = (LAS bf16*)(F.lds + 44032);
    LAS float* part = (LAS float*)(F.lds + 80896);
    LAS float* red = (LAS float*)(F.lds + 82944);
    const int d = tid & 127, tq = tid >> 7;
    float lfv[16], qv[16], kv[16]; float loc = 0.f;
#pragma unroll
    for (int i = 0; i < 16; ++i) { const size_t row = (size_t)(t0 + 16 * tq + i);
        if (IS_A) { lfv[i] = bf2f(h0[row * N_AB + H0_AF + h * 128 + d]); kv[i] = -expm1f(lfv[i]); qv[i] = bf2f(h0[row * N_AB + H0_AQ + h * 128 + d]); }
        else { lfv[i] = bf2f(lab[row * 512 + h * 128 + d]); kv[i] = bf2f(h0[row * N_AB + H0_BK + h * 128 + d]); qv[i] = bf2f(h0[row * N_AB + H0_BQ + h * 128 + d]); }
        loc += lfv[i]; }
    part[tq * 128 + d] = loc;
    stage_vt<DV>(VT, h0 + (size_t)t0 * N_AB + (IS_A ? H0_AI + h * 128 : H0_BV + h * 256), N_AB, tid);
    __syncthreads();
    { float pre = 0.f;
#pragma unroll
        for (int j = 0; j < 4; ++j) { const float p = part[j * 128 + d]; pre += (j < tq) ? p : 0.f; }
        float bc = pre;
#pragma unroll
        for (int i = 0; i < 16; ++i) { bc += lfv[i]; const int t = 16 * tq + i;
            Qs[t * LDQ + d] = (bf16)f2bf(qv[i] * __expf(bc)); Ks[t * LDQ + d] = (bf16)f2bf(kv[i] * __expf(fminf(-bc, 80.f))); } }
    __syncthreads();
    { const int mi = w >> 1;
#pragma unroll
        for (int q = 0; q < 2; ++q) { const int ni = 2 * (w & 1) + q; f32x4 acc = {0.f, 0.f, 0.f, 0.f};
            if (ni <= mi) {
#pragma unroll
                for (int ks = 0; ks < 4; ++ks) acc = mfma16(lds_frag(Qs, LDQ, 16 * mi, 32 * ks, lane), lds_frag(Ks, LDQ, 16 * ni, 32 * ks, lane), acc); }
            const int s = 16 * ni + r16;
#pragma unroll
            for (int j = 0; j < 4; ++j) { const int t = 16 * mi + 4 * g4 + j; P[t * LDK + s] = (bf16)f2bf((ni <= mi && s <= t) ? acc[j] : 0.f); } } }
    __syncthreads();
    constexpr int NE2 = DV / 32;
    const int mi = w & 3, e0 = (w >> 2) * (DV / 2);
    const bf16* S = (const bf16*)(ws + WS_R2) + (IS_A ? (size_t)((b * NCH + n) * 8 + h) * 128 * 128 : (size_t)64 * MiB / 2 + (size_t)((b * NCH + n) * 4 + h) * 256 * 128);
    f32x4 acc[NE2];
    { const bf16x8 p0 = lds_frag(P, LDK, 16 * mi, 0, lane), p1 = lds_frag(P, LDK, 16 * mi, 32, lane);
        bf16x8 qf[4];
#pragma unroll
        for (int ks = 0; ks < 4; ++ks) qf[ks] = lds_frag(Qs, LDQ, 16 * mi, 32 * ks, lane);
#pragma unroll
        for (int i = 0; i < NE2; ++i) { const int et0 = e0 + 16 * i; f32x4 a = {0.f, 0.f, 0.f, 0.f};
            a = mfma16(p0, lds_frag(VT, LDK, et0, 0, lane), a); a = mfma16(p1, lds_frag(VT, LDK, et0, 32, lane), a);
            if (n > 0) {
#pragma unroll
                for (int ks = 0; ks < 4; ++ks) { const bf16x8 sf = *(const GAS bf16x8*)(S + (size_t)(et0 + r16) * 128 + 32 * ks + 8 * g4); a = mfma16(qf[ks], sf, a); } }
            acc[i] = a; } }
    float ss[4];
#pragma unroll
    for (int j = 0; j < 4; ++j) { float s = 0.f;
#pragma unroll
        for (int i = 0; i < NE2; ++i) s += acc[i][j] * acc[i][j];
        s += __shfl_xor(s, 1); s += __shfl_xor(s, 2); s += __shfl_xor(s, 4); s += __shfl_xor(s, 8); ss[j] = s; }
    if (r16 == 0) {
#pragma unroll
        for (int j = 0; j < 4; ++j) red[w * 16 + 4 * g4 + j] = ss[j]; }
    __syncthreads();
    const float* gn = args.in[IS_A ? I_ANORM : I_BNORM];
    const int gcol = IS_A ? H0_AG + h * 128 : H0_BG + h * 256, ocol = IS_A ? h * 128 : 1024 + h * 256;
    bf16* mixed = (bf16*)(ws + WS_MIX);
#pragma unroll
    for (int j = 0; j < 4; ++j) { const float tot = red[w * 16 + 4 * g4 + j] + red[(w ^ 4) * 16 + 4 * g4 + j]; const float rstd = 1.0f / sqrtf(tot * (1.0f / DV) + EPS);
        const size_t row = (size_t)(t0 + 16 * mi + 4 * g4 + j);
#pragma unroll
        for (int i = 0; i < NE2; ++i) { const int e = e0 + 16 * i + r16; const float gate = bf2f(h0[row * N_AB + gcol + e]);
            mixed[row * D + ocol + e] = (bf16)f2bf(acc[i][j] * rstd * gn[e] * gate); } }
    __syncthreads();
}

__device__ __forceinline__ void ab_phase_a(const Args& args, Frame& F) {
    for (int u = F.bid; u < 3072; u += F.G) {
        if (u < 2048) { const int h = u & 7, n = (u >> 3) & 63, b = u >> 9; ab_a_unit<128, true>(args, F, b, n, h); }
        else { const int v = u - 2048; const int h = v & 3, n = (v >> 2) & 63, b = v >> 8; ab_a_unit<256, false>(args, F, b, n, h); }
    }
}
__device__ __forceinline__ void ab_phase_c(const Args& args, Frame& F) {
    for (int u = F.bid; u < 3072; u += F.G) {
        if (u < 2048) { const int h = u & 7, n = (u >> 3) & 63, b = u >> 9; ab_c_unit<128, true>(args, F, b, n, h); }
        else { const int v = u - 2048; const int h = v & 3, n = (v >> 2) & 63, b = v >> 8; ab_c_unit<256, false>(args, F, b, n, h); }
    }
}
__device__ __forceinline__ int swz128(int r, int c) { return r * 256 + ((((c >> 3) ^ r) & 15) << 4) + (c & 7) * 2; }
__device__ __forceinline__ bf16x8 frag128(const LAS unsigned char* tile, int r0, int k0, int lane) { const int r = r0 + (lane & 15), ch = (k0 >> 3) + (lane >> 4); return *(const LAS bf16x8*)(tile + r * 256 + (((ch ^ r) & 15) << 4)); }
__device__ __forceinline__ bf16x8 tfrag128(const LAS unsigned char* tile, int s0, int c0, int lane) {
    const int r16 = lane & 15, g4 = lane >> 4; const int row = s0 + 8 * g4 + (r16 >> 2), col = c0 + 4 * (r16 & 3);
    const s16x4 lo = __builtin_bit_cast(s16x4, __builtin_amdgcn_ds_read_tr16_b64_v4i16((LAS s16x4*)(tile + swz128(row, col))));
    const s16x4 hi = __builtin_bit_cast(s16x4, __builtin_amdgcn_ds_read_tr16_b64_v4i16((LAS s16x4*)(tile + swz128(row + 4, col))));
    return __builtin_shufflevector(lo, hi, 0, 1, 2, 3, 4, 5, 6, 7);
}
__device__ __forceinline__ void dma_tile128(LAS unsigned char* tile, const bf16* src, size_t pitch, int rows, int wave, int lane) {
    for (int ii = wave; ii < rows / 4; ii += 8) { const int row = 4 * ii + (lane >> 4), ch = ((lane & 15) ^ row) & 15;
        __builtin_amdgcn_global_load_lds((const unsigned*)(src + (size_t)row * pitch + ch * 8), (LAS unsigned*)(tile + ii * 1024), 16, 0, 0); }
}
#define BAR_LDS() do { asm volatile("s_waitcnt lgkmcnt(0)" ::: "memory"); __builtin_amdgcn_s_barrier(); asm volatile("" ::: "memory"); } while (0)
#define BAR_ALL() do { asm volatile("s_waitcnt vmcnt(0) lgkmcnt(0)" ::: "memory"); __builtin_amdgcn_s_barrier(); asm volatile("" ::: "memory"); } while (0)

__device__ __forceinline__ void ab_decode(int u, bool& isA, int& b, int& n, int& h) {
    if (u < 2048) { isA = true; h = u & 7; n = (u >> 3) & 63; b = u >> 9; } else { const int v = u - 2048; isA = false; h = v & 3; n = (v >> 2) & 63; b = v >> 8; }
}
__device__ __forceinline__ void ab_load_raw(const Args& args, int u, int tid, bool need_q, u32x4 (&R)[6]) {
    bool isA; int b, n, h; ab_decode(u, isA, b, n, h);
    const bf16* h0 = (const bf16*)(args.ws + WS_R1); const bf16* lab = (const bf16*)(args.ws + WS_LAB);
    const size_t t0 = (size_t)(b * SEQ + n * 64);
#pragma unroll
    for (int i = 0; i < 2; ++i) { const int cid = tid + 512 * i, row = cid >> 4, ch = cid & 15;
        const bf16* hrow = h0 + (t0 + row) * N_AB + h * 128 + ch * 8;
        R[i] = isA ? *(const GAS u32x4*)(hrow + H0_AF) : *(const GAS u32x4*)(lab + (t0 + row) * 512 + h * 128 + ch * 8);
        if (need_q) R[2 + i] = *(const GAS u32x4*)(hrow + (isA ? H0_AQ : H0_BQ));
        if (!isA) R[4 + i] = *(const GAS u32x4*)(hrow + H0_BK); else R[4 + i] = (u32x4){0u, 0u, 0u, 0u}; }
}
__device__ __forceinline__ void ab_store_raw(LAS unsigned char* LF, LAS unsigned char* Q, LAS unsigned char* K, int tid, bool need_q, bool isA, const u32x4 (&R)[6]) {
#pragma unroll
    for (int i = 0; i < 2; ++i) { const int cid = tid + 512 * i, row = cid >> 4, ch = cid & 15; const int off = row * 256 + (((ch ^ row) & 15) << 4);
        *(LAS u32x4*)(LF + off) = R[i]; if (need_q) *(LAS u32x4*)(Q + off) = R[2 + i]; if (!isA) *(LAS u32x4*)(K + off) = R[4 + i]; }
}

constexpr int C2_LF = 0, C2_Q = 16384, C2_K = 32768, C2_P = 49152, C2_V0 = 58368, C2_S0 = 74752, C2_S1 = 107520, C2_PART = 140288, C2_RED = 142336;
static_assert(C2_RED + 1024 <= LDS_BYTES - 1024, "phase (c) LDS map");

template <bool IS_A>
__device__ __forceinline__ void ab_c_unit2(const Args& args, Frame& F, int b, int n, int h) {
    unsigned char* ws = args.ws; const bf16* h0 = (const bf16*)(ws + WS_R1);
    const int t0 = b * SEQ + n * 64, tid = F.tid, lane = F.lane, w = F.wave, r16 = lane & 15, g4 = lane >> 4;
    LAS unsigned char* LF = F.lds + C2_LF; LAS unsigned char* Q = F.lds + C2_Q; LAS unsigned char* K = F.lds + C2_K;
    LAS bf16* P = (LAS bf16*)(F.lds + C2_P); LAS unsigned char* V0 = F.lds + C2_V0; LAS unsigned char* S0 = F.lds + C2_S0; LAS unsigned char* S1 = F.lds + C2_S1;
    LAS float* part = (LAS float*)(F.lds + C2_PART); LAS float* red = (LAS float*)(F.lds + C2_RED);
    constexpr int DV = IS_A ? 128 : 256;
    const bf16* Sg = (const bf16*)(ws + WS_R2) + (IS_A ? (size_t)((b * NCH + n) * 8 + h) * 128 * 128 : (size_t)64 * MiB / 2 + (size_t)((b * NCH + n) * 4 + h) * 256 * 128);
    const bf16* Vg = h0 + (size_t)t0 * N_AB + (IS_A ? H0_AI + h * 128 : H0_BV + h * 256);
    dma_tile128(V0, Vg, N_AB, 64, w, lane);
    if (n > 0) { dma_tile128(S0, Sg, 128, 128, w, lane); if (!IS_A) dma_tile128(S1, Sg + 128 * 128, 128, 128, w, lane); }
    const int d = tid & 127, tq = tid >> 7;
    float lfv[16]; float loc = 0.f;
#pragma unroll
    for (int i = 0; i < 16; ++i) { lfv[i] = bf2f(*(const LAS bf16*)(LF + swz128(16 * tq + i, d))); loc += lfv[i]; }
    part[tq * 128 + d] = loc;
    BAR_LDS();
    { float pre = 0.f;
#pragma unroll
        for (int j = 0; j < 4; ++j) { const float p = part[j * 128 + d]; pre += (j < tq) ? p : 0.f; }
        float bc = pre;
#pragma unroll
        for (int i = 0; i < 16; ++i) { bc += lfv[i]; const int off = swz128(16 * tq + i, d);
            const float qv = bf2f(*(const LAS bf16*)(Q + off)); const float kv = IS_A ? -expm1f(lfv[i]) : bf2f(*(const LAS bf16*)(K + off));
            *(LAS bf16*)(Q + off) = (bf16)f2bf(qv * __expf(bc)); *(LAS bf16*)(K + off) = (bf16)f2bf(kv * __expf(fminf(-bc, 80.f))); } }
    BAR_LDS();
    if (!IS_A) dma_tile128(LF, Vg + 128, N_AB, 64, w, lane);
    { const int mi = w >> 1;
#pragma unroll
        for (int q2 = 0; q2 < 2; ++q2) { const int ni = 2 * (w & 1) + q2; f32x4 acc = {0.f, 0.f, 0.f, 0.f};
            if (ni <= mi) {
#pragma unroll
                for (int ks = 0; ks < 4; ++ks) acc = mfma16(frag128(K, 16 * ni, 32 * ks, lane), frag128(Q, 16 * mi, 32 * ks, lane), acc); }
            const int t = 16 * mi + r16, s0 = 16 * ni + 4 * g4;
            float pv[4];
#pragma unroll
            for (int j = 0; j < 4; ++j) pv[j] = (ni <= mi && s0 + j <= t) ? acc[j] : 0.f;
            u32x2 o; o.x = pk2(pv[0], pv[1]); o.y = pk2(pv[2], pv[3]);
            *(LAS u32x2*)(P + t * LDK + s0) = o; } }
    const int mi = w & 3, eh = w >> 2;
    constexpr int NH = IS_A ? 1 : 2;
    const int gcol = IS_A ? H0_AG + h * 128 : H0_BG + h * 256, ocol = IS_A ? h * 128 : 1024 + h * 256;
    const size_t row = (size_t)(t0 + 16 * mi + r16);
    u32x2 gwv[NH][4];
#pragma unroll
    for (int hf = 0; hf < NH; ++hf)
#pragma unroll
        for (int i = 0; i < 4; ++i) gwv[hf][i] = *(const GAS u32x2*)(h0 + row * N_AB + gcol + 128 * hf + 64 * eh + 16 * i + 4 * g4);
    BAR_ALL();
    f32x4 acc[NH][4];
    { const bf16x8 p0 = lds_frag(P, LDK, 16 * mi, 0, lane), p1 = lds_frag(P, LDK, 16 * mi, 32, lane);
        bf16x8 qf[4];
#pragma unroll
        for (int ks = 0; ks < 4; ++ks) qf[ks] = frag128(Q, 16 * mi, 32 * ks, lane);
#pragma unroll
        for (int hf = 0; hf < NH; ++hf) { const LAS unsigned char* Vt = hf ? LF : V0; const LAS unsigned char* St = hf ? S1 : S0;
#pragma unroll
            for (int i = 0; i < 4; ++i) { const int e0 = 64 * eh + 16 * i; f32x4 a = {0.f, 0.f, 0.f, 0.f};
                a = mfma16(tfrag128(Vt, 0, e0, lane), p0, a); a = mfma16(tfrag128(Vt, 32, e0, lane), p1, a);
                if (n > 0) {
#pragma unroll
                    for (int ks = 0; ks < 4; ++ks) a = mfma16(frag128(St, e0, 32 * ks, lane), qf[ks], a); }
                acc[hf][i] = a; } } }
    float ss = 0.f;
#pragma unroll
    for (int hf = 0; hf < NH; ++hf)
#pragma unroll
        for (int i = 0; i < 4; ++i)
#pragma unroll
            for (int j = 0; j < 4; ++j) ss += acc[hf][i][j] * acc[hf][i][j];
    ss += __shfl_xor(ss, 16); ss += __shfl_xor(ss, 32);
    if (g4 == 0) red[eh * 64 + 16 * mi + r16] = ss;
    BAR_LDS();
    const float tot = red[16 * mi + r16] + red[64 + 16 * mi + r16]; const float rstd = 1.0f / sqrtf(tot * (1.0f / DV) + EPS);
    const float* gn = args.in[IS_A ? I_ANORM : I_BNORM];
    bf16* mixed = (bf16*)(ws + WS_MIX);
#pragma unroll
    for (int hf = 0; hf < NH; ++hf)
#pragma unroll
        for (int i = 0; i < 4; ++i) { const int e = 128 * hf + 64 * eh + 16 * i + 4 * g4;
            const u32x2 gw = gwv[hf][i]; const f32x4 gg = *(const f32x4*)(gn + e);
            u32x2 o; o.x = pk2(acc[hf][i][0] * rstd * gg.x * bflo(gw.x), acc[hf][i][1] * rstd * gg.y * bfhi(gw.x)); o.y = pk2(acc[hf][i][2] * rstd * gg.z * bflo(gw.y), acc[hf][i][3] * rstd * gg.w * bfhi(gw.y));
            *(GAS u32x2*)(mixed + row * D + ocol + e) = o; }
}

__device__ __forceinline__ void ab_phase_c2(const Args& args, Frame& F) {
    u32x4 R[6];
    int u = F.bid;
    if (u < 3072) ab_load_raw(args, u, F.tid, true, R);
    for (; u < 3072; u += F.G) {
        bool isA; int b, n, h; ab_decode(u, isA, b, n, h);
        BAR_ALL();
        ab_store_raw(F.lds + C2_LF, F.lds + C2_Q, F.lds + C2_K, F.tid, true, isA, R);
        if (u + F.G < 3072) ab_load_raw(args, u + F.G, F.tid, true, R);
        BAR_LDS();
        if (isA) ab_c_unit2<true>(args, F, b, n, h); else ab_c_unit2<false>(args, F, b, n, h);
    }
    BAR_ALL();
}

constexpr int A2_LF = 0, A2_K = 16384, A2_KT = 32768, A2_V0 = 51200, A2_V1 = 67584, A2_PART = 83968;
template <bool IS_A>
__device__ __forceinline__ void ab_a_unit2(const Args& args, Frame& F, int b, int n, int h) {
    unsigned char* ws = args.ws; const bf16* h0 = (const bf16*)(ws + WS_R1);
    const int t0 = b * SEQ + n * 64, tid = F.tid, lane = F.lane, w = F.wave;
    LAS unsigned char* LF = F.lds + A2_LF; LAS unsigned char* K = F.lds + A2_K; LAS bf16* KT = (LAS bf16*)(F.lds + A2_KT);
    LAS unsigned char* V0 = F.lds + A2_V0; LAS unsigned char* V1 = F.lds + A2_V1; LAS float* part = (LAS float*)(F.lds + A2_PART);
    constexpr int DV = IS_A ? 128 : 256;
    const bf16* Vg = h0 + (size_t)t0 * N_AB + (IS_A ? H0_AI + h * 128 : H0_BV + h * 256);
    dma_tile128(V0, Vg, N_AB, 64, w, lane);
    if (!IS_A) dma_tile128(V1, Vg + 128, N_AB, 64, w, lane);
    const int d = tid & 127, tq = tid >> 7;
    float lfv[16], kv[16]; float loc = 0.f;
#pragma unroll
    for (int i = 0; i < 16; ++i) { const int off = swz128(16 * tq + i, d); lfv[i] = bf2f(*(const LAS bf16*)(LF + off)); kv[i] = IS_A ? -expm1f(lfv[i]) : bf2f(*(const LAS bf16*)(K + off)); loc += lfv[i]; }
    part[tq * 128 + d] = loc;
    BAR_LDS();
    float pre = 0.f, tot = 0.f;
#pragma unroll
    for (int j = 0; j < 4; ++j) { const float p = part[j * 128 + d]; tot += p; pre += (j < tq) ? p : 0.f; }
    { float bc = pre; unsigned wv[8];
#pragma unroll
        for (int i = 0; i < 16; i += 2) { bc += lfv[i]; const float k0 = kv[i] * __expf(tot - bc); bc += lfv[i + 1]; const float k1 = kv[i + 1] * __expf(tot - bc); wv[i >> 1] = pk2(k0, k1); }
        u32x4 o0, o1; o0.x = wv[0]; o0.y = wv[1]; o0.z = wv[2]; o0.w = wv[3]; o1.x = wv[4]; o1.y = wv[5]; o1.z = wv[6]; o1.w = wv[7];
        *(LAS u32x4*)(KT + d * LDK + 16 * tq) = o0; *(LAS u32x4*)(KT + d * LDK + 16 * tq + 8) = o1; }
    if (tq == 0) { float* G = (float*)(ws + (IS_A ? WS_GA : WS_GB)); G[(size_t)((b * NCH + n) * (IS_A ? 8 : 4) + h) * 128 + d] = __expf(tot); }
    BAR_ALL();
    bf16* U = (bf16*)(ws + WS_R2) + (IS_A ? (size_t)((b * NCH + n) * 8 + h) * 128 * 128 : (size_t)64 * MiB / 2 + (size_t)((b * NCH + n) * 4 + h) * 256 * 128);
    const bf16x8 a0 = lds_frag(KT, LDK, 16 * w, 0, lane), a1 = lds_frag(KT, LDK, 16 * w, 32, lane);
#pragma unroll 4
    for (int et = 0; et < DV / 16; ++et) { const LAS unsigned char* Vt = (et < 8) ? V0 : V1; const int c0 = (et & 7) * 16;
        f32x4 acc = {0.f, 0.f, 0.f, 0.f};
        acc = mfma16(a0, tfrag128(Vt, 0, c0, lane), acc);
        acc = mfma16(a1, tfrag128(Vt, 32, c0, lane), acc);
        u32x2 o; o.x = pk2(acc[0], acc[1]); o.y = pk2(acc[2], acc[3]);
        *(GAS u32x2*)(U + (size_t)(16 * et + (lane & 15)) * 128 + 16 * w + 4 * (lane >> 4)) = o; }
}
__device__ __forceinline__ void ab_phase_a2(const Args& args, Frame& F) {
    u32x4 R[6];
    int u = F.bid;
    if (u < 3072) ab_load_raw(args, u, F.tid, false, R);
    for (; u < 3072; u += F.G) {
        bool isA; int b, n, h; ab_decode(u, isA, b, n, h);
        BAR_ALL();
        ab_store_raw(F.lds + A2_LF, F.lds + A2_LF, F.lds + A2_K, F.tid, false, isA, R);
        if (u + F.G < 3072) ab_load_raw(args, u + F.G, F.tid, false, R);
        BAR_LDS();
        if (isA) ab_a_unit2<true>(args, F, b, n, h); else ab_a_unit2<false>(args, F, b, n, h);
    }
    BAR_ALL();
}
constexpr int NPR = NCH / 2, NPAIRS = BATCH * NPR * 12;
__device__ __forceinline__ void abp_decode(int up, bool& isA, int& b, int& p, int& h) {
    if (up < 1024) { isA = true; h = up & 7; p = (up >> 3) & 31; b = up >> 8; } else { const int v = up - 1024; isA = false; h = v & 3; p = (v >> 2) & 31; b = v >> 7; }
}
__device__ __forceinline__ int abp_chunk_unit(int up, int sub) {
    bool isA; int b, p, h; abp_decode(up, isA, b, p, h); const int n = 2 * p + sub;
    return isA ? ((b << 9) | (n << 3) | h) : 2048 + ((b << 8) | (n << 2) | h);
}
__device__ __forceinline__ size_t abp_state_off(bool isA, int b, int p, int h) {
    return isA ? (size_t)((b * NPR + p) * 8 + h) * 128 * 128 : (size_t)64 * MiB / 2 + (size_t)((b * NPR + p) * 4 + h) * 256 * 128;
}

template <bool IS_A>
__device__ __forceinline__ void ab_a_pair(const Args& args, Frame& F, int up, int b, int p, int h, u32x4 (&R)[6]) {
    unsigned char* ws = args.ws; const bf16* h0 = (const bf16*)(ws + WS_R1);
    const int tid = F.tid, lane = F.lane, w = F.wave, r16 = lane & 15, g4 = lane >> 4;
    LAS unsigned char* LF = F.lds + A2_LF; LAS unsigned char* K = F.lds + A2_K; LAS bf16* KT = (LAS bf16*)(F.lds + A2_KT);
    LAS unsigned char* V0 = F.lds + A2_V0; LAS unsigned char* V1 = F.lds + A2_V1; LAS float* part = (LAS float*)(F.lds + A2_PART);
    constexpr int DV = IS_A ? 128 : 256, NT = DV / 16;
    const int d = tid & 127, tq = tid >> 7;
    f32x4 acc[NT];
#pragma unroll
    for (int et = 0; et < NT; ++et) acc[et] = (f32x4){0.f, 0.f, 0.f, 0.f};
    float tot0 = 0.f, tot1 = 0.f;
#pragma unroll
    for (int sub = 0; sub < 2; ++sub) {
        const int n = 2 * p + sub, t0 = b * SEQ + n * 64;
        BAR_ALL();
        ab_store_raw(LF, LF, K, tid, false, IS_A, R);
        if (sub == 0) ab_load_raw(args, abp_chunk_unit(up, 1), tid, false, R);
        else if (up + F.G < NPAIRS) ab_load_raw(args, abp_chunk_unit(up + F.G, 0), tid, false, R);
        BAR_LDS();
        const bf16* Vg = h0 + (size_t)t0 * N_AB + (IS_A ? H0_AI + h * 128 : H0_BV + h * 256);
        dma_tile128(V0, Vg, N_AB, 64, w, lane);
        if (!IS_A) dma_tile128(V1, Vg + 128, N_AB, 64, w, lane);
        float lfv[16], kv[16]; float loc = 0.f;
#pragma unroll
        for (int i = 0; i < 16; ++i) { const int off = swz128(16 * tq + i, d); lfv[i] = bf2f(*(const LAS bf16*)(LF + off)); kv[i] = IS_A ? -expm1f(lfv[i]) : bf2f(*(const LAS bf16*)(K + off)); loc += lfv[i]; }
        part[tq * 128 + d] = loc;
        BAR_LDS();
        float pre = 0.f, tot = 0.f;
#pragma unroll
        for (int j = 0; j < 4; ++j) { const float pp = part[j * 128 + d]; tot += pp; pre += (j < tq) ? pp : 0.f; }
        { float bc = pre; unsigned wv[8];
#pragma unroll
            for (int i = 0; i < 16; i += 2) { bc += lfv[i]; const float k0 = kv[i] * __expf(tot - bc); bc += lfv[i + 1]; const float k1 = kv[i + 1] * __expf(tot - bc); wv[i >> 1] = pk2(k0, k1); }
            u32x4 o0, o1; o0.x = wv[0]; o0.y = wv[1]; o0.z = wv[2]; o0.w = wv[3]; o1.x = wv[4]; o1.y = wv[5]; o1.z = wv[6]; o1.w = wv[7];
            *(LAS u32x4*)(KT + d * LDK + 16 * tq) = o0; *(LAS u32x4*)(KT + d * LDK + 16 * tq + 8) = o1; }
        if (sub == 0) tot0 = tot; else tot1 = tot;
        BAR_ALL();
        if (sub == 1) {
            float gd[4];
#pragma unroll
            for (int j = 0; j < 4; ++j) { const int dd = 16 * w + 4 * g4 + j; gd[j] = __expf((part[dd] + part[128 + dd]) + (part[256 + dd] + part[384 + dd])); }
#pragma unroll
            for (int et = 0; et < NT; ++et)
#pragma unroll
                for (int j = 0; j < 4; ++j) acc[et][j] *= gd[j];
        }
        int ll = lane; asm volatile("" : "+v"(ll));
        const bf16x8 a0 = lds_frag(KT, LDK, 16 * w, 0, ll), a1 = lds_frag(KT, LDK, 16 * w, 32, ll);
#pragma unroll
        for (int et = 0; et < NT; ++et) { const LAS unsigned char* Vt = (et < 8) ? V0 : V1; const int c0 = (et & 7) * 16;
            acc[et] = mfma16(a0, tfrag128(Vt, 0, c0, ll), acc[et]);
            acc[et] = mfma16(a1, tfrag128(Vt, 32, c0, ll), acc[et]); if (et & 1) __builtin_amdgcn_sched_barrier(0); }
    }
    if (tq == 0) { float* G = (float*)(ws + (IS_A ? WS_GA : WS_GB)); G[(size_t)((b * NPR + p) * (IS_A ? 8 : 4) + h) * 128 + d] = __expf(tot0 + tot1); }
    bf16* U = (bf16*)(ws + WS_R2) + abp_state_off(IS_A, b, p, h);
#pragma unroll
    for (int et = 0; et < NT; ++et) { u32x2 o; o.x = pk2(acc[et][0], acc[et][1]); o.y = pk2(acc[et][2], acc[et][3]);
        *(GAS u32x2*)(U + (size_t)(16 * et + r16) * 128 + 16 * w + 4 * g4) = o; }
}
__device__ __forceinline__ void ab_phase_a3(const Args& args, Frame& F) {
    u32x4 R[6];
    int up = F.bid;
    if (up < NPAIRS) ab_load_raw(args, abp_chunk_unit(up, 0), F.tid, false, R);
    for (; up < NPAIRS; up += F.G) {
        bool isA; int b, p, h; abp_decode(up, isA, b, p, h);
        if (isA) ab_a_pair<true>(args, F, up, b, p, h, R); else ab_a_pair<false>(args, F, up, b, p, h, R);
    }
    BAR_ALL();
}

__device__ __forceinline__ void ab_scan_p(const Args& args, Frame& F) {
    unsigned char* ws = args.ws;
    const int NT_A = BATCH * 8 * 128 * 16, NT_B = BATCH * 4 * 256 * 16;
    for (int gt = F.bid * 512 + F.tid; gt < NT_A + NT_B; gt += F.G * 512) {
        const bool isA = gt < NT_A; const int r = isA ? gt : gt - NT_A;
        const int d8 = r & 15; int e, h, b, H, DV;
        if (isA) { e = (r >> 4) & 127; h = (r >> 11) & 7; b = r >> 14; H = 8; DV = 128; } else { e = (r >> 4) & 255; h = (r >> 12) & 3; b = r >> 14; H = 4; DV = 256; }
        bf16* S = (bf16*)(ws + WS_R2) + (isA ? (size_t)0 : (size_t)64 * MiB / 2);
        const float* G = (const float*)(ws + (isA ? WS_GA : WS_GB));
        float st[8];
#pragma unroll
        for (int j = 0; j < 8; ++j) st[j] = 0.f;
#pragma unroll 4
        for (int p = 0; p < NPR; ++p) {
            GAS u32x4* q = (GAS u32x4*)(S + ((size_t)((b * NPR + p) * H + h) * DV + e) * 128 + 8 * d8);
            const float* gp = G + (size_t)((b * NPR + p) * H + h) * 128 + 8 * d8;
            const u32x4 u = *q; const f32x4 g0 = *(const f32x4*)gp, g1 = *(const f32x4*)(gp + 4);
            u32x4 o; o.x = pk2(st[0], st[1]); o.y = pk2(st[2], st[3]); o.z = pk2(st[4], st[5]); o.w = pk2(st[6], st[7]);
            *q = o;
            st[0] = g0.x * st[0] + bflo(u.x); st[1] = g0.y * st[1] + bfhi(u.x); st[2] = g0.z * st[2] + bflo(u.y); st[3] = g0.w * st[3] + bfhi(u.y);
            st[4] = g1.x * st[4] + bflo(u.z); st[5] = g1.y * st[5] + bfhi(u.z); st[6] = g1.z * st[6] + bflo(u.w); st[7] = g1.w * st[7] + bfhi(u.w);
        }
    }
}

template <bool IS_A>
__device__ __forceinline__ void ab_c_step(const Args& args, Frame& F, int b, int p, int h, const int sub) {
    unsigned char* ws = args.ws; const bf16* h0 = (const bf16*)(ws + WS_R1);
    const int n = 2 * p + sub;
    int lane = F.lane; asm volatile("" : "+v"(lane));
    const int t0 = b * SEQ + n * 64, tid = F.tid, w = F.wave, r16 = lane & 15, g4 = lane >> 4;
    LAS unsigned char* LF = F.lds + C2_LF; LAS unsigned char* Q = F.lds + C2_Q; LAS unsigned char* K = F.lds + C2_K;
    LAS bf16* P = (LAS bf16*)(F.lds + C2_P); LAS unsigned char* V0 = F.lds + C2_V0; LAS unsigned char* S0 = F.lds + C2_S0; LAS unsigned char* S1 = F.lds + C2_S1;
    LAS float* part = (LAS float*)(F.lds + C2_PART); LAS float* red = (LAS float*)(F.lds + C2_RED);
    constexpr int DV = IS_A ? 128 : 256;
    const bf16* Sg = (const bf16*)(ws + WS_R2) + abp_state_off(IS_A, b, p, h);
    const bf16* Vg = h0 + (size_t)t0 * N_AB + (IS_A ? H0_AI + h * 128 : H0_BV + h * 256);
    dma_tile128(V0, Vg, N_AB, 64, w, lane);
    if (sub == 0 && p > 0) { dma_tile128(S0, Sg, 128, 128, w, lane); if (!IS_A) dma_tile128(S1, Sg + 128 * 128, 128, 128, w, lane); }
    const int d = tid & 127, tq = tid >> 7;
    float lfv[16]; float loc = 0.f;
#pragma unroll
    for (int i = 0; i < 16; ++i) { lfv[i] = bf2f(*(const LAS bf16*)(LF + swz128(16 * tq + i, d))); loc += lfv[i]; }
    part[tq * 128 + d] = loc;
    BAR_LDS();
    { float pre = 0.f;
#pragma unroll
        for (int j = 0; j < 4; ++j) { const float pp = part[j * 128 + d]; pre += (j < tq) ? pp : 0.f; }
        float bc = pre;
#pragma unroll
        for (int i = 0; i < 16; ++i) { bc += lfv[i]; const int off = swz128(16 * tq + i, d);
            const float qv = bf2f(*(const LAS bf16*)(Q + off)); const float kv = IS_A ? -expm1f(lfv[i]) : bf2f(*(const LAS bf16*)(K + off));
            *(LAS bf16*)(Q + off) = (bf16)f2bf(qv * __expf(bc)); *(LAS bf16*)(K + off) = (bf16)f2bf(kv * __expf(fminf(-bc, 80.f))); } }
    BAR_LDS();
    if (!IS_A) dma_tile128(LF, Vg + 128, N_AB, 64, w, lane);
    { const int mi = w >> 1;
#pragma unroll
        for (int q2 = 0; q2 < 2; ++q2) { const int ni = 2 * (w & 1) + q2; f32x4 acc = {0.f, 0.f, 0.f, 0.f};
            if (ni <= mi) {
#pragma unroll
                for (int ks = 0; ks < 4; ++ks) acc = mfma16(frag128(K, 16 * ni, 32 * ks, lane), frag128(Q, 16 * mi, 32 * ks, lane), acc); }
            const int t = 16 * mi + r16, s0 = 16 * ni + 4 * g4;
            float pv[4];
#pragma unroll
            for (int j = 0; j < 4; ++j) pv[j] = (ni <= mi && s0 + j <= t) ? acc[j] : 0.f;
            u32x2 o; o.x = pk2(pv[0], pv[1]); o.y = pk2(pv[2], pv[3]);
            *(LAS u32x2*)(P + t * LDK + s0) = o; } }
    const int mi = w & 3, eh = w >> 2;
    constexpr int NH = IS_A ? 1 : 2;
    const int gcol = IS_A ? H0_AG + h * 128 : H0_BG + h * 256, ocol = IS_A ? h * 128 : 1024 + h * 256;
    const size_t row = (size_t)(t0 + 16 * mi + r16);
    u32x2 gwv[NH][4];
#pragma unroll
    for (int hf = 0; hf < NH; ++hf)
#pragma unroll
        for (int i = 0; i < 4; ++i) gwv[hf][i] = *(const GAS u32x2*)(h0 + row * N_AB + gcol + 128 * hf + 64 * eh + 16 * i + 4 * g4);
    BAR_ALL();
    f32x4 acc[NH][4];
    { const bf16x8 p0 = lds_frag(P, LDK, 16 * mi, 0, lane), p1 = lds_frag(P, LDK, 16 * mi, 32, lane);
        bf16x8 qf[4];
#pragma unroll
        for (int ks = 0; ks < 4; ++ks) qf[ks] = frag128(Q, 16 * mi, 32 * ks, lane);
#pragma unroll
        for (int hf = 0; hf < NH; ++hf) { const LAS unsigned char* Vt = hf ? LF : V0; const LAS unsigned char* St = hf ? S1 : S0;
#pragma unroll
            for (int i = 0; i < 4; ++i) { const int e0 = 64 * eh + 16 * i; f32x4 a = {0.f, 0.f, 0.f, 0.f};
                a = mfma16(tfrag128(Vt, 0, e0, lane), p0, a); a = mfma16(tfrag128(Vt, 32, e0, lane), p1, a);
                if (n > 0) {
#pragma unroll
                    for (int ks = 0; ks < 4; ++ks) a = mfma16(frag128(St, e0, 32 * ks, lane), qf[ks], a); }
                acc[hf][i] = a; } } }
    float ss = 0.f;
#pragma unroll
    for (int hf = 0; hf < NH; ++hf)
#pragma unroll
        for (int i = 0; i < 4; ++i)
#pragma unroll
            for (int j = 0; j < 4; ++j) ss += acc[hf][i][j] * acc[hf][i][j];
    ss += __shfl_xor(ss, 16); ss += __shfl_xor(ss, 32);
    if (g4 == 0) red[eh * 64 + 16 * mi + r16] = ss;
    BAR_LDS();
    const float tot = red[16 * mi + r16] + red[64 + 16 * mi + r16]; const float rstd = 1.0f / sqrtf(tot * (1.0f / DV) + EPS);
    const float* gn = args.in[IS_A ? I_ANORM : I_BNORM];
    bf16* mixed = (bf16*)(ws + WS_MIX);
#pragma unroll
    for (int hf = 0; hf < NH; ++hf)
#pragma unroll
        for (int i = 0; i < 4; ++i) { const int e = 128 * hf + 64 * eh + 16 * i + 4 * g4;
            const u32x2 gw = gwv[hf][i]; const f32x4 gg = *(const f32x4*)(gn + e);
            u32x2 o; o.x = pk2(acc[hf][i][0] * rstd * gg.x * bflo(gw.x), acc[hf][i][1] * rstd * gg.y * bfhi(gw.x)); o.y = pk2(acc[hf][i][2] * rstd * gg.z * bflo(gw.y), acc[hf][i][3] * rstd * gg.w * bfhi(gw.y));
            *(GAS u32x2*)(mixed + row * D + ocol + e) = o; }
    if (sub == 0) {
        const int d0 = 16 * w;
        const float gd = __expf((part[d0 + r16] + part[128 + d0 + r16]) + (part[256 + d0 + r16] + part[384 + d0 + r16]));
        const bf16x8 k0 = tfrag128(K, 0, d0, lane), k1 = tfrag128(K, 32, d0, lane);
#pragma unroll
        for (int et = 0; et < DV / 16; ++et) { LAS unsigned char* St = (et < 8) ? S0 : S1; const LAS unsigned char* Vt = (et < 8) ? V0 : LF; const int e0 = (et & 7) * 16;
            f32x4 a = {0.f, 0.f, 0.f, 0.f};
            if (n > 0) {
#pragma unroll
                for (int j = 0; j < 4; ++j) a[j] = bf2f(*(const LAS bf16*)(St + swz128(e0 + 4 * g4 + j, d0 + r16))); }
            a = mfma16(tfrag128(Vt, 0, e0, lane), k0, a); a = mfma16(tfrag128(Vt, 32, e0, lane), k1, a);
#pragma unroll
            for (int j = 0; j < 4; ++j) *(LAS bf16*)(St + swz128(e0 + 4 * g4 + j, d0 + r16)) = (bf16)f2bf(a[j] * gd);
            __builtin_amdgcn_sched_barrier(0); }
    }
}
__device__ __forceinline__ void ab_phase_c3(const Args& args, Frame& F) {
    u32x4 R[6];
    int up = F.bid;
    if (up < NPAIRS) ab_load_raw(args, abp_chunk_unit(up, 0), F.tid, true, R);
    for (; up < NPAIRS; up += F.G) {
        bool isA; int b, p, h; abp_decode(up, isA, b, p, h);
#pragma unroll
        for (int sub = 0; sub < 2; ++sub) {
            BAR_ALL();
            ab_store_raw(F.lds + C2_LF, F.lds + C2_Q, F.lds + C2_K, F.tid, true, isA, R);
            if (sub == 0) ab_load_raw(args, abp_chunk_unit(up, 1), F.tid, true, R);
            else if (up + F.G < NPAIRS) ab_load_raw(args, abp_chunk_unit(up + F.G, 0), F.tid, true, R);
            BAR_LDS();
            if (isA) ab_c_step<true>(args, F, b, p, h, sub); else ab_c_step<false>(args, F, b, p, h, sub);
        }
    }
    BAR_ALL();
}
#ifndef PROBE_SKIP
#define PROBE_SKIP 0
#endif
constexpr int H1_CQ = 0, H1_CKV = 1024, H1_IQ = 1280, H1_DQ = 2304, H1_DK = 2816, H1_DV = 3328, H1_DOG = 4352;
constexpr int SM_IK = 0, SM_IW = 64, SM_DI = 80, SM_DF = 84;
constexpr size_t SCORES_PER_BATCH = (size_t)4096 * 64 * 65 / 2;
__device__ __forceinline__ size_t score_row_off(int t) { const size_t c = (size_t)(t >> 6), r = (size_t)(t & 63); return 2048 * c * (c + 1) + 64 * r * (c + 1); }

__device__ __forceinline__ void dsa_prep_rows(const Args& args, Frame& F) {
    unsigned char* ws = args.ws; const bf16* h1 = (const bf16*)(ws + WS_R1); bf16* ckvn = (bf16*)(ws + WS_CKVN);
    const float* g = args.in[I_CKVG];
    const int gw = F.bid * 8 + F.wave, NGW = F.G * 8;
    for (int m = gw; m < T; m += NGW) {
        const u32x2 v = *(const GAS u32x2*)(h1 + (size_t)m * N_CD + H1_CKV + 4 * F.lane);
        const float a = bflo(v.x), b = bfhi(v.x), c = bflo(v.y), d = bfhi(v.y);
        const float ss = wave_sum(a * a + b * b + c * c + d * d); const float rs = 1.0f / sqrtf(ss * (1.0f / 256.f) + EPS);
        const f32x4 gg = *(const f32x4*)(g + 4 * F.lane);
        u32x2 o; o.x = pk2(a * rs * gg.x, b * rs * gg.y); o.y = pk2(c * rs * gg.z, d * rs * gg.w);
        *(GAS u32x2*)(ckvn + (size_t)m * 256 + 4 * F.lane) = o;
    }
}

__device__ __forceinline__ void dsa_indexer(const Args& args, Frame& F) {
    unsigned char* ws = args.ws; const bf16* h1 = (const bf16*)(ws + WS_R1); const float* small = (const float*)(ws + WS_SMALL);
    float* scores = (float*)(ws + WS_R2);
    LAS bf16* KS = (LAS bf16*)F.lds;
    const int lane = F.lane, w = F.wave, r16 = lane & 15, g4 = lane >> 4;
    const int u_lo = (int)((long)F.bid * (4 * 272) / F.G), u_hi = (int)((long)(F.bid + 1) * (4 * 272) / F.G);
    int u = u_lo;
    while (u < u_hi) {
        const int b = u / 272; int v = u % 272; int qt = 0;
        { int p = 0; while ((p + 1) * (p + 2) <= v) ++p; v -= p * (p + 1); if (v < p + 1) { qt = 2 * p; } else { qt = 2 * p + 1; v -= p + 1; } }
        const int seg0 = v; const int nsq = (qt >> 1) + 1;
        int nseg = nsq - seg0; if (nseg > u_hi - u) nseg = u_hi - u;
        const int q0 = qt * 128;
        const int tq = q0 + 16 * w + r16; const size_t qrow = (size_t)(b * SEQ + tq);
        bf16x8 qf[16][2]; float wv[16];
#pragma unroll
        for (int hh = 0; hh < 16; ++hh) {
#pragma unroll
            for (int ks = 0; ks < 2; ++ks) qf[hh][ks] = *(const GAS bf16x8*)(h1 + qrow * N_CD + H1_IQ + hh * 64 + ks * 32 + 8 * g4);
            wv[hh] = small[qrow * 128 + SM_IW + hh] * 0.25f; }
        const size_t rowbase = (size_t)b * SCORES_PER_BATCH + score_row_off(tq);
        const int rowlen = 64 * ((tq >> 6) + 1);
#pragma unroll 1
        for (int sg = 0; sg < nseg; ++sg) {
            const int s0 = (seg0 + sg) * 256;
            __syncthreads();
#pragma unroll 2
            for (int i = F.tid; i < 256 * 16; i += 512) { const int s = i >> 4, c4 = (i & 15) * 4; const f32x4 kv = *(const f32x4*)(small + (size_t)(b * SEQ + s0 + s) * 128 + SM_IK + c4);
                u32x2 o; o.x = pk2(kv.x, kv.y); o.y = pk2(kv.z, kv.w); *(LAS u32x2*)(KS + s * LDK + c4) = o; }
            __syncthreads();
#pragma unroll 1
            for (int kt = 0; kt < 16; ++kt) {
                if (s0 + 16 * kt > q0 + 16 * w + 15) break;
                const bf16x8 k0 = lds_frag(KS, LDK, 16 * kt, 0, lane), k1 = lds_frag(KS, LDK, 16 * kt, 32, lane);
                f32x4 sc = {0.f, 0.f, 0.f, 0.f};
#pragma unroll
                for (int hh = 0; hh < 16; ++hh) { f32x4 a = {0.f, 0.f, 0.f, 0.f}; a = mfma16(k0, qf[hh][0], a); a = mfma16(k1, qf[hh][1], a);
#pragma unroll
                    for (int j = 0; j < 4; ++j) sc[j] += wv[hh] * fmaxf(a[j], 0.f); }
                const int sk = s0 + 16 * kt + 4 * g4;
                if (sk < rowlen) *(GAS f32x4*)(scores + rowbase + sk) = sc;
            }
        }
        u += nseg;
    }
}

#ifndef PROBE_TOPK_NOHIST
#define PROBE_TOPK_NOHIST 0
#endif
#ifndef PROBE_TOPK_NOEMIT
#define PROBE_TOPK_NOEMIT 0
#endif
template <int NB>
__device__ __forceinline__ void topk_scan(LAS unsigned* hist, int lane, int need, int& bin, int& above, int& cnt) {
    unsigned c[NB]; unsigned tot = 0u;
#pragma unroll
    for (int q = 0; q < NB / 4; ++q) { const u32x4 v = *(const LAS u32x4*)(hist + NB * lane + 4 * q); c[4 * q] = v.x; c[4 * q + 1] = v.y; c[4 * q + 2] = v.z; c[4 * q + 3] = v.w; tot += (v.x + v.y) + (v.z + v.w); }
#pragma unroll
    for (int q = 0; q < NB / 4; ++q) *(LAS u32x4*)(hist + NB * lane + 4 * q) = (u32x4){0u, 0u, 0u, 0u};
    unsigned inc = tot;
#pragma unroll
    for (int o = 1; o < 64; o <<= 1) { const unsigned u = __shfl_down(inc, o); if (lane + o < 64) inc += u; }
    unsigned run = inc - tot; int fb = -1; unsigned fa = 0u, fc = 0u;
#pragma unroll
    for (int jj = NB - 1; jj >= 0; --jj) { const unsigned cj = c[jj]; const bool hit = (run < (unsigned)need) && (run + cj >= (unsigned)need); fb = hit ? jj : fb; fa = hit ? run : fa; fc = hit ? cj : fc; run += cj; }
    const unsigned long long m = __ballot(fb >= 0); const int L = (int)__builtin_ctzll(m);
    bin = __shfl(NB * lane + fb, L); above = (int)__shfl(fa, L); cnt = (int)__shfl(fc, L);
}
__device__ __forceinline__ void topk_keys16(const float* sr, int t, int lane, int c, unsigned (&key)[16]) {
#pragma unroll
    for (int j = 0; j < 16; ++j) { const int i = 16 * c + j; const int s = 64 * i + lane; unsigned k = 0u;
        if (64 * i <= t) { const unsigned bits = __builtin_bit_cast(unsigned, sr[s]); k = (bits & 0x80000000u) ? ~bits : (bits | 0x80000000u); if (s > t) k = 0u; }
        key[j] = k; }
}
__device__ __forceinline__ void topk_row(const float* sr, int t, int lane, LAS unsigned* hist, unsigned short* out) {
    const int nchunk = (t >> 10) + 1;
    int bin, above, cnt; unsigned tau; int need_eq = 0x7fffffff;
#if PROBE_TOPK_NOHIST
    tau = 0xC0000000u; if (false) {
#endif
#pragma unroll 1
    for (int c = 0; c < nchunk; ++c) { unsigned key[16]; topk_keys16(sr, t, lane, c, key);
#pragma unroll
        for (int j = 0; j < 16; ++j) __hip_atomic_fetch_add(hist + (key[j] >> 21), 1u, __ATOMIC_RELAXED, __HIP_MEMORY_SCOPE_WORKGROUP); }
    topk_scan<32>(hist, lane, 256, bin, above, cnt);
    tau = (unsigned)bin << 21; int need = 256 - above;
    if (need != cnt) {
        const unsigned p1 = (unsigned)bin;
#pragma unroll 1
        for (int c = 0; c < nchunk; ++c) { unsigned key[16]; topk_keys16(sr, t, lane, c, key);
#pragma unroll
            for (int j = 0; j < 16; ++j) if ((key[j] >> 21) == p1) __hip_atomic_fetch_add(hist + ((key[j] >> 10) & 2047u), 1u, __ATOMIC_RELAXED, __HIP_MEMORY_SCOPE_WORKGROUP); }
        topk_scan<32>(hist, lane, need, bin, above, cnt);
        tau |= (unsigned)bin << 10; need -= above;
        if (need != cnt) {
            const unsigned p2 = tau >> 10;
#pragma unroll 1
            for (int c = 0; c < nchunk; ++c) { unsigned key[16]; topk_keys16(sr, t, lane, c, key);
#pragma unroll
                for (int j = 0; j < 16; ++j) if ((key[j] >> 10) == p2) __hip_atomic_fetch_add(hist + (key[j] & 1023u), 1u, __ATOMIC_RELAXED, __HIP_MEMORY_SCOPE_WORKGROUP); }
            topk_scan<16>(hist, lane, need, bin, above, cnt);
            tau |= (unsigned)bin; need_eq = need - above;
        }
    }
#if PROBE_TOPK_NOHIST
    }
#endif
    int pos = 0, eqseen = 0;
    if (PROBE_TOPK_NOEMIT) return;
    const unsigned long long lt_mask = (1ull << lane) - 1ull;
#pragma unroll 1
    for (int c = 0; c < nchunk; ++c) { unsigned key[16]; topk_keys16(sr, t, lane, c, key);
#pragma unroll
        for (int j = 0; j < 16; ++j) {
            const bool gt = key[j] > tau, eq = key[j] == tau;
            const unsigned long long meq = __ballot(eq);
            const bool take = gt || (eq && (eqseen + __builtin_popcountll(meq & lt_mask) < need_eq));
            const unsigned long long mt = __ballot(take);
            if (take && (!PROBE_TOPK_NOHIST || pos + __builtin_popcountll(mt & lt_mask) < 256)) out[pos + __builtin_popcountll(mt & lt_mask)] = (unsigned short)(64 * (16 * c + j) + lane);
            pos += __builtin_popcountll(mt); eqseen += __builtin_popcountll(meq);
        } }
}
__device__ __forceinline__ bool topk_row_fast(const float* sr, int t, int lane, LAS unsigned* hist, LAS unsigned* memb, unsigned short* out) {
    const int nchunk = (t >> 10) + 1;
    float v[64];
#pragma unroll
    for (int c = 0; c < 4; ++c) {
        if (c < nchunk) {
#pragma unroll
            for (int j = 0; j < 16; ++j) { const int i = 16 * c + j; float x = -INFINITY; if (64 * i <= t) x = sr[64 * i + lane]; v[i] = x; }
        } else {
#pragma unroll
            for (int j = 0; j < 16; ++j) v[16 * c + j] = -INFINITY;
        }
    }
    float lo = v[0], hi = v[0];
#pragma unroll
    for (int o = 1; o < 64; o <<= 1) { lo = fminf(lo, __shfl_xor(lo, o)); hi = fmaxf(hi, __shfl_xor(hi, o)); }
    const float dd = hi - lo; lo -= 0.75f * dd; hi += 0.75f * dd;
    const float inv = (hi > lo) ? 2047.5f / (hi - lo) : 0.f;
#define TOPK_BIN(x, s) (((s) <= t) ? (int)fminf(fmaxf(((x) - lo) * inv, 0.f), 2047.f) : -1)
#pragma unroll
    for (int c = 0; c < 4; ++c) if (c < nchunk) {
#pragma unroll
        for (int j = 0; j < 16; ++j) { const int i = 16 * c + j; const int b = TOPK_BIN(v[i], 64 * i + lane); if (b >= 0) __hip_atomic_fetch_add(hist + b, 1u, __ATOMIC_RELAXED, __HIP_MEMORY_SCOPE_WORKGROUP); }
    }
    int B, above, cnt;
    topk_scan<32>(hist, lane, 256, B, above, cnt);
    if (cnt > 64) return false;
    const int need2 = 256 - above;
    const unsigned long long lt_mask = (1ull << lane) - 1ull;
    int pos = 0, nm = 0;
#pragma unroll
    for (int c = 0; c < 4; ++c) if (c < nchunk) {
#pragma unroll
        for (int j = 0; j < 16; ++j) { const int i = 16 * c + j; const int s = 64 * i + lane; const int b = TOPK_BIN(v[i], s);
            const unsigned long long mg = __ballot(b > B);
            if (b > B) out[pos + __builtin_popcountll(mg & lt_mask)] = (unsigned short)s;
            pos += __builtin_popcountll(mg);
            const unsigned long long me = __ballot(b == B);
            if (me != 0ull) { if (b == B) { const int slot = nm + __builtin_popcountll(me & lt_mask); const unsigned bits = __builtin_bit_cast(unsigned, v[i]);
                    memb[slot] = (bits & 0x80000000u) ? ~bits : (bits | 0x80000000u); memb[64 + slot] = (unsigned)s; }
                nm += __builtin_popcountll(me); }
        }
    }
#undef TOPK_BIN
    const unsigned mk = (lane < nm) ? memb[lane] : 0u, mi = (lane < nm) ? memb[64 + lane] : 0xffffffffu;
    int rank = 0;
    for (int q = 0; q < nm; ++q) { const unsigned kq = __builtin_amdgcn_readlane(mk, q), iq = __builtin_amdgcn_readlane(mi, q); rank += (kq > mk || (kq == mk && iq < mi)) ? 1 : 0; }
    if (lane < nm && rank < need2) out[above + rank] = (unsigned short)mi;
    return true;
}
__device__ __forceinline__ void dsa_topk(const Args& args, Frame& F) {
    unsigned char* ws = args.ws; const float* scores = (const float*)(ws + WS_R2); unsigned short* idx = (unsigned short*)(ws + WS_IDX);
    const int lane = F.lane; const int gw = F.bid * 8 + F.wave, NGW = F.G * 8;
    LAS unsigned* hist = (LAS unsigned*)(F.lds + F.wave * 8192);
    LAS unsigned* memb = (LAS unsigned*)(F.lds + 65536 + F.wave * 512);
    __syncthreads();
    for (int i = lane; i < 2048; i += 64) hist[i] = 0u;
    for (int rr = gw; rr < T; rr += NGW) {
        const int b = rr >> 12, jj = rr & 4095; const int t = (jj & 1) ? 4095 - (jj >> 1) : (jj >> 1); const int row = b * SEQ + t;
        unsigned short* out = idx + (size_t)row * 256;
        if (t < 256) {
#pragma unroll
            for (int i = 0; i < 4; ++i) { const int s = 64 * i + lane; out[s] = (unsigned short)(s <= t ? s : 0); }
            continue;
        }
        const float* sr = scores + (size_t)b * SCORES_PER_BATCH + score_row_off(t);
        if (!topk_row_fast(sr, t, lane, hist, memb, out)) topk_row(sr, t, lane, hist, out);
    }
}

#ifndef PROBE_ONETILE
#define PROBE_ONETILE 0
#endif
#ifndef PROBE_NOSTORE
#define PROBE_NOSTORE 0
#endif
#ifndef PROBE_NOGATHER
#define PROBE_NOGATHER 0
#endif
__device__ __forceinline__ void pl16(float& a, float& b) { asm volatile("s_nop 1\n\tv_permlane16_swap_b32 %0, %1" : "+v"(a), "+v"(b)); }
__device__ __forceinline__ void pl32(float& a, float& b) { asm volatile("s_nop 1\n\tv_permlane32_swap_b32 %0, %1" : "+v"(a), "+v"(b)); }
__device__ __forceinline__ float xmax16(float x) { float a = x, b = x; pl16(a, b); return fmaxf(a, b); }
__device__ __forceinline__ float xmax32(float x) { float a = x, b = x; pl32(a, b); return fmaxf(a, b); }
__device__ __forceinline__ float xadd16(float x) { float a = x, b = x; pl16(a, b); return a + b; }
__device__ __forceinline__ float xadd32(float x) { float a = x, b = x; pl32(a, b); return a + b; }
__device__ __forceinline__ s16x4 lds_tr(const LAS bf16* p) { return __builtin_bit_cast(s16x4, __builtin_amdgcn_ds_read_tr16_b64_v4i16((LAS s16x4*)p)); }
__device__ __forceinline__ void dsa_attention(const Args& args, Frame& F, bf16* obuf) {
    unsigned char* ws = args.ws; const bf16* ckvn = (const bf16*)(ws + WS_CKVN); bf16* qo = (bf16*)args.out; const unsigned short* idx = (const unsigned short*)(ws + WS_IDX);
    const int lane = F.lane, w = F.wave, r16 = lane & 15, g4 = lane >> 4;
    constexpr int LDV = 264;
    LAS bf16* KV = (LAS bf16*)(F.lds + w * (32 * LDV * 2));
    LAS float* rel = (LAS float*)(F.lds + 8 * 32 * LDV * 2);
    LAS unsigned char* bkt = (LAS unsigned char*)(F.lds + 8 * 32 * LDV * 2 + 1024);
    LAS unsigned char* bkey = (LAS unsigned char*)(F.lds + 8 * 32 * LDV * 2 + 1024 + 128 + w * 256);
    __syncthreads();
    if (F.tid < 256) rel[F.tid] = args.in[I_REL][F.tid];
    if (F.tid < 128) { const int n = F.tid; int bk = n; if (n >= 16) { int lg = 16 + (int)(__logf((float)n / 16.0f) / 2.0794415416798357f * 16.0f); bk = lg < 31 ? lg : 31; } bkt[n] = (unsigned char)bk; }
    __syncthreads();
    const bool g8 = (F.G & 7) == 0 && F.G >= 8;
    const int nwb = g8 ? (F.G / 8) * 2 * 8 : F.G * 8;
    const int wib = g8 ? ((F.bid >> 3) * 2 + (F.bid & 1)) * 8 + w : F.bid * 8 + w;
    const int bsel = g8 ? ((F.bid & 7) >> 1) : -1;
    const int nrows = g8 ? SEQ : T;
    const LAS bf16* tr_lo = KV + (4 * g4 + (r16 >> 2)) * LDV + 4 * (r16 & 3);
    const LAS bf16* tr_hi = tr_lo + 16 * LDV;
    for (int rr0 = wib; rr0 < nrows; rr0 += nwb) {
        const int b = g8 ? bsel : (rr0 >> 12); const int jj = rr0 & 4095; const int t = (jj & 1) ? 4095 - (jj >> 1) : (jj >> 1); const int row = b * SEQ + t;
        const int nsel = t < 255 ? t + 1 : 256;
        int myidx[4];
#pragma unroll
        for (int i = 0; i < 4; ++i) myidx[i] = idx[(size_t)row * 256 + 64 * i + lane];
#pragma unroll
        for (int i = 0; i < 4; ++i) { int dist = t - myidx[i]; dist = dist < 0 ? 0 : dist; bkey[64 * i + lane] = (dist < 128) ? bkt[dist] : (unsigned char)31; }
        bf16x8 qf[8];
#pragma unroll
        for (int ks = 0; ks < 8; ++ks) qf[ks] = *(const GAS bf16x8*)(qo + (size_t)row * D + (r16 & 7) * 256 + 32 * ks + 8 * g4);
        f32x4 o[16];
#pragma unroll
        for (int i = 0; i < 16; ++i) o[i] = (f32x4){0.f, 0.f, 0.f, 0.f};
        float mrun = -3.0e38f, lrun = 0.f;
        const int ntile = PROBE_ONETILE ? 1 : ((nsel + 31) >> 5);
        const bf16* kvb = ckvn + (size_t)(b * SEQ) * 256 + 8 * (lane & 31);
        u32x4 G[16];
        {
#pragma unroll
            for (int i = 0; i < 16; ++i) { const int kidx = __shfl(myidx[0], 2 * i + (lane >> 5)); G[i] = *(const GAS u32x4*)(kvb + (size_t)(PROBE_NOGATHER ? (kidx & 31) : kidx) * 256); } }
#pragma unroll 1
        for (int kt = 0; kt < ntile; ++kt) {
            const int src = (kt & 1) * 32;
            const int ireg = (kt >> 1) == 0 ? myidx[0] : (kt >> 1) == 1 ? myidx[1] : (kt >> 1) == 2 ? myidx[2] : myidx[3];
#pragma unroll
            for (int i = 0; i < 16; ++i) *(LAS u32x4*)(KV + (2 * i + (lane >> 5)) * LDV + 8 * (lane & 31)) = G[i];
            if (kt + 1 < ntile) {
                const int src2 = ((kt + 1) & 1) * 32;
                const int ireg2 = ((kt + 1) >> 1) == 0 ? myidx[0] : ((kt + 1) >> 1) == 1 ? myidx[1] : ((kt + 1) >> 1) == 2 ? myidx[2] : myidx[3];
#pragma unroll
                for (int i = 0; i < 16; ++i) { const int kidx = __shfl(ireg2, src2 + 2 * i + (lane >> 5)); G[i] = *(const GAS u32x4*)(kvb + (size_t)(PROBE_NOGATHER ? (kidx & 31) : kidx) * 256); }
            }
            f32x4 s0 = {0.f, 0.f, 0.f, 0.f}, s1 = {0.f, 0.f, 0.f, 0.f};
#pragma unroll
            for (int ks = 0; ks < 8; ++ks) { s0 = mfma16(lds_frag(KV, LDV, 0, 32 * ks, lane), qf[ks], s0); s1 = mfma16(lds_frag(KV, LDV, 16, 32 * ks, lane), qf[ks], s1); }
            float lg[8];
#pragma unroll
            for (int j = 0; j < 8; ++j) { const int kl = (j < 4 ? 4 * g4 + j : 16 + 4 * g4 + (j - 4)); const int kk = 32 * kt + kl; const int bk = (int)bkey[kk];
                const float v = (j < 4 ? s0[j] : s1[j - 4]) + rel[bk * 8 + (r16 & 7)];
                lg[j] = (kk < nsel) ? v : -3.0e38f; }
            float mx = lg[0];
#pragma unroll
            for (int j = 1; j < 8; ++j) mx = fmaxf(mx, lg[j]);
            mx = xmax16(mx); mx = xmax32(mx);
            const bool grow = mx > mrun;
            const float mnew = grow ? mx : mrun; const float corr = grow ? __expf(mrun - mnew) : 1.0f;
            float p[8], ps = 0.f;
#pragma unroll
            for (int j = 0; j < 8; ++j) { p[j] = (lg[j] > -1.0e38f) ? __expf(lg[j] - mnew) : 0.f; ps += p[j]; }
            ps = xadd16(ps); ps = xadd32(ps);
            lrun = lrun * corr + ps; mrun = mnew;
            bf16x8 pf; { u32x4 pw; pw.x = pk2(p[0], p[1]); pw.y = pk2(p[2], p[3]); pw.z = pk2(p[4], p[5]); pw.w = pk2(p[6], p[7]); pf = __builtin_bit_cast(bf16x8, pw); }
            if (__any(grow)) {
                float cr[4];
#pragma unroll
                for (int j = 0; j < 4; ++j) cr[j] = __shfl(corr, (4 * g4 + j) & 7);
#pragma unroll
                for (int nt = 0; nt < 16; ++nt)
#pragma unroll
                    for (int j = 0; j < 4; ++j) o[nt][j] *= cr[j];
            }
#pragma unroll
            for (int nt = 0; nt < 16; ++nt) {
                const s16x4 lo = lds_tr(tr_lo + 16 * nt), hi = lds_tr(tr_hi + 16 * nt);
                bf16x8 vf; vf[0] = lo[0]; vf[1] = lo[1]; vf[2] = lo[2]; vf[3] = lo[3]; vf[4] = hi[0]; vf[5] = hi[1]; vf[6] = hi[2]; vf[7] = hi[3];
                o[nt] = mfma16(pf, vf, o[nt]);
            }
        }
        float linv[4];
#pragma unroll
        for (int j = 0; j < 4; ++j) linv[j] = 1.0f / __shfl(lrun, (4 * g4 + j) & 7);
        if (g4 < 2 && !PROBE_NOSTORE) {
#pragma unroll
            for (int nt = 0; nt < 16; ++nt)
#pragma unroll
                for (int j = 0; j < 4; ++j) obuf[(size_t)row * D + (4 * g4 + j) * 256 + 16 * nt + r16] = (bf16)f2bf(o[nt][j] * linv[j]);
        }
    }
}
__device__ __forceinline__ float ml_wave_incl_scan_add(float v, int lane) {
#pragma unroll
    for (int o = 1; o < 64; o <<= 1) { const float u = __shfl_up(v, o); if (lane >= o) v += u; }
    return v;
}
__device__ __forceinline__ float ml_wave_incl_scan_max(float v, int lane) {
#pragma unroll
    for (int o = 1; o < 64; o <<= 1) { const float u = __shfl_up(v, o); if (lane >= o) v = fmaxf(v, u); }
    return v;
}
constexpr size_t ML_A = 0, ML_BL = 4096, ML_MP = 8192;

__device__ __forceinline__ void ml_conv16(const bf16* h1, int b, int s0, int col, const float (&w4)[4], float (&out)[16]) {
    float x[19];
#pragma unroll
    for (int i = 0; i < 19; ++i) { const int s = s0 - 3 + i; x[i] = (s >= 0) ? bf2f(h1[(size_t)(b * SEQ + s) * N_CD + col]) : 0.f; }
#pragma unroll
    for (int i = 0; i < 16; ++i) { const float c = w4[0] * x[i] + w4[1] * x[i + 1] + w4[2] * x[i + 2] + w4[3] * x[i + 3]; out[i] = siluf_(c); }
}

__device__ __forceinline__ void ml_a_unit(const Args& args, Frame& F, int b, int n, int h) {
    unsigned char* ws = args.ws; const bf16* h1 = (const bf16*)(ws + WS_R1); const float* small = (const float*)(ws + WS_SMALL);
    const int t0 = b * SEQ + n * 64, tid = F.tid, lane = F.lane, w = F.wave;
    LAS bf16* KT = (LAS bf16*)F.lds;
    LAS bf16* VT = (LAS bf16*)(F.lds + 18432);
    LAS float* part = (LAS float*)(F.lds + 55296);
    LAS float* uu = (LAS float*)(F.lds + 57344);
    const float* gb = args.in[I_GATEB];
    if (w == 0) {
        const float ig = small[(size_t)(t0 + lane) * 128 + SM_DI + h] + gb[h];
        const float lf = log_sigmoid_(small[(size_t)(t0 + lane) * 128 + SM_DF + h] + gb[4 + h]);
        const float bc = ml_wave_incl_scan_add(lf, lane); const float bl = __shfl(bc, 63);
        const float lu = bl - bc + ig; const float a = wave_max(lu);
        uu[lane] = __expf(lu - a);
        if (lane == 0) { float* sc = (float*)(ws + WS_MLSC); const int si = (b * NCH + n) * 4 + h; sc[ML_A / 4 + si] = a; sc[ML_BL / 4 + si] = bl; }
    }
    stage_vt<256>(VT, h1 + (size_t)t0 * N_CD + H1_DV + h * 256, N_CD, tid);
    __syncthreads();
    const int d = tid & 127, tq = tid >> 7;
    { const float* cw = args.in[I_CONVW]; const int ch = 512 + h * 128 + d; float w4[4];
#pragma unroll
        for (int j = 0; j < 4; ++j) w4[j] = cw[j * 1024 + ch];
        float kc[16]; ml_conv16(h1, b, n * 64 + 16 * tq, H1_DK + h * 128 + d, w4, kc);
        float loc = 0.f; unsigned wv[8];
#pragma unroll
        for (int i = 0; i < 16; i += 2) { const float k0 = kc[i] * 0.08838834764831845f * uu[16 * tq + i], k1 = kc[i + 1] * 0.08838834764831845f * uu[16 * tq + i + 1]; loc += k0 + k1; wv[i >> 1] = pk2(k0, k1); }
        u32x4 o0, o1; o0.x = wv[0]; o0.y = wv[1]; o0.z = wv[2]; o0.w = wv[3]; o1.x = wv[4]; o1.y = wv[5]; o1.z = wv[6]; o1.w = wv[7];
        *(LAS u32x4*)(KT + d * LDK + 16 * tq) = o0; *(LAS u32x4*)(KT + d * LDK + 16 * tq + 8) = o1;
        part[tq * 128 + d] = loc; }
    __syncthreads();
    if (tid < 128) { float* nl = (float*)(ws + WS_MLN); nl[(size_t)((b * NCH + n) * 4 + h) * 128 + tid] = part[tid] + part[128 + tid] + part[256 + tid] + part[384 + tid]; }
    bf16* U = (bf16*)(ws + WS_R2) + (size_t)((b * NCH + n) * 4 + h) * 256 * 128;
    const bf16x8 a0 = lds_frag(KT, LDK, 16 * w, 0, lane), a1 = lds_frag(KT, LDK, 16 * w, 32, lane);
#pragma unroll 4
    for (int et = 0; et < 16; ++et) {
        f32x4 acc = {0.f, 0.f, 0.f, 0.f};
        acc = mfma16(a0, lds_frag(VT, LDK, 16 * et, 0, lane), acc);
        acc = mfma16(a1, lds_frag(VT, LDK, 16 * et, 32, lane), acc);
        u32x2 o; o.x = pk2(acc[0], acc[1]); o.y = pk2(acc[2], acc[3]);
        *(GAS u32x2*)(U + (size_t)(16 * et + (lane & 15)) * 128 + 16 * w + 4 * (lane >> 4)) = o;
    }
    __syncthreads();
}

__device__ __forceinline__ void ml_scan(const Args& args, Frame& F) {
    unsigned char* ws = args.ws; float* sc = (float*)(ws + WS_MLSC);
    const int NTC = BATCH * 4 * 256 * 16, NTN = BATCH * 4 * 128;
    for (int gt = 64 * (F.wave * F.G + F.bid) + F.lane; gt < NTC + NTN; gt += F.G * 512) {
        if (gt < NTC) {
            const int d8 = gt & 15, e = (gt >> 4) & 255, h = (gt >> 12) & 3, b = gt >> 14;
            bf16* S = (bf16*)args.out + (size_t)33554432;
            float st[8]; float m = 0.f;
#pragma unroll
            for (int j = 0; j < 8; ++j) st[j] = 0.f;
#pragma unroll 4
            for (int n = 0; n < NCH; ++n) { const int si = (b * NCH + n) * 4 + h;
                GAS u32x4* p = (GAS u32x4*)(S + ((size_t)si * 256 + e) * 128 + 8 * d8);
                const u32x4 u = *p; const float a = sc[ML_A / 4 + si], bl = sc[ML_BL / 4 + si];
                u32x4 o; o.x = pk2(st[0], st[1]); o.y = pk2(st[2], st[3]); o.z = pk2(st[4], st[5]); o.w = pk2(st[6], st[7]);
                *p = o;
                const float mn = fmaxf(bl + m, a); const float dec = __expf(bl + m - mn), inw = __expf(a - mn); m = mn;
                st[0] = dec * st[0] + inw * bflo(u.x); st[1] = dec * st[1] + inw * bfhi(u.x); st[2] = dec * st[2] + inw * bflo(u.y); st[3] = dec * st[3] + inw * bfhi(u.y);
                st[4] = dec * st[4] + inw * bflo(u.z); st[5] = dec * st[5] + inw * bfhi(u.z); st[6] = dec * st[6] + inw * bflo(u.w); st[7] = dec * st[7] + inw * bfhi(u.w);
            }
        } else {
            const int r = gt - NTC; const int d = r & 127, h = (r >> 7) & 3, b = r >> 9;
            float* nl = (float*)(ws + WS_MLN); float st = 0.f, m = 0.f;
            for (int n = 0; n < NCH; ++n) { const int si = (b * NCH + n) * 4 + h;
                const float u = nl[(size_t)si * 128 + d]; const float a = sc[ML_A / 4 + si], bl = sc[ML_BL / 4 + si];
                nl[(size_t)si * 128 + d] = st; if (d == 0) sc[ML_MP / 4 + si] = m;
                const float mn = fmaxf(bl + m, a); st = __expf(bl + m - mn) * st + __expf(a - mn) * u; m = mn; }
        }
    }
}

__device__ __forceinline__ void ml_c_unit(const Args& args, Frame& F, int b, int n, int h) {
    unsigned char* ws = args.ws; const bf16* h1 = (const bf16*)(ws + WS_R1); const float* small = (const float*)(ws + WS_SMALL);
    const int t0 = b * SEQ + n * 64, tid = F.tid, lane = F.lane, w = F.wave, r16 = lane & 15, g4 = lane >> 4;
    LAS bf16* Qs = (LAS bf16*)F.lds;
    LAS bf16* Ks = (LAS bf16*)(F.lds + 17408);
    LAS bf16* P = (LAS bf16*)(F.lds + 34816);
    LAS bf16* VT = (LAS bf16*)(F.lds + 44032);
    LAS bf16* NT = (LAS bf16*)(F.lds + 80896);
    LAS float* red = (LAS float*)(F.lds + 85248);
    LAS float* bcs = (LAS float*)(F.lds + 85760);
    LAS float* igs = (LAS float*)(F.lds + 86016);
    LAS float* mts = (LAS float*)(F.lds + 86272);
    LAS float* psum = (LAS float*)(F.lds + 86528);
    const float* gb = args.in[I_GATEB];
    const int si = (b * NCH + n) * 4 + h;
    const float mprev = ((const float*)(ws + WS_MLSC))[ML_MP / 4 + si];
    if (w == 0) {
        const float ig = small[(size_t)(t0 + lane) * 128 + SM_DI + h] + gb[h];
        const float lf = log_sigmoid_(small[(size_t)(t0 + lane) * 128 + SM_DF + h] + gb[4 + h]);
        const float bc = ml_wave_incl_scan_add(lf, lane);
        const float gmb = ig - bc;
        const float pm = ml_wave_incl_scan_max(gmb, lane);
        bcs[lane] = bc; igs[lane] = gmb; mts[lane] = bc + fmaxf(pm, mprev);
    }
    if (w == 1) { const float* nl = (const float*)(ws + WS_MLN);
        for (int i = lane; i < 16 * LDQ; i += 64) { const int rr = i / LDQ, cc = i % LDQ; NT[i] = (bf16)((rr == 0 && cc < 128) ? f2bf(nl[(size_t)si * 128 + cc]) : 0u); } }
    stage_vt<256>(VT, h1 + (size_t)t0 * N_CD + H1_DV + h * 256, N_CD, tid);
    { const int d = tid & 127, tq = tid >> 7; const float* cw = args.in[I_CONVW]; float w4[4]; float qc[16];
#pragma unroll
        for (int j = 0; j < 4; ++j) w4[j] = cw[j * 1024 + h * 128 + d];
        ml_conv16(h1, b, n * 64 + 16 * tq, H1_DQ + h * 128 + d, w4, qc);
#pragma unroll
        for (int i = 0; i < 16; ++i) Qs[(16 * tq + i) * LDQ + d] = (bf16)f2bf(qc[i]);
#pragma unroll
        for (int j = 0; j < 4; ++j) w4[j] = cw[j * 1024 + 512 + h * 128 + d];
        ml_conv16(h1, b, n * 64 + 16 * tq, H1_DK + h * 128 + d, w4, qc);
#pragma unroll
        for (int i = 0; i < 16; ++i) Ks[(16 * tq + i) * LDQ + d] = (bf16)f2bf(qc[i] * 0.08838834764831845f); }
    __syncthreads();
    { const int mi = w >> 1; float rs[4] = {0.f, 0.f, 0.f, 0.f};
#pragma unroll
        for (int q = 0; q < 2; ++q) { const int ni = 2 * (w & 1) + q; f32x4 acc = {0.f, 0.f, 0.f, 0.f};
            if (ni <= mi) {
#pragma unroll
                for (int ks = 0; ks < 4; ++ks) acc = mfma16(lds_frag(Qs, LDQ, 16 * mi, 32 * ks, lane), lds_frag(Ks, LDQ, 16 * ni, 32 * ks, lane), acc); }
            const int s = 16 * ni + r16; const float gs = igs[s];
#pragma unroll
            for (int j = 0; j < 4; ++j) { const int t = 16 * mi + 4 * g4 + j; float v = 0.f;
                if (ni <= mi && s <= t) v = acc[j] * __expf(bcs[t] + gs - mts[t]);
                const unsigned vb = f2bf(v); P[t * LDK + s] = (bf16)vb; rs[j] += v; } }
#pragma unroll
        for (int j = 0; j < 4; ++j) { float s = rs[j]; s += __shfl_xor(s, 1); s += __shfl_xor(s, 2); s += __shfl_xor(s, 4); s += __shfl_xor(s, 8); if (r16 == 0) psum[(w & 1) * 64 + 16 * mi + 4 * g4 + j] = s; } }
    __syncthreads();
    const int mi = w & 3, e0 = (w >> 2) * 128;
    const bf16* C = (const bf16*)(ws + WS_R2) + (size_t)si * 256 * 128;
    f32x4 acc1[8], acc2[8]; f32x4 accn = {0.f, 0.f, 0.f, 0.f};
    { const bf16x8 p0 = lds_frag(P, LDK, 16 * mi, 0, lane), p1 = lds_frag(P, LDK, 16 * mi, 32, lane);
        bf16x8 qf[4];
#pragma unroll
        for (int ks = 0; ks < 4; ++ks) qf[ks] = lds_frag(Qs, LDQ, 16 * mi, 32 * ks, lane);
#pragma unroll
        for (int ks = 0; ks < 4; ++ks) accn = mfma16(qf[ks], lds_frag(NT, LDQ, 0, 32 * ks, lane), accn);
#pragma unroll
        for (int i = 0; i < 8; ++i) { const int et0 = e0 + 16 * i; f32x4 a = {0.f, 0.f, 0.f, 0.f}, c = {0.f, 0.f, 0.f, 0.f};
            a = mfma16(p0, lds_frag(VT, LDK, et0, 0, lane), a); a = mfma16(p1, lds_frag(VT, LDK, et0, 32, lane), a);
            if (n > 0) {
#pragma unroll
                for (int ks = 0; ks < 4; ++ks) { const bf16x8 sf = *(const GAS bf16x8*)(C + (size_t)(et0 + r16) * 128 + 32 * ks + 8 * g4); c = mfma16(qf[ks], sf, c); } }
            acc1[i] = a; acc2[i] = c; } }
    float hv[8][4]; float ss[4];
#pragma unroll
    for (int j = 0; j < 4; ++j) { const int t = 16 * mi + 4 * g4 + j;
        const float mt = mts[t]; const float wi = __expf(bcs[t] + mprev - mt);
        const float qn_inter = __shfl(accn[j], 16 * g4);
        const float qn = psum[t] + psum[64 + t] + wi * qn_inter;
        const float den = fmaxf(fabsf(qn), __expf(-mt)); const float inv = 1.0f / den; float s = 0.f;
#pragma unroll
        for (int i = 0; i < 8; ++i) { const float v = (acc1[i][j] + wi * acc2[i][j]) * inv; hv[i][j] = v; s += v * v; }
        s += __shfl_xor(s, 1); s += __shfl_xor(s, 2); s += __shfl_xor(s, 4); s += __shfl_xor(s, 8); ss[j] = s; }
    if (r16 == 0) {
#pragma unroll
        for (int j = 0; j < 4; ++j) red[w * 16 + 4 * g4 + j] = ss[j]; }
    __syncthreads();
    const float* gn = args.in[I_DNORM]; bf16* mixed = (bf16*)(ws + WS_MIX);
#pragma unroll
    for (int j = 0; j < 4; ++j) { const float tot = red[w * 16 + 4 * g4 + j] + red[(w ^ 4) * 16 + 4 * g4 + j]; const float rstd = 1.0f / sqrtf(tot * (1.0f / 256.f) + EPS);
        const size_t row = (size_t)(t0 + 16 * mi + 4 * g4 + j);
#pragma unroll
        for (int i = 0; i < 8; ++i) { const int e = e0 + 16 * i + r16; const float gate = bf2f(h1[row * N_CD + H1_DOG + h * 256 + e]);
            mixed[row * D + 1024 + h * 256 + e] = (bf16)f2bf(hv[i][j] * rstd * gn[e] * gate); } }
    __syncthreads();
}
__device__ __forceinline__ void ml_phase_a(const Args& args, Frame& F) { for (int u = F.bid; u < 1024; u += F.G) { const int h = u & 3, n = (u >> 2) & 63, b = u >> 8; ml_a_unit(args, F, b, n, h); } }
__device__ __forceinline__ void ml_phase_c(const Args& args, Frame& F) { for (int u = F.bid; u < 1024; u += F.G) { const int h = u & 3, n = (u >> 2) & 63, b = u >> 8; ml_c_unit(args, F, b, n, h); } }
__device__ __forceinline__ void ml_load_raw(const Args& args, int u, int tid, bool need_q, u32x4 (&R)[6]) {
    const int h = u & 3, n = (u >> 2) & 63, b = u >> 8;
    const bf16* h1 = (const bf16*)(args.ws + WS_R1); const size_t t0 = (size_t)(b * SEQ + n * 64);
#pragma unroll
    for (int i = 0; i < 2; ++i) { const int cid = tid + 512 * i, row = cid >> 4, ch = cid & 15; const bf16* hrow = h1 + (t0 + row) * N_CD + h * 128 + ch * 8;
        if (need_q) R[i] = *(const GAS u32x4*)(hrow + H1_DQ); R[2 + i] = *(const GAS u32x4*)(hrow + H1_DK); }
    R[4] = (u32x4){0u, 0u, 0u, 0u}; R[5] = (u32x4){0u, 0u, 0u, 0u};
    if (tid < 48 && n > 0) { const int row = tid >> 4, ch = tid & 15; const bf16* hrow = h1 + (t0 - 3 + row) * N_CD + h * 128 + ch * 8;
        if (need_q) R[4] = *(const GAS u32x4*)(hrow + H1_DQ); R[5] = *(const GAS u32x4*)(hrow + H1_DK); }
}
__device__ __forceinline__ void ml_store_raw(LAS unsigned char* Q, LAS unsigned char* K, LAS unsigned char* HQ, LAS unsigned char* HK, int tid, bool need_q, const u32x4 (&R)[6]) {
#pragma unroll
    for (int i = 0; i < 2; ++i) { const int cid = tid + 512 * i, row = cid >> 4, ch = cid & 15; const int off = row * 256 + (((ch ^ row) & 15) << 4);
        if (need_q) *(LAS u32x4*)(Q + off) = R[i]; *(LAS u32x4*)(K + off) = R[2 + i]; }
    if (tid < 48) { if (need_q) *(LAS u32x4*)(HQ + tid * 16) = R[4]; *(LAS u32x4*)(HK + tid * 16) = R[5]; }
}
__device__ __forceinline__ void ml_conv16_lds(const LAS unsigned char* X, const LAS unsigned char* HX, int tq, int d, const float (&w4)[4], float (&out)[16]) {
    float x[19];
#pragma unroll
    for (int i = 0; i < 19; ++i) { const int r = 16 * tq - 3 + i; x[i] = (r >= 0) ? bf2f(*(const LAS bf16*)(X + swz128(r, d))) : bf2f(*(const LAS bf16*)(HX + ((r + 3) * 128 + d) * 2)); }
#pragma unroll
    for (int i = 0; i < 16; ++i) { const float c = w4[0] * x[i] + w4[1] * x[i + 1] + w4[2] * x[i + 2] + w4[3] * x[i + 3]; out[i] = siluf_(c); }
}
constexpr int M2_Q = 0, M2_K = 16384, M2_P = 32768, M2_V0 = 41984, M2_V1 = 58368, M2_S0 = 74752, M2_S1 = 107520, M2_NT = 140288, M2_HQ = 140544, M2_HK = 141312,
              M2_BCS = 142080, M2_IGS = 142336, M2_MTS = 142592, M2_RED = 142848, M2_PSUM = 143360;
static_assert(M2_NT + 4096 <= LDS_BYTES - 1024 && M2_PSUM + 512 <= LDS_BYTES - 1024, "mlstm (c) LDS map");

__device__ __forceinline__ void ml_c_unit2(const Args& args, Frame& F, int b, int n, int h) {
    unsigned char* ws = args.ws; const bf16* h1 = (const bf16*)(ws + WS_R1); const float* small = (const float*)(ws + WS_SMALL);
    const int t0 = b * SEQ + n * 64, tid = F.tid, lane = F.lane, w = F.wave, r16 = lane & 15, g4 = lane >> 4;
    LAS unsigned char* Q = F.lds + M2_Q; LAS unsigned char* K = F.lds + M2_K; LAS bf16* P = (LAS bf16*)(F.lds + M2_P);
    LAS unsigned char* V0 = F.lds + M2_V0; LAS unsigned char* V1 = F.lds + M2_V1; LAS unsigned char* S0 = F.lds + M2_S0; LAS unsigned char* S1 = F.lds + M2_S1;
    LAS unsigned char* NT = F.lds + M2_NT; LAS unsigned char* HQ = F.lds + M2_HQ; LAS unsigned char* HK = F.lds + M2_HK;
    LAS float* bcs = (LAS float*)(F.lds + M2_BCS); LAS float* igs = (LAS float*)(F.lds + M2_IGS); LAS float* mts = (LAS float*)(F.lds + M2_MTS);
    LAS float* red = (LAS float*)(F.lds + M2_RED); LAS float* psum = (LAS float*)(F.lds + M2_PSUM);
    const float* gb = args.in[I_GATEB];
    const int si = (b * NCH + n) * 4 + h;
    const float mprev = ((const float*)(ws + WS_MLSC))[ML_MP / 4 + si];
    const bf16* Cg = (const bf16*)args.out + (size_t)33554432 + (size_t)si * 256 * 128;
    const bf16* Vg = h1 + (size_t)t0 * N_CD + H1_DV + h * 256;
    dma_tile128(V0, Vg, N_CD, 64, w, lane); dma_tile128(V1, Vg + 128, N_CD, 64, w, lane);
    if (n > 0) { dma_tile128(S0, Cg, 128, 128, w, lane); dma_tile128(S1, Cg + 128 * 128, 128, 128, w, lane); }
    if (w == 0) {
        const float ig = small[(size_t)(t0 + lane) * 128 + SM_DI + h] + gb[h];
        const float lf = log_sigmoid_(small[(size_t)(t0 + lane) * 128 + SM_DF + h] + gb[4 + h]);
        const float bc = ml_wave_incl_scan_add(lf, lane);
        const float gmb = ig - bc;
        const float pm = ml_wave_incl_scan_max(gmb, lane);
        bcs[lane] = bc; igs[lane] = gmb; mts[lane] = bc + fmaxf(pm, mprev);
    }
    if (w == 1) { const float* nl = (const float*)(ws + WS_MLN); const f32x2 nv = *(const f32x2*)(nl + (size_t)si * 128 + 2 * lane); *(LAS unsigned*)(NT + 4 * lane) = pk2(nv.x, nv.y); }
    { const int d = tid & 127, tq = tid >> 7; const float* cw = args.in[I_CONVW]; float w4[4]; float qc[16], kc[16];
#pragma unroll
        for (int j = 0; j < 4; ++j) w4[j] = cw[j * 1024 + h * 128 + d];
        ml_conv16_lds(Q, HQ, tq, d, w4, qc);
#pragma unroll
        for (int j = 0; j < 4; ++j) w4[j] = cw[j * 1024 + 512 + h * 128 + d];
        ml_conv16_lds(K, HK, tq, d, w4, kc);
        BAR_LDS();
#pragma unroll
        for (int i = 0; i < 16; ++i) { const int off = swz128(16 * tq + i, d); *(LAS bf16*)(Q + off) = (bf16)f2bf(qc[i]); *(LAS bf16*)(K + off) = (bf16)f2bf(kc[i] * 0.08838834764831845f); } }
    BAR_LDS();
    { const int mi = w >> 1; float rs = 0.f; const int t = 16 * mi + r16; const float bt = bcs[t] - mts[t];
#pragma unroll
        for (int q2 = 0; q2 < 2; ++q2) { const int ni = 2 * (w & 1) + q2; f32x4 acc = {0.f, 0.f, 0.f, 0.f};
            if (ni <= mi) {
#pragma unroll
                for (int ks = 0; ks < 4; ++ks) acc = mfma16(frag128(K, 16 * ni, 32 * ks, lane), frag128(Q, 16 * mi, 32 * ks, lane), acc); }
            const int s0 = 16 * ni + 4 * g4; float pv[4];
#pragma unroll
            for (int j = 0; j < 4; ++j) { float v = 0.f; if (ni <= mi && s0 + j <= t) v = acc[j] * __expf(bt + igs[s0 + j]); pv[j] = v; rs += v; }
            u32x2 o; o.x = pk2(pv[0], pv[1]); o.y = pk2(pv[2], pv[3]);
            *(LAS u32x2*)(P + t * LDK + s0) = o; }
        rs += __shfl_xor(rs, 16); rs += __shfl_xor(rs, 32);
        if (g4 == 0) psum[(w & 1) * 64 + t] = rs; }
    BAR_ALL();
    const int mi = w & 3, eh = w >> 2; const int t = 16 * mi + r16;
    f32x4 acc1[2][4], acc2[2][4]; f32x4 accn = {0.f, 0.f, 0.f, 0.f};
    { const bf16x8 p0 = lds_frag(P, LDK, 16 * mi, 0, lane), p1 = lds_frag(P, LDK, 16 * mi, 32, lane);
        bf16x8 qf[4];
#pragma unroll
        for (int ks = 0; ks < 4; ++ks) qf[ks] = frag128(Q, 16 * mi, 32 * ks, lane);
#pragma unroll
        for (int ks = 0; ks < 4; ++ks) accn = mfma16(frag128(NT, 0, 32 * ks, lane), qf[ks], accn);
#pragma unroll
        for (int hf = 0; hf < 2; ++hf) { const LAS unsigned char* Vt = hf ? V1 : V0; const LAS unsigned char* St = hf ? S1 : S0;
#pragma unroll
            for (int i = 0; i < 4; ++i) { const int e0 = 64 * eh + 16 * i; f32x4 a = {0.f, 0.f, 0.f, 0.f}, c = {0.f, 0.f, 0.f, 0.f};
                a = mfma16(tfrag128(Vt, 0, e0, lane), p0, a); a = mfma16(tfrag128(Vt, 32, e0, lane), p1, a);
                if (n > 0) {
#pragma unroll
                    for (int ks = 0; ks < 4; ++ks) c = mfma16(frag128(St, e0, 32 * ks, lane), qf[ks], c); }
                acc1[hf][i] = a; acc2[hf][i] = c; } } }
    const float mt = mts[t]; const float wi = __expf(bcs[t] + mprev - mt);
    const float qn_inter = __shfl(accn[0], r16);
    const float qn = psum[t] + psum[64 + t] + wi * qn_inter;
    const float inv = 1.0f / fmaxf(fabsf(qn), __expf(-mt));
    float ss = 0.f;
#pragma unroll
    for (int hf = 0; hf < 2; ++hf)
#pragma unroll
        for (int i = 0; i < 4; ++i)
#pragma unroll
            for (int j = 0; j < 4; ++j) { const float v = (acc1[hf][i][j] + wi * acc2[hf][i][j]) * inv; acc1[hf][i][j] = v; ss += v * v; }
    ss += __shfl_xor(ss, 16); ss += __shfl_xor(ss, 32);
    if (g4 == 0) red[eh * 64 + t] = ss;
    BAR_LDS();
    const float tot = red[t] + red[64 + t]; const float rstd = 1.0f / sqrtf(tot * (1.0f / 256.f) + EPS);
    const float* gn = args.in[I_DNORM]; bf16* mixed = (bf16*)(ws + WS_MIX);
    const size_t row = (size_t)(t0 + t);
#pragma unroll
    for (int hf = 0; hf < 2; ++hf)
#pragma unroll
        for (int i = 0; i < 4; ++i) { const int e = 128 * hf + 64 * eh + 16 * i + 4 * g4;
            const u32x2 gw = *(const GAS u32x2*)(h1 + row * N_CD + H1_DOG + h * 256 + e); const f32x4 gg = *(const f32x4*)(gn + e);
            u32x2 o; o.x = pk2(acc1[hf][i][0] * rstd * gg.x * bflo(gw.x), acc1[hf][i][1] * rstd * gg.y * bfhi(gw.x)); o.y = pk2(acc1[hf][i][2] * rstd * gg.z * bflo(gw.y), acc1[hf][i][3] * rstd * gg.w * bfhi(gw.y));
            *(GAS u32x2*)(mixed + row * D + 1024 + h * 256 + e) = o; }
}
__device__ __forceinline__ void ml_phase_c2(const Args& args, Frame& F) {
    u32x4 R[6];
    int u = F.bid;
    if (u < 1024) ml_load_raw(args, u, F.tid, true, R);
    for (; u < 1024; u += F.G) {
        const int h = u & 3, n = (u >> 2) & 63, b = u >> 8;
        BAR_ALL();
        ml_store_raw(F.lds + M2_Q, F.lds + M2_K, F.lds + M2_HQ, F.lds + M2_HK, F.tid, true, R);
        if (u + F.G < 1024) ml_load_raw(args, u + F.G, F.tid, true, R);
        BAR_LDS();
        ml_c_unit2(args, F, b, n, h);
    }
    BAR_ALL();
}

constexpr int MA_K = 0, MA_KT = 16384, MA_V0 = 34816, MA_V1 = 51200, MA_HK = 67584, MA_PART = 68352, MA_UU = 70400;
__device__ __forceinline__ void ml_a_unit2(const Args& args, Frame& F, int b, int n, int h) {
    unsigned char* ws = args.ws; const bf16* h1 = (const bf16*)(ws + WS_R1); const float* small = (const float*)(ws + WS_SMALL);
    const int t0 = b * SEQ + n * 64, tid = F.tid, lane = F.lane, w = F.wave;
    LAS unsigned char* K = F.lds + MA_K; LAS bf16* KT = (LAS bf16*)(F.lds + MA_KT); LAS unsigned char* V0 = F.lds + MA_V0; LAS unsigned char* V1 = F.lds + MA_V1;
    LAS unsigned char* HK = F.lds + MA_HK; LAS float* part = (LAS float*)(F.lds + MA_PART); LAS float* uu = (LAS float*)(F.lds + MA_UU);
    const float* gb = args.in[I_GATEB];
    const bf16* Vg = h1 + (size_t)t0 * N_CD + H1_DV + h * 256;
    dma_tile128(V0, Vg, N_CD, 64, w, lane); dma_tile128(V1, Vg + 128, N_CD, 64, w, lane);
    if (w == 0) {
        const float ig = small[(size_t)(t0 + lane) * 128 + SM_DI + h] + gb[h];
        const float lf = log_sigmoid_(small[(size_t)(t0 + lane) * 128 + SM_DF + h] + gb[4 + h]);
        const float bc = ml_wave_incl_scan_add(lf, lane); const float bl = __shfl(bc, 63);
        const float lu = bl - bc + ig; const float a = wave_max(lu);
        uu[lane] = __expf(lu - a);
        if (lane == 0) { float* sc = (float*)(ws + WS_MLSC); const int si = (b * NCH + n) * 4 + h; sc[ML_A / 4 + si] = a; sc[ML_BL / 4 + si] = bl; }
    }
    const int d = tid & 127, tq = tid >> 7;
    float kc[16];
    { const float* cw = args.in[I_CONVW]; float w4[4];
#pragma unroll
        for (int j = 0; j < 4; ++j) w4[j] = cw[j * 1024 + 512 + h * 128 + d];
        ml_conv16_lds(K, HK, tq, d, w4, kc); }
    BAR_LDS();
    { float loc = 0.f; unsigned wv[8];
#pragma unroll
        for (int i = 0; i < 16; i += 2) { const float k0 = kc[i] * 0.08838834764831845f * uu[16 * tq + i], k1 = kc[i + 1] * 0.08838834764831845f * uu[16 * tq + i + 1]; loc += k0 + k1; wv[i >> 1] = pk2(k0, k1); }
        u32x4 o0, o1; o0.x = wv[0]; o0.y = wv[1]; o0.z = wv[2]; o0.w = wv[3]; o1.x = wv[4]; o1.y = wv[5]; o1.z = wv[6]; o1.w = wv[7];
        *(LAS u32x4*)(KT + d * LDK + 16 * tq) = o0; *(LAS u32x4*)(KT + d * LDK + 16 * tq + 8) = o1;
        part[tq * 128 + d] = loc; }
    BAR_ALL();
    if (tid < 128) { float* nl = (float*)(ws + WS_MLN); nl[(size_t)((b * NCH + n) * 4 + h) * 128 + tid] = part[tid] + part[128 + tid] + part[256 + tid] + part[384 + tid]; }
    bf16* U = (bf16*)args.out + (size_t)33554432 + (size_t)((b * NCH + n) * 4 + h) * 256 * 128;
    const bf16x8 a0 = lds_frag(KT, LDK, 16 * w, 0, lane), a1 = lds_frag(KT, LDK, 16 * w, 32, lane);
#pragma unroll 4
    for (int et = 0; et < 16; ++et) { const LAS unsigned char* Vt = (et < 8) ? V0 : V1; const int c0 = (et & 7) * 16;
        f32x4 acc = {0.f, 0.f, 0.f, 0.f};
        acc = mfma16(a0, tfrag128(Vt, 0, c0, lane), acc);
        acc = mfma16(a1, tfrag128(Vt, 32, c0, lane), acc);
        u32x2 o; o.x = pk2(acc[0], acc[1]); o.y = pk2(acc[2], acc[3]);
        *(GAS u32x2*)(U + (size_t)(16 * et + (lane & 15)) * 128 + 16 * w + 4 * (lane >> 4)) = o; }
}
__device__ __forceinline__ void ml_phase_a2(const Args& args, Frame& F) {
    u32x4 R[6];
    int u = F.bid;
    if (u < 1024) ml_load_raw(args, u, F.tid, false, R);
    for (; u < 1024; u += F.G) {
        const int h = u & 3, n = (u >> 2) & 63, b = u >> 8;
        BAR_ALL();
        ml_store_raw(F.lds + MA_K, F.lds + MA_K, F.lds + MA_HK, F.lds + MA_HK, F.tid, false, R);
        if (u + F.G < 1024) ml_load_raw(args, u + F.G, F.tid, false, R);
        BAR_LDS();
        ml_a_unit2(args, F, b, n, h);
    }
    BAR_ALL();
}
constexpr int N_PHASES = 20;
constexpr int LDS_TAB_OFF = LDS_BYTES - 1024, LDS_BARW_OFF = LDS_BYTES - 512;

__device__ __forceinline__ void moe_table(Frame& F, int layer) {
    volatile LAS int* tab = (volatile LAS int*)(F.lds + LDS_TAB_OFF);
    __syncthreads();
    if (F.tid == 0) { int acc = 0;
        for (int e = 0; e < 16; ++e) { const int c = (int)__hip_atomic_load((unsigned*)(F.ctl + CW_CNT) + (layer * 16 + e) * 64, RLX_AGENT); tab[e] = acc; tab[32 + e] = c; acc += (c + 255) >> 8; }
        tab[16] = acc; }
    __syncthreads();
}

__global__ void __launch_bounds__(512, 2) hybrid_fwd(Args args) {
    extern __shared__ __attribute__((aligned(16))) unsigned char lds_raw[];
    Frame F;
    F.lds = (LAS unsigned char*)lds_raw;
    F.tid = threadIdx.x; F.lane = F.tid & 63; F.wave = __builtin_amdgcn_readfirstlane(F.tid >> 6);
    F.G = gridDim.x; F.bid = blockIdx.x;
    unsigned char* ws = args.ws;
    F.ctl = (gu32*)(ws + WS_CTL);
    if (F.tid < 256) ((LAS unsigned*)(F.lds + LDS_TAB_OFF))[F.tid] = 0u;
    __syncthreads();
    XcdBarrier bar; bar.bar = (unsigned*)(F.ctl + CW_BAR); bar.x = 0; bar.st = nullptr;
    if (args.use_bar) bar = xcd_barrier_post((unsigned*)(F.ctl + CW_BAR), (volatile LAS unsigned*)(F.lds + LDS_BARW_OFF));
    const int lo = args.ph_lo, hi = args.ph_hi;
#ifndef PH_MASK
#define PH_MASK 0xffffffu
#endif
#define IN(k) (((PH_MASK >> (k)) & 1u) && lo <= (k) && (k) < hi)
#define SEAM(k) do { if (IN(k) && IN((k) + 1)) xcd_barrier(bar); } while (0)
#ifndef DIAG_OC_MODE
#define DIAG_OC_MODE 0
#endif
#ifndef DIAG_OC_SCALE
#define DIAG_OC_SCALE 0.f
#endif
#ifndef PROBE_SKIP
#define PROBE_SKIP 0
#endif
#ifndef PROBE_DUP
#define PROBE_DUP -1
#endif
#define REP(k) for (int _r = 0; _r < ((PROBE_DUP == (k)) ? 2 : 1); ++_r)
#define REPBAR(k) do { if (PROBE_DUP == (k) && _r == 0) xcd_barrier(bar); } while (0)
    const volatile LAS int* tab = (const volatile LAS int*)(F.lds + LDS_TAB_OFF);

    if (IN(0)) REP(0) { p0_prologue(args, F); REPBAR(0); } SEAM(0);
    if (IN(1)) REP(1) { pg8::StaticOrder S; S.init((const bf16*)(ws + WS_XB), D, (const bf16*)(ws + WS_WINAB), D, T, N_AB, F.G, F.bid);
        pg8::EpiAB E{(bf16*)(ws + WS_R1), (const float*)(ws + WS_LB)};
        pg8::gemm_phase<pg8::EpiAB, pg8::StaticOrder, false>(F.lds, D, S, E); REPBAR(1); } SEAM(1);
    if (IN(2)) REP(2) { ab_phase_a3(args, F); REPBAR(2); } SEAM(2);
    if (IN(3)) REP(3) { ab_scan_p(args, F); REPBAR(3); } SEAM(3);
    if (IN(4)) REP(4) { ab_phase_c3(args, F); REPBAR(4); } SEAM(4);
    if (IN(5)) REP(5) { pg8::StaticOrder S; S.init((const bf16*)(ws + WS_MIX), D, (const bf16*)(ws + WS_WOUTAB), D, T, D, F.G, F.bid);
        pg8::EpiBf16 E{(bf16*)(ws + WS_TMP), D};
        pg8::gemm_phase<pg8::EpiBf16, pg8::StaticOrder, false>(F.lds, D, S, E); REPBAR(5); } SEAM(5);
    if (IN(6)) REP(6) { ln_phase<0, true, false>(args, F, 0, args.in[I_X]); REPBAR(6); } SEAM(6);
    if (IN(7)) REP(7) { moe_table(F, 0);
        pg8::MoeOrder S{(const char*)(ws + WS_XB), (const char*)(ws + WS_W13), D, D, 4, F.G, F.bid, 1024, tab, (const int*)(ws + WS_LIST), true};
        pg8::EpiMoe1 E{(bf16*)(ws + WS_MIX), (const float*)(ws + WS_WL), tab};
        pg8::gemm_phase<pg8::EpiMoe1, pg8::MoeOrder, true>(F.lds, D, S, E); REPBAR(7); } SEAM(7);
    if (IN(8)) REP(8) { moe_table(F, 0);
        pg8::MoeOrder S{(const char*)(ws + WS_MIX), (const char*)(ws + WS_W2T), DEXP, DEXP, 8, F.G, F.bid, 2048, tab, (const int*)(ws + WS_LIST), false};
        pg8::EpiMoe2 E{(bf16*)(ws + WS_R2), (const int*)(ws + WS_LIST), tab};
        pg8::gemm_phase<pg8::EpiMoe2, pg8::MoeOrder, false>(F.lds, DEXP, S, E); REPBAR(8); } SEAM(8);
    if (IN(9)) REP(9) { ln_phase<1, false, false>(args, F, 0, nullptr); REPBAR(9); } SEAM(9);
    if (IN(10)) REP(10) { pg8::StaticOrder S; S.init((const bf16*)(ws + WS_XB), D, (const bf16*)(ws + WS_WINCD), D, T, N_CD, F.G, F.bid);
        pg8::EpiCD E{(bf16*)(ws + WS_R1), (float*)(ws + WS_SMALL)};
        pg8::gemm_phase<pg8::EpiCD, pg8::StaticOrder, false>(F.lds, D, S, E); REPBAR(10); } SEAM(10);
    if (IN(11)) REP(11) {
        { pg8::HeadOrder S{(const char*)(ws + WS_R1), (const char*)(ws + WS_WUK), N_CD, 256, 128, F.G, F.bid};
          pg8::EpiHead E{(bf16*)args.out, D, 256, 2, 0, 0.f};
          pg8::gemm_phase<pg8::EpiHead, pg8::HeadOrder, false>(F.lds, 256 + args.pad, S, E); }
        if (!(PROBE_SKIP & 1)) dsa_indexer(args, F);
        ml_phase_a2(args, F); REPBAR(11); } SEAM(11);
    if (IN(12)) REP(12) { dsa_prep_rows(args, F); if (!(PROBE_SKIP & 2)) dsa_topk(args, F); ml_scan(args, F); REPBAR(12); } SEAM(12);
    if (IN(13)) REP(13) { if (!(PROBE_SKIP & 4)) dsa_attention(args, F, _r == 0 ? (bf16*)args.out : (bf16*)(ws + WS_MIX)); ml_phase_c2(args, F); REPBAR(13); } SEAM(13);
    if (IN(14)) REP(14) { pg8::HeadOrder S{(const char*)args.out, (const char*)(ws + WS_WUV), D, 256, 256, F.G, F.bid};
        pg8::EpiHead E{(bf16*)(ws + WS_MIX), D, 128, 1, DIAG_OC_MODE, DIAG_OC_SCALE};
        pg8::gemm_phase<pg8::EpiHead, pg8::HeadOrder, false>(F.lds, 256 + args.pad, S, E); REPBAR(14); } SEAM(14);
    if (IN(15)) REP(15) { pg8::StaticOrder S; S.init((const bf16*)(ws + WS_MIX), D, (const bf16*)(ws + WS_WOUTCD), D, T, D, F.G, F.bid);
        pg8::EpiBf16 E{(bf16*)(ws + WS_TMP), D};
        pg8::gemm_phase<pg8::EpiBf16, pg8::StaticOrder, false>(F.lds, D, S, E); REPBAR(15); } SEAM(15);
    if (IN(16)) REP(16) { ln_phase<0, false, false>(args, F, 1, nullptr); REPBAR(16); } SEAM(16);
    if (IN(17)) REP(17) { moe_table(F, 1);
        pg8::MoeOrder S{(const char*)(ws + WS_XB), (const char*)(ws + WS_W13), D, D, 4, F.G, F.bid, 1024, tab, (const int*)(ws + WS_LIST), true};
        pg8::EpiMoe1 E{(bf16*)(ws + WS_MIX), (const float*)(ws + WS_WL), tab};
        pg8::gemm_phase<pg8::EpiMoe1, pg8::MoeOrder, true>(F.lds, D, S, E); REPBAR(17); } SEAM(17);
    if (IN(18)) REP(18) { moe_table(F, 1);
        pg8::MoeOrder S{(const char*)(ws + WS_MIX), (const char*)(ws + WS_W2T), DEXP, DEXP, 8, F.G, F.bid, 2048, tab, (const int*)(ws + WS_LIST), false};
        pg8::EpiMoe2 E{(bf16*)(ws + WS_R2), (const int*)(ws + WS_LIST), tab};
        pg8::gemm_phase<pg8::EpiMoe2, pg8::MoeOrder, false>(F.lds, DEXP, S, E); REPBAR(18); } SEAM(18);
    if (IN(19)) { ln_phase<1, false, true>(args, F, 1, nullptr); }
#undef IN
#undef SEAM
}

#ifndef MK_ONE_LAUNCH
#define MK_ONE_LAUNCH 1
#endif
extern "C" void kernel_launch(void* const* d_in, const int* in_sizes, int n_in, void* d_out, int out_size, void* d_ws, size_t ws_size, hipStream_t stream) {
    static int grid = 0;
    if (grid == 0) {
        if (n_in != 24 || in_sizes[0] != T * D || out_size != T * D || ws_size < WS_END) { fprintf(stderr, "kernel_launch: unexpected shapes (n_in %d, in0 %d, out %d, ws %zu < %zu); nothing launched\n", n_in, n_in > 0 ? in_sizes[0] : -1, out_size, ws_size, (size_t)WS_END); grid = -1; return; }
        int dev = 0, cus = 0, per_cu = 0;
        if (hipGetDevice(&dev) != hipSuccess || hipDeviceGetAttribute(&cus, hipDeviceAttributeMultiprocessorCount, dev) != hipSuccess) { grid = -1; return; }
        if (hipFuncSetAttribute((const void*)hybrid_fwd, hipFuncAttributeMaxDynamicSharedMemorySize, LDS_BYTES) != hipSuccess) { fprintf(stderr, "kernel_launch: hipFuncSetAttribute failed\n"); grid = -1; return; }
        if (hipOccupancyMaxActiveBlocksPerMultiprocessor(&per_cu, (const void*)hybrid_fwd, 512, LDS_BYTES) != hipSuccess || per_cu < 1) fprintf(stderr, "kernel_launch: occupancy query reports %d\n", per_cu);
        (void)hipGetLastError();
        grid = cus;
    }
    if (grid < 0) return;
    if (hipMemsetAsync((char*)d_ws + WS_CTL, 0, CTL_ZERO_BYTES, stream) != hipSuccess) return;
    Args a{};
    for (int i = 0; i < 24; ++i) a.in[i] = (const float*)d_in[i];
    a.out = (float*)d_out; a.ws = (unsigned char*)d_ws; a.pad = 0;
#if MK_ONE_LAUNCH
    a.ph_lo = 0; a.ph_hi = N_PHASES; a.use_bar = 1;
    hipLaunchKernelGGL(hybrid_fwd, dim3(grid), dim3(512), LDS_BYTES, stream, a);
#else
    a.use_bar = 0;
    for (int p = 0; p < N_PHASES; ++p) { a.ph_lo = p; a.ph_hi = p + 1; hipLaunchKernelGGL(hybrid_fwd, dim3(grid), dim3(512), LDS_BYTES, stream, a); }
#endif
}
```

```cpp
#include <hip/hip_runtime.h>
#include <cstdio>
#include <cstdint>

#define LAS __attribute__((address_space(3)))
#define GAS __attribute__((address_space(1)))
typedef unsigned short bf16;
typedef short bf16x8 __attribute__((ext_vector_type(8)));
typedef short s16x4 __attribute__((ext_vector_type(4)));
typedef float f32x4 __attribute__((ext_vector_type(4)));
typedef float f32x2 __attribute__((ext_vector_type(2)));
typedef unsigned u32x4 __attribute__((ext_vector_type(4)));
typedef unsigned u32x2 __attribute__((ext_vector_type(2)));
typedef GAS unsigned gu32;

constexpr int BATCH = 4, SEQ = 4096, T = BATCH * SEQ, D = 2048, NCH = SEQ / 64;
constexpr int N_AB = 7168, PSRC_AB = 7184;
constexpr int N_CD = 5632, PSRC_CD = 5464;
constexpr int NE = 16, DEXP = 512;
constexpr float DN_ALPHA = 1.4142135623730951f;
constexpr float EPS = 1e-5f;

constexpr size_t MiB = 1u << 20;
constexpr size_t WS_CTL = 0, CTL_ZERO_BYTES = 128 * 1024;
constexpr size_t WS_LB = 1 * MiB;
constexpr size_t WS_MLSC = 1 * MiB + 65536;
constexpr size_t WS_GA = 2 * MiB;
constexpr size_t WS_GB = 3 * MiB;
constexpr size_t WS_MLN = 4 * MiB;
constexpr size_t WS_LIST = 5 * MiB;
constexpr size_t WS_WL = 6 * MiB;
constexpr size_t WS_SMALL = 8 * MiB;
constexpr size_t WS_LAB = 16 * MiB;
constexpr size_t WS_IDX = 32 * MiB;
constexpr size_t WS_CKVN = 40 * MiB;
constexpr size_t WS_W = 48 * MiB;
constexpr size_t WS_WINAB = WS_W, WS_WOUTAB = WS_W + 28 * MiB, WS_WINCD = WS_W + 36 * MiB, WS_WOUTCD = WS_W + 58 * MiB, WS_WUK = WS_W + 66 * MiB, WS_WUV = WS_W + 67 * MiB;
constexpr size_t WS_XB = 116 * MiB;
constexpr size_t WS_MIX = 180 * MiB;
constexpr size_t WS_R1 = 244 * MiB;
constexpr size_t WS_TMP = WS_R1, WS_W13 = WS_R1 + 128 * MiB, WS_W2T = WS_R1 + 192 * MiB;
constexpr size_t WS_R2 = 468 * MiB;
constexpr size_t WS_END = 598 * MiB;
constexpr int CW_TMO = 0, CW_CODE = 1;
constexpr int CW_BAR = 4096;
constexpr int CW_CNT = 16384;
static_assert((CW_CNT + 2 * 16 * 64) * 4 <= (int)CTL_ZERO_BYTES && (CW_BAR + 3456) * 4 <= (int)CTL_ZERO_BYTES, "control words inside the cleared region");

constexpr int RING_BYTES = 131072;
constexpr int LDSCTL_OFF = RING_BYTES, MISC_OFF = LDSCTL_OFF + 320;
constexpr int LDS_BYTES = 147456;

#define RLX_AGENT __ATOMIC_RELAXED, __HIP_MEMORY_SCOPE_AGENT
#define LDS_WAIT() asm volatile("s_waitcnt lgkmcnt(0)" ::: "memory")
#define VM_WAIT() asm volatile("s_waitcnt vmcnt(0)" ::: "memory")
__device__ __forceinline__ unsigned f2bf(float f) { unsigned u = __builtin_bit_cast(unsigned, f); return (u + 0x7fffu + ((u >> 16) & 1u)) >> 16; }
__device__ __forceinline__ unsigned pk2(float lo, float hi) { return f2bf(lo) | (f2bf(hi) << 16); }
__device__ __forceinline__ float bf2f(unsigned b) { return __builtin_bit_cast(float, b << 16); }
__device__ __forceinline__ float bflo(unsigned w) { return __builtin_bit_cast(float, w << 16); }
__device__ __forceinline__ float bfhi(unsigned w) { return __builtin_bit_cast(float, w & 0xffff0000u); }
__device__ __forceinline__ unsigned cvt_pk_bf16(float lo, float hi) { unsigned r; asm volatile("v_cvt_pk_bf16_f32 %0, %1, %2" : "=v"(r) : "v"(lo), "v"(hi)); return r; }
__device__ __forceinline__ float sigmoidf_(float v) { return __builtin_amdgcn_rcpf(1.0f + __expf(-v)); }
__device__ __forceinline__ float siluf_(float v) { return v * __builtin_amdgcn_rcpf(1.0f + __expf(-v)); }
__device__ __forceinline__ float wave_sum(float v) {
#pragma unroll
    for (int o = 1; o < 64; o <<= 1) v += __shfl_xor(v, o);
    return v;
}
__device__ __forceinline__ float wave_max(float v) {
#pragma unroll
    for (int o = 1; o < 64; o <<= 1) v = fmaxf(v, __shfl_xor(v, o));
    return v;
}
namespace pg8 {
constexpr int BM = 256, BK = 64, HALF = 128, HTB = HALF * BK * 2, STAGE_BYTES = 8 * HTB, NXCD = 8, WGM = 8;
__host__ __device__ __forceinline__ int lds_byte(int r, int c) { const int st = (r >> 4) * 2 + (c >> 5), rr = r & 15, cc = c & 31, ob = rr * 64 + cc * 2; return st * 1024 + (ob ^ (((ob >> 9) & 1) << 5)); }
__host__ __device__ __forceinline__ void stage_rc(int b, int& R, int& C) { const int st = b / 1024, sb = b % 1024, swz = sb ^ (((sb >> 9) & 1) << 5); R = (st >> 1) * 16 + swz / 64; C = (st & 1) * 32 + (swz % 64) / 2; }
__host__ __device__ __forceinline__ int perm32(int rho) { const int n = rho >> 4, i = rho & 15; return 8 * (i >> 2) + 4 * n + (i & 3); }

struct Unit { int pm, pn, ex; };

struct StaticOrder {
    const char* A; const char* Bt; int lda, ldb;
    int nM, nN, nwg, G, c;
    __device__ void init(const bf16* A_, int lda_, const bf16* Bt_, int ldb_, int M, int N, int G_, int c_) { A = (const char*)A_; Bt = (const char*)Bt_; lda = lda_; ldb = ldb_; nM = M / BM; nN = N / BM; nwg = nM * nN; G = G_; c = c_; }
    __device__ bool next(int i, Unit& u) const {
        const long L = (long)i * G + c; if (L >= nwg) return false;
        int wgid = (int)L; { const int q = nwg / NXCD, r = nwg % NXCD, xcd = wgid % NXCD, off = wgid / NXCD; wgid = (xcd < r ? xcd * (q + 1) : r * (q + 1) + (xcd - r) * q) + off; }
        const int nig = WGM * nN, gid = wgid / nig, fm = gid * WGM, gsz = (nM - fm) < WGM ? (nM - fm) : WGM;
        u.pm = fm + ((wgid % nig) % gsz); u.pn = (wgid % nig) / gsz; u.ex = 0; return true;
    }
    __device__ __forceinline__ const char* a_base(const Unit& u) const { return A + (size_t)u.pm * BM * lda * 2; }
    __device__ __forceinline__ const char* b_base(const Unit& u) const { return Bt + (size_t)u.pn * BM * ldb * 2; }
    __device__ __forceinline__ unsigned a_rowoff(const Unit&, int) const { return 0u; }
};

template <class Epi, class Sched, bool GATHER = false>
__device__ __forceinline__ void gemm_phase(LAS unsigned char* lds, const int K, const Sched& S, const Epi& E) {
    const int tid = threadIdx.x, wid = __builtin_amdgcn_readfirstlane(tid >> 6), lane = tid & 63, wr = wid >> 2, wc = wid & 3, fr = lane & 15, fq = lane >> 4;
    const int nt = K / BK;
    const int lda = S.lda, ldb = S.ldb;
    int Rst[2], Cst[2];
    unsigned voffA[2], voffB[2];
#pragma unroll
    for (int i = 0; i < 2; ++i) { int R, C; stage_rc(tid * 16 + i * 8192, R, C); Rst[i] = R; Cst[i] = C; const int Rb = Epi::PERM ? ((R & ~31) + perm32(R & 31)) : R;
        voffA[i] = (unsigned)(R * lda + C) * 2u; voffB[i] = (unsigned)(Rb * ldb + C) * 2u; }
    const size_t kstep = (size_t)(BK * 2);
    const size_t hstepA = (size_t)HALF * lda * 2, hstepB = (size_t)HALF * ldb * 2;
    const unsigned ldsw = (unsigned)wid * 1024u;
    const int aoff = lds_byte(wr * 64 + fr, fq * 8), boff = lds_byte(wc * 32 + fr, fq * 8);
    unsigned vc[2][2], vn[2][2];
#define PG8_SA(b, h) (((b) * 2 + (h)) * HTB)
#define PG8_SB(b, h) ((4 + (b) * 2 + (h)) * HTB)
#define PG8_STAGE_B(bufoff, gbase) do { _Pragma("unroll") for (int _i = 0; _i < 2; ++_i) \
        __builtin_amdgcn_global_load_lds((const unsigned*)((const char*)(gbase) + voffB[_i]), (LAS unsigned*)(lds + (bufoff) + ldsw + _i * 8192), 16, 0, 0); } while (0)
#define PG8_STAGE_A(bufoff, gbase, h, vs) do { _Pragma("unroll") for (int _i = 0; _i < 2; ++_i) { \
        const char* _p = GATHER ? ((const char*)(gbase) + (vs)[h][_i]) : ((const char*)(gbase) + (h) * hstepA + voffA[_i]); \
        __builtin_amdgcn_global_load_lds((const unsigned*)_p, (LAS unsigned*)(lds + (bufoff) + ldsw + _i * 8192), 16, 0, 0); } } while (0)
#define PG8_LDA(dst, b, h) do { _Pragma("unroll") for (int m = 0; m < 4; ++m) _Pragma("unroll") for (int k = 0; k < 2; ++k) dst[m][k] = *(const LAS bf16x8*)(lds + PG8_SA(b, h) + aoff + m * 2048 + k * 1024); } while (0)
#define PG8_LDB(dst, b, h) do { _Pragma("unroll") for (int n = 0; n < 2; ++n) _Pragma("unroll") for (int k = 0; k < 2; ++k) dst[n][k] = *(const LAS bf16x8*)(lds + PG8_SB(b, h) + boff + n * 2048 + k * 1024); } while (0)
#define PG8_MMA(ai, bj, At, Bt) do { __builtin_amdgcn_s_setprio(1); _Pragma("unroll") for (int m = 0; m < 4; ++m) _Pragma("unroll") for (int n = 0; n < 2; ++n) _Pragma("unroll") for (int k = 0; k < 2; ++k) \
        acc[ai][bj][m][n] = __builtin_amdgcn_mfma_f32_16x16x32_bf16(Bt[n][k], At[m][k], acc[ai][bj][m][n], 0, 0, 0); __builtin_amdgcn_s_setprio(0); } while (0)
#define PG8_WAIT_V(n) asm volatile("s_waitcnt vmcnt(" #n ")" ::: "memory")
#define PG8_WAIT_L(n) asm volatile("s_waitcnt lgkmcnt(" #n ")" ::: "memory")
#define PG8_BAR __builtin_amdgcn_s_barrier()
#define PG8_SCHED __builtin_amdgcn_sched_barrier(0)
#define PG8_LOADV(dst, u) do { if constexpr (GATHER) { _Pragma("unroll") for (int _h = 0; _h < 2; ++_h) _Pragma("unroll") for (int _i = 0; _i < 2; ++_i) \
        dst[_h][_i] = S.a_rowoff(u, _h * HALF + Rst[_i]) + (unsigned)Cst[_i] * 2u; } } while (0)
    Unit cur, nxt; int ui = 0;
    if (!S.next(0, cur)) return;
    f32x4 acc[2][2][4][2];
#pragma unroll
    for (int a = 0; a < 2; ++a)
#pragma unroll
        for (int b = 0; b < 2; ++b)
#pragma unroll
            for (int m = 0; m < 4; ++m)
#pragma unroll
                for (int n = 0; n < 2; ++n) acc[a][b][m][n] = (f32x4){0.f, 0.f, 0.f, 0.f};
    bf16x8 At[4][2], B0[2][2], B1[2][2];
    const char* cA = S.a_base(cur); const char* cB = S.b_base(cur);
    PG8_LOADV(vc, cur);
#pragma unroll
    for (int _h = 0; _h < 2; ++_h)
#pragma unroll
        for (int _i = 0; _i < 2; ++_i) vn[_h][_i] = GATHER ? vc[_h][_i] : 0u;
    PG8_STAGE_B(PG8_SB(0, 0), cB); PG8_STAGE_B(PG8_SB(0, 1), cB + hstepB); PG8_STAGE_A(PG8_SA(0, 0), cA, 0, vc); PG8_STAGE_A(PG8_SA(0, 1), cA, 1, vc);
    if (wr == 1) PG8_BAR;
    PG8_WAIT_V(2); PG8_BAR;
    PG8_STAGE_B(PG8_SB(1, 0), cB + kstep); PG8_STAGE_A(PG8_SA(1, 0), cA + kstep, 0, vc); PG8_STAGE_B(PG8_SB(1, 1), cB + hstepB + kstep);
    PG8_WAIT_V(6); PG8_BAR;
    for (;;) {
        const bool has_next = S.next(ui + 1, nxt);
        const char* nA = has_next ? S.a_base(nxt) : cA; const char* nB = has_next ? S.b_base(nxt) : cB;
        if constexpr (GATHER) { if (has_next) { PG8_LOADV(vn, nxt); } else {
#pragma unroll
            for (int _h = 0; _h < 2; ++_h)
#pragma unroll
                for (int _i = 0; _i < 2; ++_i) vn[_h][_i] = vc[_h][_i]; }
            asm volatile("s_waitcnt vmcnt(0)" :: "v"(vn[0][0]), "v"(vn[0][1]), "v"(vn[1][0]), "v"(vn[1][1]) : "memory"); }
        for (int t = 0; t < nt; t += 2) {
            const bool last = (t == nt - 2);
            const char* a1 = cA + (size_t)(t + 1) * kstep;
            const char* a2 = last ? nA : cA + (size_t)(t + 2) * kstep; const char* b2 = last ? nB : cB + (size_t)(t + 2) * kstep;
            const char* a3 = a2 + kstep; const char* b3 = b2 + kstep;
            unsigned vs[2][2];
#pragma unroll
            for (int _h = 0; _h < 2; ++_h)
#pragma unroll
                for (int _i = 0; _i < 2; ++_i) vs[_h][_i] = GATHER ? (last ? vn[_h][_i] : vc[_h][_i]) : 0u;
            PG8_LDB(B0, 0, 0); PG8_LDB(B1, 0, 1); PG8_SCHED; PG8_LDA(At, 0, 0); PG8_STAGE_A(PG8_SA(1, 1), a1, 1, vc);
            PG8_WAIT_V(8); PG8_WAIT_L(0); PG8_BAR; PG8_MMA(0, 0, At, B0); PG8_MMA(0, 1, At, B1); PG8_BAR; PG8_SCHED;
            PG8_LDA(At, 0, 1); PG8_STAGE_B(PG8_SB(0, 0), b2); PG8_STAGE_B(PG8_SB(0, 1), b2 + hstepB); PG8_STAGE_A(PG8_SA(0, 0), a2, 0, vs);
            PG8_WAIT_V(8); PG8_WAIT_L(0); PG8_BAR; PG8_MMA(1, 0, At, B0); PG8_MMA(1, 1, At, B1); PG8_BAR; PG8_SCHED;
            PG8_LDB(B0, 1, 0); PG8_LDB(B1, 1, 1); PG8_SCHED; PG8_LDA(At, 1, 0); PG8_STAGE_A(PG8_SA(0, 1), a2, 1, vs);
            PG8_WAIT_V(8); PG8_WAIT_L(0); PG8_BAR; PG8_MMA(0, 0, At, B0); PG8_MMA(0, 1, At, B1); PG8_BAR; PG8_SCHED;
            PG8_LDA(At, 1, 1); PG8_STAGE_B(PG8_SB(1, 0), b3); PG8_STAGE_B(PG8_SB(1, 1), b3 + hstepB); PG8_STAGE_A(PG8_SA(1, 0), a3, 0, vs);
            PG8_WAIT_V(8); PG8_WAIT_L(0); PG8_BAR; PG8_MMA(1, 0, At, B0); PG8_MMA(1, 1, At, B1); PG8_BAR; PG8_SCHED;
        }
        if (wr == 0) PG8_BAR;
        E(acc, cur, wr, wc, fr, fq);
        if (!has_next) break;
#pragma unroll
        for (int a = 0; a < 2; ++a)
#pragma unroll
            for (int b = 0; b < 2; ++b)
#pragma unroll
                for (int m = 0; m < 4; ++m)
#pragma unroll
                    for (int n = 0; n < 2; ++n) acc[a][b][m][n] = (f32x4){0.f, 0.f, 0.f, 0.f};
        cur = nxt; cA = nA; cB = nB; ++ui;
#pragma unroll
        for (int _h = 0; _h < 2; ++_h)
#pragma unroll
            for (int _i = 0; _i < 2; ++_i) vc[_h][_i] = vn[_h][_i];
        if (wr == 1) PG8_BAR;
    }
    PG8_WAIT_V(0);
    PG8_BAR;
#undef PG8_SA
#undef PG8_SB
#undef PG8_STAGE_A
#undef PG8_STAGE_B
#undef PG8_LDA
#undef PG8_LDB
#undef PG8_MMA
#undef PG8_WAIT_V
#undef PG8_WAIT_L
#undef PG8_BAR
#undef PG8_SCHED
#undef PG8_LOADV
}
}
namespace pg8 {
struct EpiF32 {
    static constexpr bool PERM = false;
    float* C; int ldc;
    __device__ __forceinline__ void operator()(const f32x4 (&acc)[2][2][4][2], const Unit& u, int wr, int wc, int fr, int fq) const {
        const int row0 = u.pm * BM + wr * 64 + fr, col0 = u.pn * BM + wc * 32 + 4 * fq;
#pragma unroll
        for (int ai = 0; ai < 2; ++ai)
#pragma unroll
            for (int m = 0; m < 4; ++m) { float* rowp = C + (size_t)(row0 + ai * HALF + m * 16) * ldc + col0;
#pragma unroll
                for (int bj = 0; bj < 2; ++bj)
#pragma unroll
                    for (int n = 0; n < 2; ++n) *(f32x4*)(rowp + bj * HALF + n * 16) = acc[ai][bj][m][n]; }
    }
};
__device__ __forceinline__ float epi_act(int mode, float v, float aux) {
    if (mode == 1) return siluf_(v);
    if (mode == 2) return v * aux;
    if (mode == 3) return __logf(aux + (1.0f - aux) * sigmoidf_(v));
    if (mode == 4) return sigmoidf_(v);
    if (mode == 5) return 0.f;
    return v;
}
__device__ __forceinline__ void store_bf16_tile(const f32x4 (&acc)[2][2][4][2], bf16* O, int ldc, int row0, int col0, int mode, float auxs, const float* auxv  , int nbj) {
    f32x4 av[2][2];
#pragma unroll
    for (int bj = 0; bj < 2; ++bj)
#pragma unroll
        for (int n = 0; n < 2; ++n) av[bj][n] = auxv ? *(const f32x4*)(auxv + bj * HALF + 4 * n) : (f32x4){auxs, auxs, auxs, auxs};
#pragma unroll
    for (int ai = 0; ai < 2; ++ai)
#pragma unroll
        for (int m = 0; m < 4; ++m) { bf16* rowp = O + (size_t)(row0 + ai * HALF + m * 16) * ldc + col0;
#pragma unroll
            for (int bj = 0; bj < 2; ++bj) { if (bj < nbj) { f32x4 v0 = acc[ai][bj][m][0], v1 = acc[ai][bj][m][1];
                if (mode != 0) {
#pragma unroll
                    for (int j = 0; j < 4; ++j) { v0[j] = epi_act(mode, v0[j], av[bj][0][j]); v1[j] = epi_act(mode, v1[j], av[bj][1][j]); } }
                u32x4 w; w.x = cvt_pk_bf16(v0[0], v0[1]); w.y = cvt_pk_bf16(v0[2], v0[3]); w.z = cvt_pk_bf16(v1[0], v1[1]); w.w = cvt_pk_bf16(v1[2], v1[3]);
                *(u32x4*)(rowp + bj * HALF) = w; } } }
}
struct EpiBf16 {
    static constexpr bool PERM = true;
    bf16* O; int ldc;
    __device__ __forceinline__ void operator()(const f32x4 (&acc)[2][2][4][2], const Unit& u, int wr, int wc, int fr, int fq) const {
        store_bf16_tile(acc, O, ldc, u.pm * BM + wr * 64 + fr, u.pn * BM + wc * 32 + 8 * fq, 0, 0.f, nullptr, 2);
    }
};
struct EpiAB {
    static constexpr bool PERM = true;
    bf16* O; const float* lb;
    __device__ __forceinline__ void operator()(const f32x4 (&acc)[2][2][4][2], const Unit& u, int wr, int wc, int fr, int fq) const {
        const int pn = u.pn; int mode = 0; float auxs = 0.f; const float* auxv = nullptr;
        const int cl = wc * 32 + 8 * fq;
        if (pn < 4) mode = 1;
        else if (pn < 8) { mode = 3; auxv = lb + (pn - 4) * BM + cl; }
        else if (pn < 12) mode = 0;
        else if (pn < 16) mode = 1;
        else if (pn < 18) { mode = 2; auxs = 0.08838834764831845f; }
        else if (pn < 24) mode = 0;
        else mode = 1;
        store_bf16_tile(acc, O, N_AB, u.pm * BM + wr * 64 + fr, pn * BM + cl, mode, auxs, auxv, 2);
    }
};
struct EpiCD {
    static constexpr bool PERM = true;
    bf16* O; float* small;
    __device__ __forceinline__ void operator()(const f32x4 (&acc)[2][2][4][2], const Unit& u, int wr, int wc, int fr, int fq) const {
        const int pn = u.pn; const int cl = wc * 32 + 8 * fq; const int row0 = u.pm * BM + wr * 64 + fr;
        if (pn == 21) {
#pragma unroll
            for (int ai = 0; ai < 2; ++ai)
#pragma unroll
                for (int m = 0; m < 4; ++m) { float* rowp = small + (size_t)(row0 + ai * HALF + m * 16) * 128 + cl;
                    *(f32x4*)(rowp) = acc[ai][0][m][0]; *(f32x4*)(rowp + 4) = acc[ai][0][m][1]; }
            return;
        }
        int mode = 0; float auxs = 0.f;
        if (pn >= 5 && pn < 9) { mode = 2; auxs = 0.125f; }
        else if (pn >= 17) mode = 4;
        store_bf16_tile(acc, O, N_CD, row0, pn * BM + cl, mode, auxs, nullptr, 2);
    }
};
struct EpiHead {
    static constexpr bool PERM = true;
    bf16* O; int ldc; int colstride; int nbj; int mode; float auxs;
    __device__ __forceinline__ void operator()(const f32x4 (&acc)[2][2][4][2], const Unit& u, int wr, int wc, int fr, int fq) const {
        store_bf16_tile(acc, O, ldc, u.pm * BM + wr * 64 + fr, u.ex * colstride + wc * 32 + 8 * fq, mode, auxs, nullptr, nbj);
    }
};
struct HeadOrder {
    const char* A; const char* Bt; int lda, ldb; int acol; int G, c;
    __device__ bool next(int i, Unit& u) const { const int L = i * G + c; if (L >= 64 * 8) return false; u.pm = L >> 3; u.ex = L & 7; u.pn = 0; return true; }
    __device__ __forceinline__ const char* a_base(const Unit& u) const { return A + ((size_t)u.pm * BM * lda + (size_t)u.ex * acol) * 2; }
    __device__ __forceinline__ const char* b_base(const Unit& u) const { return Bt + (size_t)u.ex * BM * ldb * 2; }
    __device__ __forceinline__ unsigned a_rowoff(const Unit&, int) const { return 0u; }
};
struct MoeOrder {
    const char* A; const char* Bt; int lda, ldb; int NT; int G, c; int brows;
    const volatile LAS int* tab; const int* list;
    bool gather;
    __device__ bool next(int i, Unit& u) const {
        const int cx = ((G & 7) == 0) ? (c & 7) * (G >> 3) + (c >> 3) : c;
        const int L = i * G + cx; const int total = tab[16] * NT; if (L >= total) return false;
        const int mg = L / NT; u.pn = L - mg * NT; int e = 0;
#pragma unroll
        for (int j = 1; j < 16; ++j) e += (mg >= tab[j]) ? 1 : 0;
        u.ex = e; u.pm = mg; return true;
    }
    __device__ __forceinline__ const char* a_base(const Unit& u) const { return gather ? A : A + (size_t)u.pm * BM * lda * 2; }
    __device__ __forceinline__ const char* b_base(const Unit& u) const { return Bt + ((size_t)u.ex * brows + (size_t)u.pn * BM) * ldb * 2; }
    __device__ __forceinline__ unsigned a_rowoff(const Unit& u, int r) const {
        const int lr = (u.pm - tab[u.ex]) * BM + r; const int ne = tab[32 + u.ex];
        const int tok = (lr < ne) ? (list[u.ex * 16384 + lr] & 0x7fffffff) : 0;
        return (unsigned)tok * (unsigned)(lda * 2);
    }
};
struct EpiMoe1 {
    static constexpr bool PERM = true;
    bf16* hid; const float* wl; const volatile LAS int* tab;
    __device__ __forceinline__ void operator()(const f32x4 (&acc)[2][2][4][2], const Unit& u, int wr, int wc, int fr, int fq) const {
        const int e = u.ex, lr0 = (u.pm - tab[e]) * BM + wr * 64 + fr, ne = tab[32 + e];
        const int col0 = u.pn * 128 + wc * 32 + 8 * fq;
#pragma unroll
        for (int ai = 0; ai < 2; ++ai)
#pragma unroll
            for (int m = 0; m < 4; ++m) { const int lr = lr0 + ai * HALF + m * 16;
                if (lr < ne) { const float w = wl[e * 16384 + lr];
                    f32x4 a0 = acc[ai][0][m][0], a1 = acc[ai][0][m][1], b0 = acc[ai][1][m][0], b1 = acc[ai][1][m][1];
#pragma unroll
                    for (int j = 0; j < 4; ++j) { a0[j] = siluf_(a0[j]) * b0[j] * w; a1[j] = siluf_(a1[j]) * b1[j] * w; }
                    u32x4 o; o.x = cvt_pk_bf16(a0[0], a0[1]); o.y = cvt_pk_bf16(a0[2], a0[3]); o.z = cvt_pk_bf16(a1[0], a1[1]); o.w = cvt_pk_bf16(a1[2], a1[3]);
                    *(u32x4*)(hid + (size_t)(u.pm * BM + wr * 64 + fr + ai * HALF + m * 16) * DEXP + col0) = o; } }
    }
};
struct EpiMoe2 {
    static constexpr bool PERM = true;
    bf16* ys; const int* list; const volatile LAS int* tab;
    __device__ __forceinline__ void operator()(const f32x4 (&acc)[2][2][4][2], const Unit& u, int wr, int wc, int fr, int fq) const {
        const int e = u.ex, lr0 = (u.pm - tab[e]) * BM + wr * 64 + fr, ne = tab[32 + e];
        const int col0 = u.pn * BM + wc * 32 + 8 * fq;
#pragma unroll
        for (int ai = 0; ai < 2; ++ai)
#pragma unroll
            for (int m = 0; m < 4; ++m) { const int lr = lr0 + ai * HALF + m * 16;
                if (lr < ne) { const int ent = list[e * 16384 + lr]; const int tok = ent & 0x7fffffff, slot = (ent >> 31) & 1;
                    bf16* rowp = ys + ((size_t)slot * T + tok) * D + col0;
#pragma unroll
                    for (int bj = 0; bj < 2; ++bj) { const f32x4 v0 = acc[ai][bj][m][0], v1 = acc[ai][bj][m][1];
                        u32x4 o; o.x = cvt_pk_bf16(v0[0], v0[1]); o.y = cvt_pk_bf16(v0[2], v0[3]); o.z = cvt_pk_bf16(v1[0], v1[1]); o.w = cvt_pk_bf16(v1[2], v1[3]);
                        *(u32x4*)(rowp + bj * HALF) = o; } } }
    }
};
}
#define XB_TMO      128
#define XB_XCNT(j)  (256  + 64 * (j))
#define XB_XSUB(j)  (1280 + 64 * (j))
#define XB_XGEN(j)  (2304 + 64 * (j))
#define XB_TOP      3328
#define XB_TOPGEN   3392
#define XCD_BAR_WORDS 3456
#define XB_SPIN_CAP (1u << 22)

__device__ __forceinline__ unsigned xb_ld(unsigned* p)              { return __hip_atomic_load(p, __ATOMIC_RELAXED, __HIP_MEMORY_SCOPE_AGENT); }
__device__ __forceinline__ unsigned xb_add(unsigned* p, unsigned v) { return __hip_atomic_fetch_add(p, v, __ATOMIC_RELAXED, __HIP_MEMORY_SCOPE_AGENT); }
__device__ __forceinline__ unsigned xb_xcc_id() { return (unsigned)__builtin_amdgcn_s_getreg((3 << 11) | 20) & 0xFu; }
#define XB_SPIN(cond, bar) do { unsigned _sp = 0; while (cond) { __builtin_amdgcn_s_sleep(1); \
    if ((++_sp & 255u) == 0u) { if (xb_ld(&(bar)[XB_TMO])) break; if (_sp > XB_SPIN_CAP) { atomicAdd(&(bar)[XB_TMO], 1u); break; } } } } while (0)

struct XcdBarrier { unsigned* bar; unsigned x; volatile LAS unsigned* st; };

__device__ __forceinline__ XcdBarrier xcd_barrier_post(unsigned* bar, volatile LAS unsigned* st) {
    XcdBarrier b; b.bar = bar; b.x = xb_xcc_id(); b.st = st;
    if (threadIdx.x == 0) (void)xb_add(&bar[XB_XCNT(b.x)], 1u);
    return b;
}
__device__ __forceinline__ void xcd_barrier_complete(unsigned* bar, unsigned x, unsigned& nloc, unsigned& nx) {
    const unsigned G = gridDim.x * gridDim.y * gridDim.z;
    unsigned sum, cnt, mine, sp = 0u;
    for (;;) {
        sum = 0u; cnt = 0u; mine = 0u;
#pragma unroll
        for (unsigned j = 0; j < 16; ++j) { const unsigned c = xb_ld(&bar[XB_XCNT(j)]); sum += c; cnt += (c > 0u) ? 1u : 0u; mine = (j == x) ? c : mine; }
        if (sum == G) break;
        __builtin_amdgcn_s_sleep(1);
        if ((++sp & 255u) == 0u) { if (xb_ld(&bar[XB_TMO])) break; if (sp > XB_SPIN_CAP) { atomicAdd(&bar[XB_TMO], 1u); break; } }
    }
    nloc = mine > 0u ? mine : 1u; nx = cnt > 0u ? cnt : 1u;
}
__device__ __forceinline__ void xcd_barrier(const XcdBarrier& b) {
    asm volatile("s_waitcnt vmcnt(0)" ::: "memory");
    __syncthreads();
    if (threadIdx.x == 0) {
        unsigned* bar = b.bar;
        __builtin_amdgcn_s_waitcnt(0);
        unsigned nloc = b.st[0], nx = b.st[1];
        if (nloc == 0u) { xcd_barrier_complete(bar, b.x, nloc, nx); b.st[0] = nloc; b.st[1] = nx; }
        const unsigned old = xb_add(&bar[XB_XSUB(b.x)], 1u);
        const unsigned gen = old / nloc;
        if (old + 1u == (gen + 1u) * nloc) {
            __builtin_amdgcn_fence(__ATOMIC_RELEASE, "agent");
            asm volatile("s_waitcnt vmcnt(0)" ::: "memory");
            const unsigned og = xb_add(&bar[XB_TOP], 1u);
            const unsigned tg = og / nx;
            if (og + 1u == (tg + 1u) * nx) xb_add(&bar[XB_TOPGEN], 1u);
            else XB_SPIN(xb_ld(&bar[XB_TOPGEN]) == tg, bar);
            __builtin_amdgcn_fence(__ATOMIC_ACQUIRE, "agent");
            xb_add(&bar[XB_XGEN(b.x)], 1u);
            asm volatile("s_waitcnt vmcnt(0)" ::: "memory");
        } else {
            XB_SPIN(xb_ld(&bar[XB_XGEN(b.x)]) == gen, bar);
            __builtin_amdgcn_fence(__ATOMIC_ACQUIRE, "agent");
            asm volatile("s_waitcnt vmcnt(0)" ::: "memory");
        }
    }
    __syncthreads();
}

struct Args {
    const float* in[24]; float* out; unsigned char* ws; int ph_lo, ph_hi, use_bar, pad;
};
enum InIdx { I_X = 0, I_WINAB, I_WOUTAB, I_LBLOG, I_ANORM, I_WA2, I_BA2, I_BNORM, I_WINCD, I_WOUTCD, I_CKVG, I_WUK, I_WUV, I_CONVW, I_GATEB, I_DNORM, I_REL, I_WR, I_BR, I_W1, I_W3, I_W2, I_LNG, I_LNB };

struct Frame {
    LAS unsigned char* lds;
    gu32* ctl;
    int tid, lane, wave, G, bid;
    const float* const* in; float* out; unsigned char* ws;
};
#ifndef PROBE_REPCONV
#define PROBE_REPCONV 0
#endif
template <class SrcFn>
__device__ __forceinline__ void transpose_item(const SrcFn& src, int Kdst, bf16* WT, LAS float* scr, int kb, int nb, int lane) {
    const int k0 = 64 * kb, n0 = 32 * nb;
    float v[32];
#pragma unroll
    for (int i = 0; i < 32; ++i) v[i] = src(k0 + 2 * i + (lane >> 5), n0 + (lane & 31));
#pragma unroll
    for (int i = 0; i < 32; ++i) scr[(2 * i + (lane >> 5)) * 33 + (lane & 31)] = v[i];
    LDS_WAIT(); asm volatile("" ::: "memory");
    const int c = lane & 7;
#pragma unroll
    for (int j = 0; j < 4; ++j) { const int n = (lane >> 3) + 8 * j; const LAS float* s = scr + (8 * c) * 33 + n;
        u32x4 o; o.x = pk2(s[0 * 33], s[1 * 33]); o.y = pk2(s[2 * 33], s[3 * 33]); o.z = pk2(s[4 * 33], s[5 * 33]); o.w = pk2(s[6 * 33], s[7 * 33]);
        *(GAS u32x4*)(WT + (size_t)(n0 + n) * Kdst + k0 + 8 * c) = o; }
    LDS_WAIT(); asm volatile("" ::: "memory");
}
constexpr int TT_LD = 264;
template <class AddrFn>
__device__ __forceinline__ void wgt_load(const AddrFn& addr, int k0, int wave, int lane, f32x4 (&v)[8]) {
#pragma unroll
    for (int i = 0; i < 8; ++i) v[i] = *(const GAS f32x4*)addr(k0 + 8 * wave + i, 4 * lane);
}
__device__ __forceinline__ void wgt_emit(LAS bf16* tile, const f32x4 (&v)[8], bf16* WT, int Kdst, int k0, int n0, int wave, int lane) {
#pragma unroll
    for (int i = 0; i < 8; ++i) { u32x2 o; o.x = pk2(v[i].x, v[i].y); o.y = pk2(v[i].z, v[i].w); *(LAS u32x2*)(tile + (8 * wave + i) * TT_LD + 4 * lane) = o; }
    asm volatile("s_waitcnt lgkmcnt(0)" ::: "memory"); __builtin_amdgcn_s_barrier(); asm volatile("" ::: "memory");
    const int r16 = lane & 15, g4 = lane >> 4;
#pragma unroll
    for (int j = 0; j < 4; ++j) { const int it = wave * 4 + j, cg = it >> 1, hh = it & 1;
        const LAS bf16* p = tile + (32 * hh + 8 * g4 + (r16 >> 2)) * TT_LD + 16 * cg + 4 * (r16 & 3);
        const s16x4 lo = __builtin_bit_cast(s16x4, __builtin_amdgcn_ds_read_tr16_b64_v4i16((LAS s16x4*)p));
        const s16x4 hi = __builtin_bit_cast(s16x4, __builtin_amdgcn_ds_read_tr16_b64_v4i16((LAS s16x4*)(p + 4 * TT_LD)));
        const bf16x8 o = __builtin_shufflevector(lo, hi, 0, 1, 2, 3, 4, 5, 6, 7);
        *(GAS bf16x8*)(WT + (size_t)(n0 + 16 * cg + r16) * Kdst + k0 + 32 * hh + 8 * g4) = o; }
}
struct TItem { const float* p0; const float* p1; int pitch; bf16* WT; int Kdst, k0, n0; };
struct TAddr { const float* p0; const float* p1; int pitch;
    __device__ __forceinline__ const float* operator()(int k, int n4) const { return (n4 < 128 ? p0 : p1) + (size_t)k * pitch + (n4 & 127); } };
template <class Decode>
__device__ __forceinline__ void wgt_run(const Decode& decode, int nit, Frame& F) {
    LAS bf16* tile0 = (LAS bf16*)F.lds; LAS bf16* tile1 = (LAS bf16*)(F.lds + 64 * TT_LD * 2);
    f32x4 v[8], v2[8];
    int it = F.bid; int par = 0;
    TItem cur; if (it < nit) { cur = decode(it); wgt_load(TAddr{cur.p0, cur.p1, cur.pitch}, cur.k0, F.wave, F.lane, v); }
    while (it < nit) {
        const int nx = it + F.G; TItem nxt = cur;
        if (nx < nit) { nxt = decode(nx); wgt_load(TAddr{nxt.p0, nxt.p1, nxt.pitch}, nxt.k0, F.wave, F.lane, v2); }
        wgt_emit(par ? tile1 : tile0, v, cur.WT, cur.Kdst, cur.k0, cur.n0, F.wave, F.lane);
#pragma unroll
        for (int i = 0; i < 8; ++i) v[i] = v2[i];
        cur = nxt; it = nx; par ^= 1;
    }
}
__device__ __forceinline__ int cd_src_col(int n) {
    if (n < 2304) return n;
    if (n < 2816) return 2384 + (n - 2304);
    if (n < 3328) return 2896 + (n - 2816);
    if (n < 4352) return 3408 + (n - 3328);
    if (n < 5376) return 4440 + (n - 4352);
    if (n < 5440) return 2304 + (n - 5376);
    if (n < 5456) return 2368 + (n - 5440);
    if (n < 5460) return 4432 + (n - 5456);
    if (n < 5464) return 4436 + (n - 5460);
    return -1;
}
__device__ __forceinline__ void load_w16_T(LAS float* WT, const float* W, int ld, int col0, int tid) {
#pragma unroll 4
    for (int i = tid; i < 2048 * 4; i += 512) { const int k = i >> 2, e4 = (i & 3) * 4; const f32x4 w = *(const f32x4*)(W + (size_t)k * ld + col0 + e4);
        WT[(e4 + 0) * 2048 + k] = w.x; WT[(e4 + 1) * 2048 + k] = w.y; WT[(e4 + 2) * 2048 + k] = w.z; WT[(e4 + 3) * 2048 + k] = w.w; }
}
template <bool WBF16>
__device__ __forceinline__ void row_dot16(const f32x4 (&v)[8], const LAS void* WTv, int lane, float (&out)[16]) {
    float s[16];
#pragma unroll
    for (int e = 0; e < 16; ++e) { float a = 0.f;
        if (WBF16) { const LAS bf16* WT = (const LAS bf16*)WTv;
#pragma unroll
            for (int j = 0; j < 8; ++j) { const u32x2 w = *(const LAS u32x2*)(WT + e * 2048 + 256 * j + 4 * lane); a += (v[j].x * bflo(w.x) + v[j].y * bfhi(w.x)) + (v[j].z * bflo(w.y) + v[j].w * bfhi(w.y)); } }
        else { const LAS float* WT = (const LAS float*)WTv;
#pragma unroll
            for (int j = 0; j < 8; ++j) { const f32x4 w = *(const LAS f32x4*)(WT + e * 2048 + 256 * j + 4 * lane); a += (v[j].x * w.x + v[j].y * w.y) + (v[j].z * w.z + v[j].w * w.w); } }
        s[e] = a; __builtin_amdgcn_sched_barrier(0); }
#define RD_STEP(N, XOR) { const bool hi_ = (lane & (XOR)) != 0; _Pragma("unroll") for (int j = 0; j < (N); ++j) { const float send = hi_ ? s[j] : s[(N) + j]; const float keep = hi_ ? s[(N) + j] : s[j]; s[j] = keep + __shfl_xor(send, (XOR)); } }
    RD_STEP(8, 32) RD_STEP(4, 16) RD_STEP(2, 8) RD_STEP(1, 4)
#undef RD_STEP
    float r = s[0]; r += __shfl_xor(r, 2); r += __shfl_xor(r, 1);
#pragma unroll
    for (int e = 0; e < 16; ++e) out[e] = __builtin_bit_cast(float, __builtin_amdgcn_readlane(__builtin_bit_cast(int, r), (((e >> 3) & 1) << 5) | (((e >> 2) & 1) << 4) | (((e >> 1) & 1) << 3) | ((e & 1) << 2)));
}
template <bool WBF16>
__device__ __forceinline__ void row_dot16x2(const f32x4 (&v0)[8], const f32x4 (&v1)[8], const LAS void* WTv, int lane, float (&out0)[16], float (&out1)[16]) {
    float s[16], q[16];
#pragma unroll
    for (int e = 0; e < 16; ++e) { float a = 0.f, b = 0.f;
        if (WBF16) { const LAS bf16* WT = (const LAS bf16*)WTv;
#pragma unroll
            for (int j = 0; j < 8; ++j) { const u32x2 w = *(const LAS u32x2*)(WT + e * 2048 + 256 * j + 4 * lane); const float w0 = bflo(w.x), w1 = bfhi(w.x), w2 = bflo(w.y), w3 = bfhi(w.y);
                a += (v0[j].x * w0 + v0[j].y * w1) + (v0[j].z * w2 + v0[j].w * w3); b += (v1[j].x * w0 + v1[j].y * w1) + (v1[j].z * w2 + v1[j].w * w3); } }
        else { const LAS float* WT = (const LAS float*)WTv;
#pragma unroll
            for (int j = 0; j < 8; ++j) { const f32x4 w = *(const LAS f32x4*)(WT + e * 2048 + 256 * j + 4 * lane);
                a += (v0[j].x * w.x + v0[j].y * w.y) + (v0[j].z * w.z + v0[j].w * w.w); b += (v1[j].x * w.x + v1[j].y * w.y) + (v1[j].z * w.z + v1[j].w * w.w); } }
        s[e] = a; q[e] = b; __builtin_amdgcn_sched_barrier(0); }
#define RD_STEP2(N, XOR) { const bool hi_ = (lane & (XOR)) != 0; _Pragma("unroll") for (int j = 0; j < (N); ++j) { \
        { const float send = hi_ ? s[j] : s[(N) + j]; const float keep = hi_ ? s[(N) + j] : s[j]; s[j] = keep + __shfl_xor(send, (XOR)); } \
        { const float send = hi_ ? q[j] : q[(N) + j]; const float keep = hi_ ? q[(N) + j] : q[j]; q[j] = keep + __shfl_xor(send, (XOR)); } } }
    RD_STEP2(8, 32) RD_STEP2(4, 16) RD_STEP2(2, 8) RD_STEP2(1, 4)
#undef RD_STEP2
    float r = s[0]; r += __shfl_xor(r, 2); r += __shfl_xor(r, 1);
    float r2 = q[0]; r2 += __shfl_xor(r2, 2); r2 += __shfl_xor(r2, 1);
#pragma unroll
    for (int e = 0; e < 16; ++e) { const int sl = (((e >> 3) & 1) << 5) | (((e >> 2) & 1) << 4) | (((e >> 1) & 1) << 3) | ((e & 1) << 2);
        out0[e] = __builtin_bit_cast(float, __builtin_amdgcn_readlane(__builtin_bit_cast(int, r), sl)); out1[e] = __builtin_bit_cast(float, __builtin_amdgcn_readlane(__builtin_bit_cast(int, r2), sl)); }
}
__device__ __forceinline__ void store_row_bf16(bf16* orow, const f32x4 (&v)[8], int lane) {
    GAS unsigned long long* o8 = (GAS unsigned long long*)orow + lane;
#pragma unroll
    for (int j = 0; j < 8; ++j) o8[64 * j] = (unsigned long long)pk2(v[j].x, v[j].y) | ((unsigned long long)pk2(v[j].z, v[j].w) << 32);
}
__device__ __forceinline__ float log_sigmoid_(float z) { return -(fmaxf(-z, 0.f) + __logf(1.0f + __expf(-fabsf(z)))); }

__device__ __forceinline__ void p0_prologue(const Args& args, Frame& F) {
    LAS float* scr = (LAS float*)(F.lds + F.wave * 16384);
    const int gw = F.bid * 8 + F.wave, NGW = F.G * 8;
    unsigned char* ws = args.ws;
    { const int gt = F.bid * 512 + F.tid; if (gt < 1024) { const float a = args.in[I_LBLOG][gt], b = args.in[I_LBLOG][1024 + gt]; const float m = fmaxf(a, b); const float ea = __expf(a - m), eb = __expf(b - m); ((float*)(ws + WS_LB))[gt] = ea / (ea + eb); } }
    {
        const float* wab = args.in[I_WINAB]; const float* woab = args.in[I_WOUTAB]; const float* wcd = args.in[I_WINCD]; const float* wocd = args.in[I_WOUTCD];
        constexpr int J0 = 32 * 28, J1 = 32 * 8, J2 = 32 * 21, J3 = 32 * 8;
        for (int rep_ = 0; rep_ < ((PROBE_REPCONV & 2) ? 2 : 1); ++rep_)
        wgt_run([&](int it) { TItem t; int r = it;
            if (r < J0) { const int kb = r / 28, nb = r % 28; t.p0 = wab + 256 * nb; t.p1 = t.p0 + 128; t.pitch = PSRC_AB; t.WT = (bf16*)(ws + WS_WINAB); t.Kdst = 2048; t.k0 = 64 * kb; t.n0 = 256 * nb; return t; } r -= J0;
            if (r < J1) { const int kb = r / 8, nb = r % 8; t.p0 = woab + 256 * nb; t.p1 = t.p0 + 128; t.pitch = 2048; t.WT = (bf16*)(ws + WS_WOUTAB); t.Kdst = 2048; t.k0 = 64 * kb; t.n0 = 256 * nb; return t; } r -= J1;
            if (r < J2) { const int kb = r / 21, nb = r % 21; t.p0 = wcd + cd_src_col(256 * nb); t.p1 = t.p0 + 128; t.pitch = PSRC_CD; t.WT = (bf16*)(ws + WS_WINCD); t.Kdst = 2048; t.k0 = 64 * kb; t.n0 = 256 * nb; return t; } r -= J2;
            { const int kb = r / 8, nb = r % 8; t.p0 = wocd + 256 * nb; t.p1 = t.p0 + 128; t.pitch = 2048; t.WT = (bf16*)(ws + WS_WOUTCD); t.Kdst = 2048; t.k0 = 64 * kb; t.n0 = 256 * nb; return t; }
        }, J0 + J1 + J2 + J3, F);
        __syncthreads();
    }
    constexpr int I2 = 32 * 8, I4 = 4 * 64, I5 = 4 * 64;
    constexpr int NIT = I2 + I4 + I5;
    for (int it = gw; it < NIT; it += NGW) {
        int r = it;
        if (r < I2) { const float* W = args.in[I_WINCD]; transpose_item([&](int k, int n) { const int sc = cd_src_col(n); return sc >= 0 ? W[(size_t)k * PSRC_CD + sc] : 0.f; }, 2048, (bf16*)(ws + WS_WINCD), scr, r / 8, 168 + r % 8, F.lane); continue; } r -= I2;
        if (r < I4) { const float* W = args.in[I_WUK];
            transpose_item([&](int k, int n) { const int h = n >> 8, c = n & 255; return k < 128 ? W[(size_t)c * 1024 + h * 128 + k] * 0.08838834764831845f : 0.f; }, 256, (bf16*)(ws + WS_WUK), scr, r / 64, r % 64, F.lane); continue; } r -= I4;
        { const float* W = args.in[I_WUV];
            transpose_item([&](int k, int n) { const int h = n >> 8, d = n & 255; return d < 128 ? W[(size_t)k * 1024 + h * 128 + d] : 0.f; }, 256, (bf16*)(ws + WS_WUV), scr, r / 64, r % 64, F.lane); }
    }
    __syncthreads();
    LAS bf16* WT = (LAS bf16*)F.lds;
    LAS float* wa2 = (LAS float*)(F.lds + 65536);
#pragma unroll 4
    for (int i = F.tid; i < 2048 * 4; i += 512) { const int k = i >> 2, e4 = (i & 3) * 4; const f32x4 w = *(const f32x4*)(args.in[I_WINAB] + (size_t)k * PSRC_AB + 7168 + e4);
        WT[(e4 + 0) * 2048 + k] = (bf16)f2bf(w.x); WT[(e4 + 1) * 2048 + k] = (bf16)f2bf(w.y); WT[(e4 + 2) * 2048 + k] = (bf16)f2bf(w.z); WT[(e4 + 3) * 2048 + k] = (bf16)f2bf(w.w); }
    for (int i = F.tid; i < 16 * 128; i += 512) *(LAS f32x4*)(wa2 + 4 * i) = *(const f32x4*)(args.in[I_WA2] + 4 * i);
    __syncthreads();
    const float* ba2 = args.in[I_BA2];
    for (int rep_ = 0; rep_ < ((PROBE_REPCONV & 4) ? 2 : 1); ++rep_)
    for (int m = gw; m < T; m += NGW) {
        const GAS f32x4* xr = (const GAS f32x4*)(args.in[I_X] + (size_t)m * D) + F.lane;
        f32x4 v[8];
#pragma unroll
        for (int j = 0; j < 8; ++j) v[j] = xr[64 * j];
        store_row_bf16((bf16*)(ws + WS_XB) + (size_t)m * D, v, F.lane);
        float ba[16]; row_dot16<true>(v, WT, F.lane, ba);
        f32x4 z0 = *(const f32x4*)(ba2 + 8 * F.lane), z1 = *(const f32x4*)(ba2 + 8 * F.lane + 4);
#pragma unroll
        for (int r = 0; r < 16; ++r) { const f32x4 w0 = *(const LAS f32x4*)(wa2 + r * 512 + 8 * F.lane), w1 = *(const LAS f32x4*)(wa2 + r * 512 + 8 * F.lane + 4); z0 += w0 * ba[r]; z1 += w1 * ba[r]; }
        u32x4 o; o.x = pk2(log_sigmoid_(z0.x) * 0.0625f, log_sigmoid_(z0.y) * 0.0625f); o.y = pk2(log_sigmoid_(z0.z) * 0.0625f, log_sigmoid_(z0.w) * 0.0625f);
        o.z = pk2(log_sigmoid_(z1.x) * 0.0625f, log_sigmoid_(z1.y) * 0.0625f); o.w = pk2(log_sigmoid_(z1.z) * 0.0625f, log_sigmoid_(z1.w) * 0.0625f);
        *(GAS u32x4*)((bf16*)(ws + WS_LAB) + (size_t)m * 512 + 8 * F.lane) = o;
    }
}

template <int MODE, bool XF32, bool OUTF32>
__device__ __forceinline__ void ln_phase(const Args& args, Frame& F, int layer, const float* xin) {
    unsigned char* ws = args.ws;
    const int gw = F.bid * 8 + F.wave, NGW = F.G * 8;
    if (MODE == 0) {
        LAS float* scr = (LAS float*)(F.lds + F.wave * 16384);
        const float* w1 = args.in[I_W1] + (size_t)layer * NE * 2048 * 512; const float* w3 = args.in[I_W3] + (size_t)layer * NE * 2048 * 512; const float* w2 = args.in[I_W2] + (size_t)layer * NE * 512 * 2048;
        constexpr int IA = 16 * 32 * 4, IB = 16 * 8 * 8;
        for (int rep_ = 0; rep_ < ((PROBE_REPCONV & 1) ? 2 : 1); ++rep_)
        wgt_run([&](int it) { TItem t;
            if (it < IA) { const int e = it >> 7, r = it & 127, kb = r >> 2, pn = r & 3;
                t.p0 = w1 + (size_t)e * 2048 * 512 + 128 * pn; t.p1 = w3 + (size_t)e * 2048 * 512 + 128 * pn; t.pitch = 512; t.WT = (bf16*)(ws + WS_W13) + (size_t)e * 1024 * 2048; t.Kdst = 2048; t.k0 = 64 * kb; t.n0 = 256 * pn; return t; }
            const int r0 = it - IA; const int e = r0 >> 6, r = r0 & 63, kb = r >> 3, nb = r & 7;
            t.p0 = w2 + (size_t)e * 512 * 2048 + 256 * nb; t.p1 = t.p0 + 128; t.pitch = 2048; t.WT = (bf16*)(ws + WS_W2T) + (size_t)e * 2048 * 512; t.Kdst = 512; t.k0 = 64 * kb; t.n0 = 256 * nb; return t;
        }, IA + IB, F);
        (void)scr;
        __syncthreads();
        load_w16_T((LAS float*)F.lds, args.in[I_WR], 16, 0, F.tid);
        __syncthreads();
    }
    const float* g = args.in[I_LNG] + (layer * 2 + MODE) * D; const float* bb = args.in[I_LNB] + (layer * 2 + MODE) * D;
    const bf16* tmp = (const bf16*)(ws + WS_TMP);
    const bf16* xbin = (const bf16*)(ws + WS_XB);
    const bf16* ys = (const bf16*)(ws + WS_R2);
    auto ln_row = [&](const int m, f32x4 (&v)[8], const bool wr) {
        float s = 0.f;
        if (XF32) { const GAS f32x4* xr = (const GAS f32x4*)(xin + (size_t)m * D) + F.lane;
#pragma unroll
            for (int j = 0; j < 8; ++j) v[j] = xr[64 * j] * DN_ALPHA; }
        else { const GAS u32x2* xr = (const GAS u32x2*)(xbin + (size_t)m * D) + F.lane;
#pragma unroll
            for (int j = 0; j < 8; ++j) { const u32x2 a = xr[64 * j]; v[j] = (f32x4){bflo(a.x), bfhi(a.x), bflo(a.y), bfhi(a.y)} * DN_ALPHA; } }
        if (MODE == 0) { const GAS u32x2* tr = (const GAS u32x2*)(tmp + (size_t)m * D) + F.lane;
#pragma unroll
            for (int j = 0; j < 8; ++j) { const u32x2 a = tr[64 * j]; v[j] += (f32x4){bflo(a.x), bfhi(a.x), bflo(a.y), bfhi(a.y)}; } }
        else { const GAS u32x2* y0 = (const GAS u32x2*)(ys + (size_t)m * D) + F.lane; const GAS u32x2* y1 = (const GAS u32x2*)(ys + ((size_t)T + m) * D) + F.lane;
#pragma unroll
            for (int j = 0; j < 8; ++j) { const u32x2 a = y0[64 * j], b = y1[64 * j]; f32x4 y; y.x = bflo(a.x) + bflo(b.x); y.y = bfhi(a.x) + bfhi(b.x); y.z = bflo(a.y) + bflo(b.y); y.w = bfhi(a.y) + bfhi(b.y);
                v[j] += y; } }
#pragma unroll
        for (int j = 0; j < 8; ++j) s += (v[j].x + v[j].y) + (v[j].z + v[j].w);
        const float mean = wave_sum(s) * (1.f / D); float s2 = 0.f;
#pragma unroll
        for (int j = 0; j < 8; ++j) { v[j] = v[j] - mean; s2 += (v[j].x * v[j].x + v[j].y * v[j].y) + (v[j].z * v[j].z + v[j].w * v[j].w); }
        const float rstd = 1.f / sqrtf(wave_sum(s2) * (1.f / D) + EPS);
#pragma unroll
        for (int j = 0; j < 8; ++j) { const f32x4 gg = *(const f32x4*)(g + 256 * j + 4 * F.lane), bv = *(const f32x4*)(bb + 256 * j + 4 * F.lane); v[j] = v[j] * rstd * gg + bv; }
        if (OUTF32 && wr) { GAS f32x4* orow = (GAS f32x4*)(args.out + (size_t)m * D) + F.lane;
#pragma unroll
            for (int j = 0; j < 8; ++j) orow[64 * j] = v[j]; }
        if (!OUTF32 && wr) store_row_bf16((bf16*)(ws + WS_XB) + (size_t)m * D, v, F.lane);
    };
    auto route = [&](const int m, const float (&lg)[16], const bool wr) {
            const float* br = args.in[I_BR];
            float aff[16], sel[16];
#pragma unroll
            for (int e = 0; e < 16; ++e) { aff[e] = sigmoidf_(lg[e]); sel[e] = aff[e] + br[e]; }
            float best = -3.0e38f; int bi1 = 0, bi2 = 1; float ba1 = 0.f, ba2_ = 0.f;
#pragma unroll
            for (int gq = 0; gq < 4; ++gq) {
                int i1 = 0; float s1 = sel[4 * gq];
#pragma unroll
                for (int j = 1; j < 4; ++j) if (sel[4 * gq + j] > s1) { s1 = sel[4 * gq + j]; i1 = j; }
                int i2 = -1; float s2v = -3.0e38f;
#pragma unroll
                for (int j = 0; j < 4; ++j) if (j != i1 && sel[4 * gq + j] > s2v) { s2v = sel[4 * gq + j]; i2 = j; }
                const float sc = s1 + s2v;
                float a1 = 0.f, a2 = 0.f;
#pragma unroll
                for (int j = 0; j < 4; ++j) { a1 = (j == i1) ? aff[4 * gq + j] : a1; a2 = (j == i2) ? aff[4 * gq + j] : a2; }
                if (sc > best) { best = sc; bi1 = 4 * gq + i1; bi2 = 4 * gq + i2; ba1 = a1; ba2_ = a2; }
            }
            if (F.lane == 0 && wr) {
                const float inv = 1.0f / (ba1 + ba2_);
                unsigned* cnt = (unsigned*)(F.ctl + CW_CNT) + layer * 16 * 64;
                const unsigned p1 = __hip_atomic_fetch_add(cnt + bi1 * 64, 1u, RLX_AGENT), p2 = __hip_atomic_fetch_add(cnt + bi2 * 64, 1u, RLX_AGENT);
                int* list = (int*)(ws + WS_LIST); float* wl = (float*)(ws + WS_WL);
                list[bi1 * 16384 + p1] = m; wl[bi1 * 16384 + p1] = ba1 * inv;
                list[bi2 * 16384 + p2] = m | (int)0x80000000; wl[bi2 * 16384 + p2] = ba2_ * inv;
            }
    };
    if (MODE == 0) {
        for (int m0 = gw; m0 < T; m0 += 2 * NGW) {
            const bool has1 = m0 + NGW < T; const int m1 = has1 ? m0 + NGW : m0;
            f32x4 v0[8], v1[8];
            ln_row(m0, v0, true); ln_row(m1, v1, has1);
            float lg0[16], lg1[16]; row_dot16x2<false>(v0, v1, (const LAS float*)F.lds, F.lane, lg0, lg1);
            route(m0, lg0, true); route(m1, lg1, has1);
        }
    } else {
        for (int m = gw; m < T; m += NGW) { f32x4 v[8]; ln_row(m, v, true); }
    }
}
__device__ __forceinline__ f32x4 mfma16(bf16x8 a, bf16x8 b, f32x4 c) { return __builtin_amdgcn_mfma_f32_16x16x32_bf16(a, b, c, 0, 0, 0); }
__device__ __forceinline__ bf16x8 lds_frag(const LAS bf16* M, int ld, int r0, int k0, int lane) { return *(const LAS bf16x8*)(M + (r0 + (lane & 15)) * ld + k0 + 8 * (lane >> 4)); }

constexpr int H0_AQ = 0, H0_AF = 1024, H0_AI = 2048, H0_AG = 3072, H0_BQ = 4096, H0_BK = 4608, H0_BV = 5120, H0_BG = 6144;
constexpr int LDK = 72, LDQ = 136;

template <int DV>
__device__ __forceinline__ void stage_vt(LAS bf16* VT, const bf16* V, int ldv, int tid) {
    constexpr int NS = 64 * DV / 512;
    const int e = tid % DV, sq = tid / DV;
    unsigned w[NS / 2];
#pragma unroll
    for (int i = 0; i < NS / 2; ++i) { const unsigned a = V[(size_t)(sq * NS + 2 * i) * ldv + e], b = V[(size_t)(sq * NS + 2 * i + 1) * ldv + e]; w[i] = a | (b << 16); }
#pragma unroll
    for (int i = 0; i < NS / 8; ++i) { u32x4 o; o.x = w[4 * i]; o.y = w[4 * i + 1]; o.z = w[4 * i + 2]; o.w = w[4 * i + 3]; *(LAS u32x4*)(VT + e * LDK + sq * NS + 8 * i) = o; }
}

template <int DV, bool IS_A>
__device__ __forceinline__ void ab_a_unit(const Args& args, Frame& F, int b, int n, int h) {
    unsigned char* ws = args.ws;
    const bf16* h0 = (const bf16*)(ws + WS_R1);
    const bf16* lab = (const bf16*)(ws + WS_LAB);
    const int t0 = b * SEQ + n * 64, tid = F.tid, lane = F.lane, w = F.wave;
    LAS bf16* KT = (LAS bf16*)F.lds;
    LAS bf16* VT = (LAS bf16*)(F.lds + 18432);
    LAS float* part = (LAS float*)(F.lds + 18432 + 36864);
    const int d = tid & 127, tq = tid >> 7;
    float lfv[16], kv[16]; float loc = 0.f;
#pragma unroll
    for (int i = 0; i < 16; ++i) { const size_t row = (size_t)(t0 + 16 * tq + i);
        if (IS_A) { lfv[i] = bf2f(h0[row * N_AB + H0_AF + h * 128 + d]); kv[i] = -expm1f(lfv[i]); }
        else { lfv[i] = bf2f(lab[row * 512 + h * 128 + d]); kv[i] = bf2f(h0[row * N_AB + H0_BK + h * 128 + d]); }
        loc += lfv[i]; }
    part[tq * 128 + d] = loc;
    stage_vt<DV>(VT, h0 + (size_t)t0 * N_AB + (IS_A ? H0_AI + h * 128 : H0_BV + h * 256), N_AB, tid);
    __syncthreads();
    float pre = 0.f, tot = 0.f;
#pragma unroll
    for (int j = 0; j < 4; ++j) { const float p = part[j * 128 + d]; tot += p; pre += (j < tq) ? p : 0.f; }
    { float bc = pre; unsigned wv[8];
#pragma unroll
        for (int i = 0; i < 16; i += 2) { bc += lfv[i]; const float k0 = kv[i] * __expf(tot - bc); bc += lfv[i + 1]; const float k1 = kv[i + 1] * __expf(tot - bc); wv[i >> 1] = pk2(k0, k1); }
        u32x4 o0, o1; o0.x = wv[0]; o0.y = wv[1]; o0.z = wv[2]; o0.w = wv[3]; o1.x = wv[4]; o1.y = wv[5]; o1.z = wv[6]; o1.w = wv[7];
        *(LAS u32x4*)(KT + d * LDK + 16 * tq) = o0; *(LAS u32x4*)(KT + d * LDK + 16 * tq + 8) = o1; }
    if (tq == 0) { float* G = (float*)(ws + (IS_A ? WS_GA : WS_GB)); G[(size_t)((b * NCH + n) * (IS_A ? 8 : 4) + h) * 128 + d] = __expf(tot); }
    __syncthreads();
    bf16* U = (bf16*)(ws + WS_R2) + (IS_A ? (size_t)((b * NCH + n) * 8 + h) * 128 * 128 : (size_t)64 * MiB / 2 + (size_t)((b * NCH + n) * 4 + h) * 256 * 128);
    const bf16x8 a0 = lds_frag(KT, LDK, 16 * w, 0, lane), a1 = lds_frag(KT, LDK, 16 * w, 32, lane);
#pragma unroll 4
    for (int et = 0; et < DV / 16; ++et) {
        f32x4 acc = {0.f, 0.f, 0.f, 0.f};
        acc = mfma16(a0, lds_frag(VT, LDK, 16 * et, 0, lane), acc);
        acc = mfma16(a1, lds_frag(VT, LDK, 16 * et, 32, lane), acc);
        u32x2 o; o.x = pk2(acc[0], acc[1]); o.y = pk2(acc[2], acc[3]);
        *(GAS u32x2*)(U + (size_t)(16 * et + (lane & 15)) * 128 + 16 * w + 4 * (lane >> 4)) = o;
    }
    __syncthreads();
}

__device__ __forceinline__ void ab_scan(const Args& args, Frame& F) {
    unsigned char* ws = args.ws;
    const int NT_A = BATCH * 8 * 128 * 16, NT_B = BATCH * 4 * 256 * 16;
    for (int gt = F.bid * 512 + F.tid; gt < NT_A + NT_B; gt += F.G * 512) {
        const bool isA = gt < NT_A; const int r = isA ? gt : gt - NT_A;
        const int d8 = r & 15; int e, h, b, H, DV;
        if (isA) { e = (r >> 4) & 127; h = (r >> 11) & 7; b = r >> 14; H = 8; DV = 128; } else { e = (r >> 4) & 255; h = (r >> 12) & 3; b = r >> 14; H = 4; DV = 256; }
        bf16* S = (bf16*)(ws + WS_R2) + (isA ? (size_t)0 : (size_t)64 * MiB / 2);
        const float* G = (const float*)(ws + (isA ? WS_GA : WS_GB));
        float st[8];
#pragma unroll
        for (int j = 0; j < 8; ++j) st[j] = 0.f;
#pragma unroll 4
        for (int n = 0; n < NCH; ++n) {
            GAS u32x4* p = (GAS u32x4*)(S + ((size_t)((b * NCH + n) * H + h) * DV + e) * 128 + 8 * d8);
            const float* gp = G + (size_t)((b * NCH + n) * H + h) * 128 + 8 * d8;
            const u32x4 u = *p; const f32x4 g0 = *(const f32x4*)gp, g1 = *(const f32x4*)(gp + 4);
            u32x4 o; o.x = pk2(st[0], st[1]); o.y = pk2(st[2], st[3]); o.z = pk2(st[4], st[5]); o.w = pk2(st[6], st[7]);
            *p = o;
            st[0] = g0.x * st[0] + bflo(u.x); st[1] = g0.y * st[1] + bfhi(u.x); st[2] = g0.z * st[2] + bflo(u.y); st[3] = g0.w * st[3] + bfhi(u.y);
            st[4] = g1.x * st[4] + bflo(u.z); st[5] = g1.y * st[5] + bfhi(u.z); st[6] = g1.z * st[6] + bflo(u.w); st[7] = g1.w * st[7] + bfhi(u.w);
        }
    }
}

template <int DV, bool IS_A>
__device__ __forceinline__ void ab_c_unit(const Args& args, Frame& F, int b, int n, int h) {
    unsigned char* ws = args.ws;
    const bf16* h0 = (const bf16*)(ws + WS_R1);
    const bf16* lab = (const bf16*)(ws + WS_LAB);
    const int t0 = b * SEQ + n * 64, tid = F.tid, lane = F.lane, w = F.wave, r16 = lane & 15, g4 = lane >> 4;
    LAS bf16* Qs = (LAS bf16*)F.lds;
    LAS bf16* Ks = (LAS bf16*)(F.lds + 17408);
    LAS bf16* P = (LAS bf16*)(F.lds + 34816);
    LAS bf16* VT = (LAS bf16*)(F.lds + 44032);
    LAS float* part = (LAS float*)(F.lds + 80896);
    LAS float* red = (LAS float*)(F.lds + 82944);
    const int d = tid & 127, tq = tid >> 7;
    float lfv[16], qv[16], kv[16]; float loc = 0.f;
#pragma unroll
    for (int i = 0; i < 16; ++i) { const size_t row = (size_t)(t0 + 16 * tq + i);
        if (IS_A) { lfv[i] = bf2f(h0[row * N_AB + H0_AF + h * 128 + d]); kv[i] = -expm1f(lfv[i]); qv[i] = bf2f(h0[row * N_AB + H0_AQ + h * 128 + d]); }
        else { lfv[i] = bf2f(lab[row * 512 + h * 128 + d]); kv[i] = bf2f(h0[row * N_AB + H0_BK + h * 128 + d]); qv[i] = bf2f(h0[row * N_AB + H0_BQ + h * 128 + d]); }
        loc += lfv[i]; }
    part[tq * 128 + d] = loc;
    stage_vt<DV>(VT, h0 + (size_t)t0 * N_AB + (IS_A ? H0_AI + h * 128 : H0_BV + h * 256), N_AB, tid);
    __syncthreads();
    { float pre = 0.f;
#pragma unroll
        for (int j = 0; j < 4; ++j) { const float p = part[j * 128 + d]; pre += (j < tq) ? p : 0.f; }
        float bc = pre;
#pragma unroll
        for (int i = 0; i < 16; ++i) { bc += lfv[i]; const int t = 16 * tq + i;
            Qs[t * LDQ + d] = (bf16)f2bf(qv[i] * __expf(bc)); Ks[t * LDQ + d] = (bf16)f2bf(kv[i] * __expf(fminf(-bc, 80.f))); } }
    __syncthreads();
    { const int mi = w >> 1;
#pragma unroll
        for (int q = 0; q < 2; ++q) { const int ni = 2 * (w & 1) + q; f32x4 acc = {0.f, 0.f, 0.f, 0.f};
            if (ni <= mi) {
#pragma unroll
                for (int ks = 0; ks < 4; ++ks) acc = mfma16(lds_frag(Qs, LDQ, 16 * mi, 32 * ks, lane), lds_frag(Ks, LDQ, 16 * ni, 32 * ks, lane), acc); }
            const int s = 16 * ni + r16;
#pragma unroll
            for (int j = 0; j < 4; ++j) { const int t = 16 * mi + 4 * g4 + j; P[t * LDK + s] = (bf16)f2bf((ni <= mi && s <= t) ? acc[j] : 0.f); } } }
    __syncthreads();
    constexpr int NE2 = DV / 32;
    const int mi = w & 3, e0 = (w >> 2) * (DV / 2);
    const bf16* S = (const bf16*)(ws + WS_R2) + (IS_A ? (size_t)((b * NCH + n) * 8 + h) * 128 * 128 : (size_t)64 * MiB / 2 + (size_t)((b * NCH + n) * 4 + h) * 256 * 128);
    f32x4 acc[NE2];
    { const bf16x8 p0 = lds_frag(P, LDK, 16 * mi, 0, lane), p1 = lds_frag(P, LDK, 16 * mi, 32, lane);
        bf16x8 qf[4];
#pragma unroll
        for (int ks = 0; ks < 4; ++ks) qf[ks] = lds_frag(Qs, LDQ, 16 * mi, 32 * ks, lane);
#pragma unroll
        for (int i = 0; i < NE2; ++i) { const int et0 = e0 + 16 * i; f32x4 a = {0.f, 0.f, 0.f, 0.f};
            a = mfma16(p0, lds_frag(VT, LDK, et0, 0, lane), a); a = mfma16(p1, lds_frag(VT, LDK, et0, 32, lane), a);
            if (n > 0) {
#pragma unroll
                for (int ks = 0; ks < 4; ++ks) { const bf16x8 sf = *(const GAS bf16x8*)(S + (size_t)(et0 + r16) * 128 + 32 * ks + 8 * g4); a = mfma16(qf[ks], sf, a); } }
            acc[i] = a; } }
    float ss[4];
#pragma unroll
    for (int j = 0; j < 4; ++j) { float s = 0.f;
#pragma unroll
        for (int i = 0; i < NE2; ++i) s += acc[i][j] * acc[i][j];
        s += __shfl_xor(s, 1); s += __shfl_xor(s, 2); s += __shfl_xor(s, 4); s += __shfl_xor(s, 8); ss[j] = s; }
    if (r16 == 0) {
#pragma unroll
        for (int j = 0; j < 4; ++j) red[w * 16 + 4 * g4 + j] = ss[j]; }
    __syncthreads();
    const float* gn = args.in[IS_A ? I_ANORM : I_BNORM];
    const int gcol = IS_A ? H0_AG + h * 128 : H0_BG + h * 256, ocol = IS_A ? h * 128 : 1024 + h * 256;
    bf16* mixed = (bf16*)(ws + WS_MIX);
#pragma unroll
    for (int j = 0; j < 4; ++j) { const float tot = red[w * 16 + 4 * g4 + j] + red[(w ^ 4) * 16 + 4 * g4 + j]; const float rstd = 1.0f / sqrtf(tot * (1.0f / DV) + EPS);
        const size_t row = (size_t)(t0 + 16 * mi + 4 * g4 + j);
#pragma unroll
        for (int i = 0; i < NE2; ++i) { const int e = e0 + 16 * i + r16; const float gate = bf2f(h0[row * N_AB + gcol + e]);
            mixed[row * D + ocol + e] = (bf16)f2bf(acc[i][j] * rstd * gn[e] * gate); } }
    __syncthreads();
}

__device__ __forceinline__ void ab_phase_a(const Args& args, Frame& F) {
    for (int u = F.bid; u < 3072; u += F.G) {
        if (u < 2048) { const int h = u & 7, n = (u >> 3) & 63, b = u >> 9; ab_a_unit<128, true>(args, F, b, n, h); }
        else { const int v = u - 2048; const int h = v & 3, n = (v >> 2) & 63, b = v >> 8; ab_a_unit<256, false>(args, F, b, n, h); }
    }
}
__device__ __forceinline__ void ab_phase_c(const Args& args, Frame& F) {
    for (int u = F.bid; u < 3072; u += F.G) {
        if (u < 2048) { const int h = u & 7, n = (u >> 3) & 63, b = u >> 9; ab_c_unit<128, true>(args, F, b, n, h); }
        else { const int v = u - 2048; const int h = v & 3, n = (v >> 2) & 63, b = v >> 8; ab_c_unit<256, false>(args, F, b, n, h); }
    }
}
__device__ __forceinline__ int swz128(int r, int c) { return r * 256 + ((((c >> 3) ^ r) & 15) << 4) + (c & 7) * 2; }
__device__ __forceinline__ bf16x8 frag128(const LAS unsigned char* tile, int r0, int k0, int lane) { const int r = r0 + (lane & 15), ch = (k0 >> 3) + (lane >> 4); return *(const LAS bf16x8*)(tile + r * 256 + (((ch ^ r) & 15) << 4)); }
__device__ __forceinline__ bf16x8 tfrag128(const LAS unsigned char* tile, int s0, int c0, int lane) {
    const int r16 = lane & 15, g4 = lane >> 4; const int row = s0 + 8 * g4 + (r16 >> 2), col = c0 + 4 * (r16 & 3);
    const s16x4 lo = __builtin_bit_cast(s16x4, __builtin_amdgcn_ds_read_tr16_b64_v4i16((LAS s16x4*)(tile + swz128(row, col))));
    const s16x4 hi = __builtin_bit_cast(s16x4, __builtin_amdgcn_ds_read_tr16_b64_v4i16((LAS s16x4*)(tile + swz128(row + 4, col))));
    return __builtin_shufflevector(lo, hi, 0, 1, 2, 3, 4, 5, 6, 7);
}
__device__ __forceinline__ void dma_tile128(LAS unsigned char* tile, const bf16* src, size_t pitch, int rows, int wave, int lane) {
    for (int ii = wave; ii < rows / 4; ii += 8) { const int row = 4 * ii + (lane >> 4), ch = ((lane & 15) ^ row) & 15;
        __builtin_amdgcn_global_load_lds((const unsigned*)(src + (size_t)row * pitch + ch * 8), (LAS unsigned*)(tile + ii * 1024), 16, 0, 0); }
}
#define BAR_LDS() do { asm volatile("s_waitcnt lgkmcnt(0)" ::: "memory"); __builtin_amdgcn_s_barrier(); asm volatile("" ::: "memory"); } while (0)
#define BAR_ALL() do { asm volatile("s_waitcnt vmcnt(0) lgkmcnt(0)" ::: "memory"); __builtin_amdgcn_s_barrier(); asm volatile("" ::: "memory"); } while (0)

__device__ __forceinline__ void ab_decode(int u, bool& isA, int& b, int& n, int& h) {
    if (u < 2048) { isA = true; h = u & 7; n = (u >> 3) & 63; b = u >> 9; } else { const int v = u - 2048; isA = false; h = v & 3; n = (v >> 2) & 63; b = v >> 8; }
}
__device__ __forceinline__ void ab_load_raw(const Args& args, int u, int tid, bool need_q, u32x4 (&R)[6]) {
    bool isA; int b, n, h; ab_decode(u, isA, b, n, h);
    const bf16* h0 = (const bf16*)(args.ws + WS_R1); const bf16* lab = (const bf16*)(args.ws + WS_LAB);
    const size_t t0 = (size_t)(b * SEQ + n * 64);
#pragma unroll
    for (int i = 0; i < 2; ++i) { const int cid = tid + 512 * i, row = cid >> 4, ch = cid & 15;
        const bf16* hrow = h0 + (t0 + row) * N_AB + h * 128 + ch * 8;
        R[i] = isA ? *(const GAS u32x4*)(hrow + H0_AF) : *(const GAS u32x4*)(lab + (t0 + row) * 512 + h * 128 + ch * 8);
        if (need_q) R[2 + i] = *(const GAS u32x4*)(hrow + (isA ? H0_AQ : H0_BQ));
        if (!isA) R[4 + i] = *(const GAS u32x4*)(hrow + H0_BK); else R[4 + i] = (u32x4){0u, 0u, 0u, 0u}; }
}
__device__ __forceinline__ void ab_store_raw(LAS unsigned char* LF, LAS unsigned char* Q, LAS unsigned char* K, int tid, bool need_q, bool isA, const u32x4 (&R)[6]) {
#pragma unroll
    for (int i = 0; i < 2; ++i) { const int cid = tid + 512 * i, row = cid >> 4, ch = cid & 15; const int off = row * 256 + (((ch ^ row) & 15) << 4);
        *(LAS u32x4*)(LF + off) = R[i]; if (need_q) *(LAS u32x4*)(Q + off) = R[2 + i]; if (!isA) *(LAS u32x4*)(K + off) = R[4 + i]; }
}

constexpr int C2_LF = 0, C2_Q = 16384, C2_K = 32768, C2_P = 49152, C2_V0 = 58368, C2_S0 = 74752, C2_S1 = 107520, C2_PART = 140288, C2_RED = 142336;
static_assert(C2_RED + 1024 <= LDS_BYTES - 1024, "phase (c) LDS map");

template <bool IS_A>
__device__ __forceinline__ void ab_c_unit2(const Args& args, Frame& F, int b, int n, int h) {
    unsigned char* ws = args.ws; const bf16* h0 = (const bf16*)(ws + WS_R1);
    const int t0 = b * SEQ + n * 64, tid = F.tid, lane = F.lane, w = F.wave, r16 = lane & 15, g4 = lane >> 4;
    LAS unsigned char* LF = F.lds + C2_LF; LAS unsigned char* Q = F.lds + C2_Q; LAS unsigned char* K = F.lds + C2_K;
    LAS bf16* P = (LAS bf16*)(F.lds + C2_P); LAS unsigned char* V0 = F.lds + C2_V0; LAS unsigned char* S0 = F.lds + C2_S0; LAS unsigned char* S1 = F.lds + C2_S1;
    LAS float* part = (LAS float*)(F.lds + C2_PART); LAS float* red = (LAS float*)(F.lds + C2_RED);
    constexpr int DV = IS_A ? 128 : 256;
    const bf16* Sg = (const bf16*)(ws + WS_R2) + (IS_A ? (size_t)((b * NCH + n) * 8 + h) * 128 * 128 : (size_t)64 * MiB / 2 + (size_t)((b * NCH + n) * 4 + h) * 256 * 128);
    const bf16* Vg = h0 + (size_t)t0 * N_AB + (IS_A ? H0_AI + h * 128 : H0_BV + h * 256);
    dma_tile128(V0, Vg, N_AB, 64, w, lane);
    if (n > 0) { dma_tile128(S0, Sg, 128, 128, w, lane); if (!IS_A) dma_tile128(S1, Sg + 128 * 128, 128, 128, w, lane); }
    const int d = tid & 127, tq = tid >> 7;
    float lfv[16]; float loc = 0.f;
#pragma unroll
    for (int i = 0; i < 16; ++i) { lfv[i] = bf2f(*(const LAS bf16*)(LF + swz128(16 * tq + i, d))); loc += lfv[i]; }
    part[tq * 128 + d] = loc;
    BAR_LDS();
    { float pre = 0.f;
#pragma unroll
        for (int j = 0; j < 4; ++j) { const float p = part[j * 128 + d]; pre += (j < tq) ? p : 0.f; }
        float bc = pre;
#pragma unroll
        for (int i = 0; i < 16; ++i) { bc += lfv[i]; const int off = swz128(16 * tq + i, d);
            const float qv = bf2f(*(const LAS bf16*)(Q + off)); const float kv = IS_A ? -expm1f(lfv[i]) : bf2f(*(const LAS bf16*)(K + off));
            *(LAS bf16*)(Q + off) = (bf16)f2bf(qv * __expf(bc)); *(LAS bf16*)(K + off) = (bf16)f2bf(kv * __expf(fminf(-bc, 80.f))); } }
    BAR_LDS();
    if (!IS_A) dma_tile128(LF, Vg + 128, N_AB, 64, w, lane);
    { const int mi = w >> 1;
#pragma unroll
        for (int q2 = 0; q2 < 2; ++q2) { const int ni = 2 * (w & 1) + q2; f32x4 acc = {0.f, 0.f, 0.f, 0.f};
            if (ni <= mi) {
#pragma unroll
                for (int ks = 0; ks < 4; ++ks) acc = mfma16(frag128(K, 16 * ni, 32 * ks, lane), frag128(Q, 16 * mi, 32 * ks, lane), acc); }
            const int t = 16 * mi + r16, s0 = 16 * ni + 4 * g4;
            float pv[4];
#pragma unroll
            for (int j = 0; j < 4; ++j) pv[j] = (ni <= mi && s0 + j <= t) ? acc[j] : 0.f;
            u32x2 o; o.x = pk2(pv[0], pv[1]); o.y = pk2(pv[2], pv[3]);
            *(LAS u32x2*)(P + t * LDK + s0) = o; } }
    const int mi = w & 3, eh = w >> 2;
    constexpr int NH = IS_A ? 1 : 2;
    const int gcol = IS_A ? H0_AG + h * 128 : H0_BG + h * 256, ocol = IS_A ? h * 128 : 1024 + h * 256;
    const size_t row = (size_t)(t0 + 16 * mi + r16);
    u32x2 gwv[NH][4];
#pragma unroll
    for (int hf = 0; hf < NH; ++hf)
#pragma unroll
        for (int i = 0; i < 4; ++i) gwv[hf][i] = *(const GAS u32x2*)(h0 + row * N_AB + gcol + 128 * hf + 64 * eh + 16 * i + 4 * g4);
    BAR_ALL();
    f32x4 acc[NH][4];
    { const bf16x8 p0 = lds_frag(P, LDK, 16 * mi, 0, lane), p1 = lds_frag(P, LDK, 16 * mi, 32, lane);
        bf16x8 qf[4];
#pragma unroll
        for (int ks = 0; ks < 4; ++ks) qf[ks] = frag128(Q, 16 * mi, 32 * ks, lane);
#pragma unroll
        for (int hf = 0; hf < NH; ++hf) { const LAS unsigned char* Vt = hf ? LF : V0; const LAS unsigned char* St = hf ? S1 : S0;
#pragma unroll
            for (int i = 0; i < 4; ++i) { const int e0 = 64 * eh + 16 * i; f32x4 a = {0.f, 0.f, 0.f, 0.f};
                a = mfma16(tfrag128(Vt, 0, e0, lane), p0, a); a = mfma16(tfrag128(Vt, 32, e0, lane), p1, a);
                if (n > 0) {
#pragma unroll
                    for (int ks = 0; ks < 4; ++ks) a = mfma16(frag128(St, e0, 32 * ks, lane), qf[ks], a); }
                acc[hf][i] = a; } } }
    float ss = 0.f;
#pragma unroll
    for (int hf = 0; hf < NH; ++hf)
#pragma unroll
        for (int i = 0; i < 4; ++i)
#pragma unroll
            for (int j = 0; j < 4; ++j) ss += acc[hf][i][j] * acc[hf][i][j];
    ss += __shfl_xor(ss, 16); ss += __shfl_xor(ss, 32);
    if (g4 == 0) red[eh * 64 + 16 * mi + r16] = ss;
    BAR_LDS();
    const float tot = red[16 * mi + r16] + red[64 + 16 * mi + r16]; const float rstd = 1.0f / sqrtf(tot * (1.0f / DV) + EPS);
    const float* gn = args.in[IS_A ? I_ANORM : I_BNORM];
    bf16* mixed = (bf16*)(ws + WS_MIX);
#pragma unroll
    for (int hf = 0; hf < NH; ++hf)
#pragma unroll
        for (int i = 0; i < 4; ++i) { const int e = 128 * hf + 64 * eh + 16 * i + 4 * g4;
            const u32x2 gw = gwv[hf][i]; const f32x4 gg = *(const f32x4*)(gn + e);
            u32x2 o; o.x = pk2(acc[hf][i][0] * rstd * gg.x * bflo(gw.x), acc[hf][i][1] * rstd * gg.y * bfhi(gw.x)); o.y = pk2(acc[hf][i][2] * rstd * gg.z * bflo(gw.y), acc[hf][i][3] * rstd * gg.w * bfhi(gw.y));
            *(GAS u32x2*)(mixed + row * D + ocol + e) = o; }
}

__device__ __forceinline__ void ab_phase_c2(const Args& args, Frame& F) {
    u32x4 R[6];
    int u = F.bid;
    if (u < 3072) ab_load_raw(args, u, F.tid, true, R);
    for (; u < 3072; u += F.G) {
        bool isA; int b, n, h; ab_decode(u, isA, b, n, h);
        BAR_ALL();
        ab_store_raw(F.lds + C2_LF, F.lds + C2_Q, F.lds + C2_K, F.tid, true, isA, R);
        if (u + F.G < 3072) ab_load_raw(args, u + F.G, F.tid, true, R);
        BAR_LDS();
        if (isA) ab_c_unit2<true>(args, F, b, n, h); else ab_c_unit2<false>(args, F, b, n, h);
    }
    BAR_ALL();
}

constexpr int A2_LF = 0, A2_K = 16384, A2_KT = 32768, A2_V0 = 51200, A2_V1 = 67584, A2_PART = 83968;
template <bool IS_A>
__device__ __forceinline__ void ab_a_unit2(const Args& args, Frame& F, int b, int n, int h) {
    unsigned char* ws = args.ws; const bf16* h0 = (const bf16*)(ws + WS_R1);
    const int t0 = b * SEQ + n * 64, tid = F.tid, lane = F.lane, w = F.wave;
    LAS unsigned char* LF = F.lds + A2_LF; LAS unsigned char* K = F.lds + A2_K; LAS bf16* KT = (LAS bf16*)(F.lds + A2_KT);
    LAS unsigned char* V0 = F.lds + A2_V0; LAS unsigned char* V1 = F.lds + A2_V1; LAS float* part = (LAS float*)(F.lds + A2_PART);
    constexpr int DV = IS_A ? 128 : 256;
    const bf16* Vg = h0 + (size_t)t0 * N_AB + (IS_A ? H0_AI + h * 128 : H0_BV + h * 256);
    dma_tile128(V0, Vg, N_AB, 64, w, lane);
    if (!IS_A) dma_tile128(V1, Vg + 128, N_AB, 64, w, lane);
    const int d = tid & 127, tq = tid >> 7;
    float lfv[16], kv[16]; float loc = 0.f;
#pragma unroll
    for (int i = 0; i < 16; ++i) { const int off = swz128(16 * tq + i, d); lfv[i] = bf2f(*(const LAS bf16*)(LF + off)); kv[i] = IS_A ? -expm1f(lfv[i]) : bf2f(*(const LAS bf16*)(K + off)); loc += lfv[i]; }
    part[tq * 128 + d] = loc;
    BAR_LDS();
    float pre = 0.f, tot = 0.f;
#pragma unroll
    for (int j = 0; j < 4; ++j) { const float p = part[j * 128 + d]; tot += p; pre += (j < tq) ? p : 0.f; }
    { float bc = pre; unsigned wv[8];
#pragma unroll
        for (int i = 0; i < 16; i += 2) { bc += lfv[i]; const float k0 = kv[i] * __expf(tot - bc); bc += lfv[i + 1]; const float k1 = kv[i + 1] * __expf(tot - bc); wv[i >> 1] = pk2(k0, k1); }
        u32x4 o0, o1; o0.x = wv[0]; o0.y = wv[1]; o0.z = wv[2]; o0.w = wv[3]; o1.x = wv[4]; o1.y = wv[5]; o1.z = wv[6]; o1.w = wv[7];
        *(LAS u32x4*)(KT + d * LDK + 16 * tq) = o0; *(LAS u32x4*)(KT + d * LDK + 16 * tq + 8) = o1; }
    if (tq == 0) { float* G = (float*)(ws + (IS_A ? WS_GA : WS_GB)); G[(size_t)((b * NCH + n) * (IS_A ? 8 : 4) + h) * 128 + d] = __expf(tot); }
    BAR_ALL();
    bf16* U = (bf16*)(ws + WS_R2) + (IS_A ? (size_t)((b * NCH + n) * 8 + h) * 128 * 128 : (size_t)64 * MiB / 2 + (size_t)((b * NCH + n) * 4 + h) * 256 * 128);
    const bf16x8 a0 = lds_frag(KT, LDK, 16 * w, 0, lane), a1 = lds_frag(KT, LDK, 16 * w, 32, lane);
#pragma unroll 4
    for (int et = 0; et < DV / 16; ++et) { const LAS unsigned char* Vt = (et < 8) ? V0 : V1; const int c0 = (et & 7) * 16;
        f32x4 acc = {0.f, 0.f, 0.f, 0.f};
        acc = mfma16(a0, tfrag128(Vt, 0, c0, lane), acc);
        acc = mfma16(a1, tfrag128(Vt, 32, c0, lane), acc);
        u32x2 o; o.x = pk2(acc[0], acc[1]); o.y = pk2(acc[2], acc[3]);
        *(GAS u32x2*)(U + (size_t)(16 * et + (lane & 15)) * 128 + 16 * w + 4 * (lane >> 4)) = o; }
}
__device__ __forceinline__ void ab_phase_a2(const Args& args, Frame& F) {
    u32x4 R[6];
    int u = F.bid;
    if (u < 3072) ab_load_raw(args, u, F.tid, false, R);
    for (; u < 3072; u += F.G) {
        bool isA; int b, n, h; ab_decode(u, isA, b, n, h);
        BAR_ALL();
        ab_store_raw(F.lds + A2_LF, F.lds + A2_LF, F.lds + A2_K, F.tid, false, isA, R);
        if (u + F.G < 3072) ab_load_raw(args, u + F.G, F.tid, false, R);
        BAR_LDS();
        if (isA) ab_a_unit2<true>(args, F, b, n, h); else ab_a_unit2<false>(args, F, b, n, h);
    }
    BAR_ALL();
}
constexpr int NPR = NCH / 2, NPAIRS = BATCH * NPR * 12;
__device__ __forceinline__ void abp_decode(int up, bool& isA, int& b, int& p, int& h) {
    if (up < 1024) { isA = true; h = up & 7; p = (up >> 3) & 31; b = up >> 8; } else { const int v = up - 1024; isA = false; h = v & 3; p = (v >> 2) & 31; b = v >> 7; }
}
__device__ __forceinline__ int abp_chunk_unit(int up, int sub) {
    bool isA; int b, p, h; abp_decode(up, isA, b, p, h); const int n = 2 * p + sub;
    return isA ? ((b << 9) | (n << 3) | h) : 2048 + ((b << 8) | (n << 2) | h);
}
__device__ __forceinline__ size_t abp_state_off(bool isA, int b, int p, int h) {
    return isA ? (size_t)((b * NPR + p) * 8 + h) * 128 * 128 : (size_t)64 * MiB / 2 + (size_t)((b * NPR + p) * 4 + h) * 256 * 128;
}

template <bool IS_A>
__device__ __forceinline__ void ab_a_pair(const Args& args, Frame& F, int up, int b, int p, int h, u32x4 (&R)[6]) {
    unsigned char* ws = args.ws; const bf16* h0 = (const bf16*)(ws + WS_R1);
    const int tid = F.tid, lane = F.lane, w = F.wave, r16 = lane & 15, g4 = lane >> 4;
    LAS unsigned char* LF = F.lds + A2_LF; LAS unsigned char* K = F.lds + A2_K; LAS bf16* KT = (LAS bf16*)(F.lds + A2_KT);
    LAS unsigned char* V0 = F.lds + A2_V0; LAS unsigned char* V1 = F.lds + A2_V1; LAS float* part = (LAS float*)(F.lds + A2_PART);
    constexpr int DV = IS_A ? 128 : 256, NT = DV / 16;
    const int d = tid & 127, tq = tid >> 7;
    f32x4 acc[NT];
#pragma unroll
    for (int et = 0; et < NT; ++et) acc[et] = (f32x4){0.f, 0.f, 0.f, 0.f};
    float tot0 = 0.f, tot1 = 0.f;
#pragma unroll
    for (int sub = 0; sub < 2; ++sub) {
        const int n = 2 * p + sub, t0 = b * SEQ + n * 64;
        BAR_ALL();
        ab_store_raw(LF, LF, K, tid, false, IS_A, R);
        if (sub == 0) ab_load_raw(args, abp_chunk_unit(up, 1), tid, false, R);
        else if (up + F.G < NPAIRS) ab_load_raw(args, abp_chunk_unit(up + F.G, 0), tid, false, R);
        BAR_LDS();
        const bf16* Vg = h0 + (size_t)t0 * N_AB + (IS_A ? H0_AI + h * 128 : H0_BV + h * 256);
        dma_tile128(V0, Vg, N_AB, 64, w, lane);
        if (!IS_A) dma_tile128(V1, Vg + 128, N_AB, 64, w, lane);
        float lfv[16], kv[16]; float loc = 0.f;
#pragma unroll
        for (int i = 0; i < 16; ++i) { const int off = swz128(16 * tq + i, d); lfv[i] = bf2f(*(const LAS bf16*)(LF + off)); kv[i] = IS_A ? -expm1f(lfv[i]) : bf2f(*(const LAS bf16*)(K + off)); loc += lfv[i]; }
        part[tq * 128 + d] = loc;
        BAR_LDS();
        float pre = 0.f, tot = 0.f;
#pragma unroll
        for (int j = 0; j < 4; ++j) { const float pp = part[j * 128 + d]; tot += pp; pre += (j < tq) ? pp : 0.f; }
        { float bc = pre; unsigned wv[8];
#pragma unroll
            for (int i = 0; i < 16; i += 2) { bc += lfv[i]; const float k0 = kv[i] * __expf(tot - bc); bc += lfv[i + 1]; const float k1 = kv[i + 1] * __expf(tot - bc); wv[i >> 1] = pk2(k0, k1); }
            u32x4 o0, o1; o0.x = wv[0]; o0.y = wv[1]; o0.z = wv[2]; o0.w = wv[3]; o1.x = wv[4]; o1.y = wv[5]; o1.z = wv[6]; o1.w = wv[7];
            *(LAS u32x4*)(KT + d * LDK + 16 * tq) = o0; *(LAS u32x4*)(KT + d * LDK + 16 * tq + 8) = o1; }
        if (sub == 0) tot0 = tot; else tot1 = tot;
        BAR_ALL();
        if (sub == 1) {
            float gd[4];
#pragma unroll
            for (int j = 0; j < 4; ++j) { const int dd = 16 * w + 4 * g4 + j; gd[j] = __expf((part[dd] + part[128 + dd]) + (part[256 + dd] + part[384 + dd])); }
#pragma unroll
            for (int et = 0; et < NT; ++et)
#pragma unroll
                for (int j = 0; j < 4; ++j) acc[et][j] *= gd[j];
        }
        int ll = lane; asm volatile("" : "+v"(ll));
        const bf16x8 a0 = lds_frag(KT, LDK, 16 * w, 0, ll), a1 = lds_frag(KT, LDK, 16 * w, 32, ll);
#pragma unroll
        for (int et = 0; et < NT; ++et) { const LAS unsigned char* Vt = (et < 8) ? V0 : V1; const int c0 = (et & 7) * 16;
            acc[et] = mfma16(a0, tfrag128(Vt, 0, c0, ll), acc[et]);
            acc[et] = mfma16(a1, tfrag128(Vt, 32, c0, ll), acc[et]); if (et & 1) __builtin_amdgcn_sched_barrier(0); }
    }
    if (tq == 0) { float* G = (float*)(ws + (IS_A ? WS_GA : WS_GB)); G[(size_t)((b * NPR + p) * (IS_A ? 8 : 4) + h) * 128 + d] = __expf(tot0 + tot1); }
    bf16* U = (bf16*)(ws + WS_R2) + abp_state_off(IS_A, b, p, h);
#pragma unroll
    for (int et = 0; et < NT; ++et) { u32x2 o; o.x = pk2(acc[et][0], acc[et][1]); o.y = pk2(acc[et][2], acc[et][3]);
        *(GAS u32x2*)(U + (size_t)(16 * et + r16) * 128 + 16 * w + 4 * g4) = o; }
}
__device__ __forceinline__ void ab_phase_a3(const Args& args, Frame& F) {
    u32x4 R[6];
    int up = F.bid;
    if (up < NPAIRS) ab_load_raw(args, abp_chunk_unit(up, 0), F.tid, false, R);
    for (; up < NPAIRS; up += F.G) {
        bool isA; int b, p, h; abp_decode(up, isA, b, p, h);
        if (isA) ab_a_pair<true>(args, F, up, b, p, h, R); else ab_a_pair<false>(args, F, up, b, p, h, R);
    }
    BAR_ALL();
}

__device__ __forceinline__ void ab_scan_p(const Args& args, Frame& F) {
    unsigned char* ws = args.ws;
    const int NT_A = BATCH * 8 * 128 * 16, NT_B = BATCH * 4 * 256 * 16;
    for (int gt = F.bid * 512 + F.tid; gt < NT_A + NT_B; gt += F.G * 512) {
        const bool isA = gt < NT_A; const int r = isA ? gt : gt - NT_A;
        const int d8 = r & 15; int e, h, b, H, DV;
        if (isA) { e = (r >> 4) & 127; h = (r >> 11) & 7; b = r >> 14; H = 8; DV = 128; } else { e = (r >> 4) & 255; h = (r >> 12) & 3; b = r >> 14; H = 4; DV = 256; }
        bf16* S = (bf16*)(ws + WS_R2) + (isA ? (size_t)0 : (size_t)64 * MiB / 2);
        const float* G = (const float*)(ws + (isA ? WS_GA : WS_GB));
        float st[8];
#pragma unroll
        for (int j = 0; j < 8; ++j) st[j] = 0.f;
#pragma unroll 4
        for (int p = 0; p < NPR; ++p) {
            GAS u32x4* q = (GAS u32x4*)(S + ((size_t)((b * NPR + p) * H + h) * DV + e) * 128 + 8 * d8);
            const float* gp = G + (size_t)((b * NPR + p) * H + h) * 128 + 8 * d8;
            const u32x4 u = *q; const f32x4 g0 = *(const f32x4*)gp, g1 = *(const f32x4*)(gp + 4);
            u32x4 o; o.x = pk2(st[0], st[1]); o.y = pk2(st[2], st[3]); o.z = pk2(st[4], st[5]); o.w = pk2(st[6], st[7]);
            *q = o;
            st[0] = g0.x * st[0] + bflo(u.x); st[1] = g0.y * st[1] + bfhi(u.x); st[2] = g0.z * st[2] + bflo(u.y); st[3] = g0.w * st[3] + bfhi(u.y);
            st[4] = g1.x * st[4] + bflo(u.z); st[5] = g1.y * st[5] + bfhi(u.z); st[6] = g1.z * st[6] + bflo(u.w); st[7] = g1.w * st[7] + bfhi(u.w);
        }
    }
}

template <bool IS_A>
__device__ __forceinline__ void ab_c_step(const Args& args, Frame& F, int b, int p, int h, const int sub) {
    unsigned char* ws = args.ws; const bf16* h0 = (const bf16*)(ws + WS_R1);
    const int n = 2 * p + sub;
    int lane = F.lane; asm volatile("" : "+v"(lane));
    const int t0 = b * SEQ + n * 64, tid = F.tid, w = F.wave, r16 = lane & 15, g4 = lane >> 4;
    LAS unsigned char* LF = F.lds + C2_LF; LAS unsigned char* Q = F.lds + C2_Q; LAS unsigned char* K = F.lds + C2_K;
    LAS bf16* P = (LAS bf16*)(F.lds + C2_P); LAS unsigned char* V0 = F.lds + C2_V0; LAS unsigned char* S0 = F.lds + C2_S0; LAS unsigned char* S1 = F.lds + C2_S1;
    LAS float* part = (LAS float*)(F.lds + C2_PART); LAS float* red = (LAS float*)(F.lds + C2_RED);
    constexpr int DV = IS_A ? 128 : 256;
    const bf16* Sg = (const bf16*)(ws + WS_R2) + abp_state_off(IS_A, b, p, h);
    const bf16* Vg = h0 + (size_t)t0 * N_AB + (IS_A ? H0_AI + h * 128 : H0_BV + h * 256);
    dma_tile128(V0, Vg, N_AB, 64, w, lane);
    if (sub == 0 && p > 0) { dma_tile128(S0, Sg, 128, 128, w, lane); if (!IS_A) dma_tile128(S1, Sg + 128 * 128, 128, 128, w, lane); }
    const int d = tid & 127, tq = tid >> 7;
    float lfv[16]; float loc = 0.f;
#pragma unroll
    for (int i = 0; i < 16; ++i) { lfv[i] = bf2f(*(const LAS bf16*)(LF + swz128(16 * tq + i, d))); loc += lfv[i]; }
    part[tq * 128 + d] = loc;
    BAR_LDS();
    { float pre = 0.f;
#pragma unroll
        for (int j = 0; j < 4; ++j) { const float pp = part[j * 128 + d]; pre += (j < tq) ? pp : 0.f; }
        float bc = pre;
#pragma unroll
        for (int i = 0; i < 16; ++i) { bc += lfv[i]; const int off = swz128(16 * tq + i, d);
            const float qv = bf2f(*(const LAS bf16*)(Q + off)); const float kv = IS_A ? -expm1f(lfv[i]) : bf2f(*(const LAS bf16*)(K + off));
            *(LAS bf16*)(Q + off) = (bf16)f2bf(qv * __expf(bc)); *(LAS bf16*)(K + off) = (bf16)f2bf(kv * __expf(fminf(-bc, 80.f))); } }
    BAR_LDS();
    if (!IS_A) dma_tile128(LF, Vg + 128, N_AB, 64, w, lane);
    { const int mi = w >> 1;
#pragma unroll
        for (int q2 = 0; q2 < 2; ++q2) { const int ni = 2 * (w & 1) + q2; f32x4 acc = {0.f, 0.f, 0.f, 0.f};
            if (ni <= mi) {
#pragma unroll
                for (int ks = 0; ks < 4; ++ks) acc = mfma16(frag128(K, 16 * ni, 32 * ks, lane), frag128(Q, 16 * mi, 32 * ks, lane), acc); }
            const int t = 16 * mi + r16, s0 = 16 * ni + 4 * g4;
            float pv[4];
#pragma unroll
            for (int j = 0; j < 4; ++j) pv[j] = (ni <= mi && s0 + j <= t) ? acc[j] : 0.f;
            u32x2 o; o.x = pk2(pv[0], pv[1]); o.y = pk2(pv[2], pv[3]);
            *(LAS u32x2*)(P + t * LDK + s0) = o; } }
    const int mi = w & 3, eh = w >> 2;
    constexpr int NH = IS_A ? 1 : 2;
    const int gcol = IS_A ? H0_AG + h * 128 : H0_BG + h * 256, ocol = IS_A ? h * 128 : 1024 + h * 256;
    const size_t row = (size_t)(t0 + 16 * mi + r16);
    u32x2 gwv[NH][4];
#pragma unroll
    for (int hf = 0; hf < NH; ++hf)
#pragma unroll
        for (int i = 0; i < 4; ++i) gwv[hf][i] = *(const GAS u32x2*)(h0 + row * N_AB + gcol + 128 * hf + 64 * eh + 16 * i + 4 * g4);
    BAR_ALL();
    f32x4 acc[NH][4];
    { const bf16x8 p0 = lds_frag(P, LDK, 16 * mi, 0, lane), p1 = lds_frag(P, LDK, 16 * mi, 32, lane);
        bf16x8 qf[4];
#pragma unroll
        for (int ks = 0; ks < 4; ++ks) qf[ks] = frag128(Q, 16 * mi, 32 * ks, lane);
#pragma unroll
        for (int hf = 0; hf < NH; ++hf) { const LAS unsigned char* Vt = hf ? LF : V0; const LAS unsigned char* St = hf ? S1 : S0;
#pragma unroll
            for (int i = 0; i < 4; ++i) { const int e0 = 64 * eh + 16 * i; f32x4 a = {0.f, 0.f, 0.f, 0.f};
                a = mfma16(tfrag128(Vt, 0, e0, lane), p0, a); a = mfma16(tfrag128(Vt, 32, e0, lane), p1, a);
                if (n > 0) {
#pragma unroll
                    for (int ks = 0; ks < 4; ++ks) a = mfma16(frag128(St, e0, 32 * ks, lane), qf[ks], a); }
                acc[hf][i] = a; } } }
    float ss = 0.f;
#pragma unroll
    for (int hf = 0; hf < NH; ++hf)
#pragma unroll
        for (int i = 0; i < 4; ++i)
#pragma unroll
            for (int j = 0; j < 4; ++j) ss += acc[hf][i][j] * acc[hf][i][j];
    ss += __shfl_xor(ss, 16); ss += __shfl_xor(ss, 32);
    if (g4 == 0) red[eh * 64 + 16 * mi + r16] = ss;
    BAR_LDS();
    const float tot = red[16 * mi + r16] + red[64 + 16 * mi + r16]; const float rstd = 1.0f / sqrtf(tot * (1.0f / DV) + EPS);
    const float* gn = args.in[IS_A ? I_ANORM : I_BNORM];
    bf16* mixed = (bf16*)(ws + WS_MIX);
#pragma unroll
    for (int hf = 0; hf < NH; ++hf)
#pragma unroll
        for (int i = 0; i < 4; ++i) { const int e = 128 * hf + 64 * eh + 16 * i + 4 * g4;
            const u32x2 gw = gwv[hf][i]; const f32x4 gg = *(const f32x4*)(gn + e);
            u32x2 o; o.x = pk2(acc[hf][i][0] * rstd * gg.x * bflo(gw.x), acc[hf][i][1] * rstd * gg.y * bfhi(gw.x)); o.y = pk2(acc[hf][i][2] * rstd * gg.z * bflo(gw.y), acc[hf][i][3] * rstd * gg.w * bfhi(gw.y));
            *(GAS u32x2*)(mixed + row * D + ocol + e) = o; }
    if (sub == 0) {
        const int d0 = 16 * w;
        const float gd = __expf((part[d0 + r16] + part[128 + d0 + r16]) + (part[256 + d0 + r16] + part[384 + d0 + r16]));
        const bf16x8 k0 = tfrag128(K, 0, d0, lane), k1 = tfrag128(K, 32, d0, lane);
#pragma unroll
        for (int et = 0; et < DV / 16; ++et) { LAS unsigned char* St = (et < 8) ? S0 : S1; const LAS unsigned char* Vt = (et < 8) ? V0 : LF; const int e0 = (et & 7) * 16;
            f32x4 a = {0.f, 0.f, 0.f, 0.f};
            if (n > 0) {
#pragma unroll
                for (int j = 0; j < 4; ++j) a[j] = bf2f(*(const LAS bf16*)(St + swz128(e0 + 4 * g4 + j, d0 + r16))); }
            a = mfma16(tfrag128(Vt, 0, e0, lane), k0, a); a = mfma16(tfrag128(Vt, 32, e0, lane), k1, a);
#pragma unroll
            for (int j = 0; j < 4; ++j) *(LAS bf16*)(St + swz128(e0 + 4 * g4 + j, d0 + r16)) = (bf16)f2bf(a[j] * gd);
            __builtin_amdgcn_sched_barrier(0); }
    }
}
__device__ __forceinline__ void ab_phase_c3(const Args& args, Frame& F) {
    u32x4 R[6];
    int up = F.bid;
    if (up < NPAIRS) ab_load_raw(args, abp_chunk_unit(up, 0), F.tid, true, R);
    for (; up < NPAIRS; up += F.G) {
        bool isA; int b, p, h; abp_decode(up, isA, b, p, h);
#pragma unroll
        for (int sub = 0; sub < 2; ++sub) {
            BAR_ALL();
            ab_store_raw(F.lds + C2_LF, F.lds + C2_Q, F.lds + C2_K, F.tid, true, isA, R);
            if (sub == 0) ab_load_raw(args, abp_chunk_unit(up, 1), F.tid, true, R);
            else if (up + F.G < NPAIRS) ab_load_raw(args, abp_chunk_unit(up + F.G, 0), F.tid, true, R);
            BAR_LDS();
            if (isA) ab_c_step<true>(args, F, b, p, h, sub); else ab_c_step<false>(args, F, b, p, h, sub);
        }
    }
    BAR_ALL();
}
#ifndef PROBE_SKIP
#define PROBE_SKIP 0
#endif
constexpr int H1_CQ = 0, H1_CKV = 1024, H1_IQ = 1280, H1_DQ = 2304, H1_DK = 2816, H1_DV = 3328, H1_DOG = 4352;
constexpr int SM_IK = 0, SM_IW = 64, SM_DI = 80, SM_DF = 84;
constexpr size_t SCORES_PER_BATCH = (size_t)4096 * 64 * 65 / 2;
__device__ __forceinline__ size_t score_row_off(int t) { const size_t c = (size_t)(t >> 6), r = (size_t)(t & 63); return 2048 * c * (c + 1) + 64 * r * (c + 1); }

__device__ __forceinline__ void dsa_prep_rows(const Args& args, Frame& F) {
    unsigned char* ws = args.ws; const bf16* h1 = (const bf16*)(ws + WS_R1); bf16* ckvn = (bf16*)(ws + WS_CKVN);
    const float* g = args.in[I_CKVG];
    const int gw = F.bid * 8 + F.wave, NGW = F.G * 8;
    for (int m = gw; m < T; m += NGW) {
        const u32x2 v = *(const GAS u32x2*)(h1 + (size_t)m * N_CD + H1_CKV + 4 * F.lane);
        const float a = bflo(v.x), b = bfhi(v.x), c = bflo(v.y), d = bfhi(v.y);
        const float ss = wave_sum(a * a + b * b + c * c + d * d); const float rs = 1.0f / sqrtf(ss * (1.0f / 256.f) + EPS);
        const f32x4 gg = *(const f32x4*)(g + 4 * F.lane);
        u32x2 o; o.x = pk2(a * rs * gg.x, b * rs * gg.y); o.y = pk2(c * rs * gg.z, d * rs * gg.w);
        *(GAS u32x2*)(ckvn + (size_t)m * 256 + 4 * F.lane) = o;
    }
}

__device__ __forceinline__ void dsa_indexer(const Args& args, Frame& F) {
    unsigned char* ws = args.ws; const bf16* h1 = (const bf16*)(ws + WS_R1); const float* small = (const float*)(ws + WS_SMALL);
    float* scores = (float*)(ws + WS_R2);
    LAS bf16* KS = (LAS bf16*)F.lds;
    const int lane = F.lane, w = F.wave, r16 = lane & 15, g4 = lane >> 4;
    const int u_lo = (int)((long)F.bid * (4 * 272) / F.G), u_hi = (int)((long)(F.bid + 1) * (4 * 272) / F.G);
    int u = u_lo;
    while (u < u_hi) {
        const int b = u / 272; int v = u % 272; int qt = 0;
        { int p = 0; while ((p + 1) * (p + 2) <= v) ++p; v -= p * (p + 1); if (v < p + 1) { qt = 2 * p; } else { qt = 2 * p + 1; v -= p + 1; } }
        const int seg0 = v; const int nsq = (qt >> 1) + 1;
        int nseg = nsq - seg0; if (nseg > u_hi - u) nseg = u_hi - u;
        const int q0 = qt * 128;
        const int tq = q0 + 16 * w + r16; const size_t qrow = (size_t)(b * SEQ + tq);
        bf16x8 qf[16][2]; float wv[16];
#pragma unroll
        for (int hh = 0; hh < 16; ++hh) {
#pragma unroll
            for (int ks = 0; ks < 2; ++ks) qf[hh][ks] = *(const GAS bf16x8*)(h1 + qrow * N_CD + H1_IQ + hh * 64 + ks * 32 + 8 * g4);
            wv[hh] = small[qrow * 128 + SM_IW + hh] * 0.25f; }
        const size_t rowbase = (size_t)b * SCORES_PER_BATCH + score_row_off(tq);
        const int rowlen = 64 * ((tq >> 6) + 1);
#pragma unroll 1
        for (int sg = 0; sg < nseg; ++sg) {
            const int s0 = (seg0 + sg) * 256;
            __syncthreads();
#pragma unroll 2
            for (int i = F.tid; i < 256 * 16; i += 512) { const int s = i >> 4, c4 = (i & 15) * 4; const f32x4 kv = *(const f32x4*)(small + (size_t)(b * SEQ + s0 + s) * 128 + SM_IK + c4);
                u32x2 o; o.x = pk2(kv.x, kv.y); o.y = pk2(kv.z, kv.w); *(LAS u32x2*)(KS + s * LDK + c4) = o; }
            __syncthreads();
#pragma unroll 1
            for (int kt = 0; kt < 16; ++kt) {
                if (s0 + 16 * kt > q0 + 16 * w + 15) break;
                const bf16x8 k0 = lds_frag(KS, LDK, 16 * kt, 0, lane), k1 = lds_frag(KS, LDK, 16 * kt, 32, lane);
                f32x4 sc = {0.f, 0.f, 0.f, 0.f};
#pragma unroll
                for (int hh = 0; hh < 16; ++hh) { f32x4 a = {0.f, 0.f, 0.f, 0.f}; a = mfma16(k0, qf[hh][0], a); a = mfma16(k1, qf[hh][1], a);
#pragma unroll
                    for (int j = 0; j < 4; ++j) sc[j] += wv[hh] * fmaxf(a[j], 0.f); }
                const int sk = s0 + 16 * kt + 4 * g4;
                if (sk < rowlen) *(GAS f32x4*)(scores + rowbase + sk) = sc;
            }
        }
        u += nseg;
    }
}

#ifndef PROBE_TOPK_NOHIST
#define PROBE_TOPK_NOHIST 0
#endif
#ifndef PROBE_TOPK_NOEMIT
#define PROBE_TOPK_NOEMIT 0
#endif
template <int NB>
__device__ __forceinline__ void topk_scan(LAS unsigned* hist, int lane, int need, int& bin, int& above, int& cnt) {
    unsigned c[NB]; unsigned tot = 0u;
#pragma unroll
    for (int q = 0; q < NB / 4; ++q) { const u32x4 v = *(const LAS u32x4*)(hist + NB * lane + 4 * q); c[4 * q] = v.x; c[4 * q + 1] = v.y; c[4 * q + 2] = v.z; c[4 * q + 3] = v.w; tot += (v.x + v.y) + (v.z + v.w); }
#pragma unroll
    for (int q = 0; q < NB / 4; ++q) *(LAS u32x4*)(hist + NB * lane + 4 * q) = (u32x4){0u, 0u, 0u, 0u};
    unsigned inc = tot;
#pragma unroll
    for (int o = 1; o < 64; o <<= 1) { const unsigned u = __shfl_down(inc, o); if (lane + o < 64) inc += u; }
    unsigned run = inc - tot; int fb = -1; unsigned fa = 0u, fc = 0u;
#pragma unroll
    for (int jj = NB - 1; jj >= 0; --jj) { const unsigned cj = c[jj]; const bool hit = (run < (unsigned)need) && (run + cj >= (unsigned)need); fb = hit ? jj : fb; fa = hit ? run : fa; fc = hit ? cj : fc; run += cj; }
    const unsigned long long m = __ballot(fb >= 0); const int L = (int)__builtin_ctzll(m);
    bin = __shfl(NB * lane + fb, L); above = (int)__shfl(fa, L); cnt = (int)__shfl(fc, L);
}
__device__ __forceinline__ void topk_keys16(const float* sr, int t, int lane, int c, unsigned (&key)[16]) {
#pragma unroll
    for (int j = 0; j < 16; ++j) { const int i = 16 * c + j; const int s = 64 * i + lane; unsigned k = 0u;
        if (64 * i <= t) { const unsigned bits = __builtin_bit_cast(unsigned, sr[s]); k = (bits & 0x80000000u) ? ~bits : (bits | 0x80000000u); if (s > t) k = 0u; }
        key[j] = k; }
}
__device__ __forceinline__ void topk_row(const float* sr, int t, int lane, LAS unsigned* hist, unsigned short* out) {
    const int nchunk = (t >> 10) + 1;
    int bin, above, cnt; unsigned tau; int need_eq = 0x7fffffff;
#if PROBE_TOPK_NOHIST
    tau = 0xC0000000u; if (false) {
#endif
#pragma unroll 1
    for (int c = 0; c < nchunk; ++c) { unsigned key[16]; topk_keys16(sr, t, lane, c, key);
#pragma unroll
        for (int j = 0; j < 16; ++j) __hip_atomic_fetch_add(hist + (key[j] >> 21), 1u, __ATOMIC_RELAXED, __HIP_MEMORY_SCOPE_WORKGROUP); }
    topk_scan<32>(hist, lane, 256, bin, above, cnt);
    tau = (unsigned)bin << 21; int need = 256 - above;
    if (need != cnt) {
        const unsigned p1 = (unsigned)bin;
#pragma unroll 1
        for (int c = 0; c < nchunk; ++c) { unsigned key[16]; topk_keys16(sr, t, lane, c, key);
#pragma unroll
            for (int j = 0; j < 16; ++j) if ((key[j] >> 21) == p1) __hip_atomic_fetch_add(hist + ((key[j] >> 10) & 2047u), 1u, __ATOMIC_RELAXED, __HIP_MEMORY_SCOPE_WORKGROUP); }
        topk_scan<32>(hist, lane, need, bin, above, cnt);
        tau |= (unsigned)bin << 10; need -= above;
        if (need != cnt) {
            const unsigned p2 = tau >> 10;
#pragma unroll 1
            for (int c = 0; c < nchunk; ++c) { unsigned key[16]; topk_keys16(sr, t, lane, c, key);
#pragma unroll
                for (int j = 0; j < 16; ++j) if ((key[j] >> 10) == p2) __hip_atomic_fetch_add(hist + (key[j] & 1023u), 1u, __ATOMIC_RELAXED, __HIP_MEMORY_SCOPE_WORKGROUP); }
            topk_scan<16>(hist, lane, need, bin, above, cnt);
            tau |= (unsigned)bin; need_eq = need - above;
        }
    }
#if PROBE_TOPK_NOHIST
    }
#endif
    int pos = 0, eqseen = 0;
    if (PROBE_TOPK_NOEMIT) return;
    const unsigned long long lt_mask = (1ull << lane) - 1ull;
#pragma unroll 1
    for (int c = 0; c < nchunk; ++c) { unsigned key[16]; topk_keys16(sr, t, lane, c, key);
#pragma unroll
        for (int j = 0; j < 16; ++j) {
            const bool gt = key[j] > tau, eq = key[j] == tau;
            const unsigned long long meq = __ballot(eq);
            const bool take = gt || (eq && (eqseen + __builtin_popcountll(meq & lt_mask) < need_eq));
            const unsigned long long mt = __ballot(take);
            if (take && (!PROBE_TOPK_NOHIST || pos + __builtin_popcountll(mt & lt_mask) < 256)) out[pos + __builtin_popcountll(mt & lt_mask)] = (unsigned short)(64 * (16 * c + j) + lane);
            pos += __builtin_popcountll(mt); eqseen += __builtin_popcountll(meq);
        } }
}
__device__ __forceinline__ bool topk_row_fast(const float* sr, int t, int lane, LAS unsigned* hist, LAS unsigned* memb, unsigned short* out) {
    const int nchunk = (t >> 10) + 1;
    float v[64];
#pragma unroll
    for (int c = 0; c < 4; ++c) {
        if (c < nchunk) {
#pragma unroll
            for (int j = 0; j < 16; ++j) { const int i = 16 * c + j; float x = -INFINITY; if (64 * i <= t) x = sr[64 * i + lane]; v[i] = x; }
        } else {
#pragma unroll
            for (int j = 0; j < 16; ++j) v[16 * c + j] = -INFINITY;
        }
    }
    float lo = v[0], hi = v[0];
#pragma unroll
    for (int o = 1; o < 64; o <<= 1) { lo = fminf(lo, __shfl_xor(lo, o)); hi = fmaxf(hi, __shfl_xor(hi, o)); }
    const float dd = hi - lo; lo -= 0.75f * dd; hi += 0.75f * dd;
    const float inv = (hi > lo) ? 2047.5f / (hi - lo) : 0.f;
#define TOPK_BIN(x, s) (((s) <= t) ? (int)fminf(fmaxf(((x) - lo) * inv, 0.f), 2047.f) : -1)
#pragma unroll
    for (int c = 0; c < 4; ++c) if (c < nchunk) {
#pragma unroll
        for (int j = 0; j < 16; ++j) { const int i = 16 * c + j; const int b = TOPK_BIN(v[i], 64 * i + lane); if (b >= 0) __hip_atomic_fetch_add(hist + b, 1u, __ATOMIC_RELAXED, __HIP_MEMORY_SCOPE_WORKGROUP); }
    }
    int B, above, cnt;
    topk_scan<32>(hist, lane, 256, B, above, cnt);
    if (cnt > 64) return false;
    const int need2 = 256 - above;
    const unsigned long long lt_mask = (1ull << lane) - 1ull;
    int pos = 0, nm = 0;
#pragma unroll
    for (int c = 0; c < 4; ++c) if (c < nchunk) {
#pragma unroll
        for (int j = 0; j < 16; ++j) { const int i = 16 * c + j; const int s = 64 * i + lane; const int b = TOPK_BIN(v[i], s);
            const unsigned long long mg = __ballot(b > B);
            if (b > B) out[pos + __builtin_popcountll(mg & lt_mask)] = (unsigned short)s;
            pos += __builtin_popcountll(mg);
            const unsigned long long me = __ballot(b == B);
            if (me != 0ull) { if (b == B) { const int slot = nm + __builtin_popcountll(me & lt_mask); const unsigned bits = __builtin_bit_cast(unsigned, v[i]);
                    memb[slot] = (bits & 0x80000000u) ? ~bits : (bits | 0x80000000u); memb[64 + slot] = (unsigned)s; }
                nm += __builtin_popcountll(me); }
        }
    }
#undef TOPK_BIN
    const unsigned mk = (lane < nm) ? memb[lane] : 0u, mi = (lane < nm) ? memb[64 + lane] : 0xffffffffu;
    int rank = 0;
    for (int q = 0; q < nm; ++q) { const unsigned kq = __builtin_amdgcn_readlane(mk, q), iq = __builtin_amdgcn_readlane(mi, q); rank += (kq > mk || (kq == mk && iq < mi)) ? 1 : 0; }
    if (lane < nm && rank < need2) out[above + rank] = (unsigned short)mi;
    return true;
}
__device__ __forceinline__ void dsa_topk(const Args& args, Frame& F) {
    unsigned char* ws = args.ws; const float* scores = (const float*)(ws + WS_R2); unsigned short* idx = (unsigned short*)(ws + WS_IDX);
    const int lane = F.lane; const int gw = F.bid * 8 + F.wave, NGW = F.G * 8;
    LAS unsigned* hist = (LAS unsigned*)(F.lds + F.wave * 8192);
    LAS unsigned* memb = (LAS unsigned*)(F.lds + 65536 + F.wave * 512);
    __syncthreads();
    for (int i = lane; i < 2048; i += 64) hist[i] = 0u;
    for (int rr = gw; rr < T; rr += NGW) {
        const int b = rr >> 12, jj = rr & 4095; const int t = (jj & 1) ? 4095 - (jj >> 1) : (jj >> 1); const int row = b * SEQ + t;
        unsigned short* out = idx + (size_t)row * 256;
        if (t < 256) {
#pragma unroll
            for (int i = 0; i < 4; ++i) { const int s = 64 * i + lane; out[s] = (unsigned short)(s <= t ? s : 0); }
            continue;
        }
        const float* sr = scores + (size_t)b * SCORES_PER_BATCH + score_row_off(t);
        if (!topk_row_fast(sr, t, lane, hist, memb, out)) topk_row(sr, t, lane, hist, out);
    }
}

#ifndef PROBE_ONETILE
#define PROBE_ONETILE 0
#endif
#ifndef PROBE_NOSTORE
#define PROBE_NOSTORE 0
#endif
#ifndef PROBE_NOGATHER
#define PROBE_NOGATHER 0
#endif
__device__ __forceinline__ void pl16(float& a, float& b) { asm volatile("s_nop 1\n\tv_permlane16_swap_b32 %0, %1" : "+v"(a), "+v"(b)); }
__device__ __forceinline__ void pl32(float& a, float& b) { asm volatile("s_nop 1\n\tv_permlane32_swap_b32 %0, %1" : "+v"(a), "+v"(b)); }
__device__ __forceinline__ float xmax16(float x) { float a = x, b = x; pl16(a, b); return fmaxf(a, b); }
__device__ __forceinline__ float xmax32(float x) { float a = x, b = x; pl32(a, b); return fmaxf(a, b); }
__device__ __forceinline__ float xadd16(float x) { float a = x, b = x; pl16(a, b); return a + b; }
__device__ __forceinline__ float xadd32(float x) { float a = x, b = x; pl32(a, b); return a + b; }
__device__ __forceinline__ s16x4 lds_tr(const LAS bf16* p) { return __builtin_bit_cast(s16x4, __builtin_amdgcn_ds_read_tr16_b64_v4i16((LAS s16x4*)p)); }
__device__ __forceinline__ void dsa_attention(const Args& args, Frame& F, bf16* obuf) {
    unsigned char* ws = args.ws; const bf16* ckvn = (const bf16*)(ws + WS_CKVN); bf16* qo = (bf16*)args.out; const unsigned short* idx = (const unsigned short*)(ws + WS_IDX);
    const int lane = F.lane, w = F.wave, r16 = lane & 15, g4 = lane >> 4;
    constexpr int LDV = 264;
    LAS bf16* KV = (LAS bf16*)(F.lds + w * (32 * LDV * 2));
    LAS float* rel = (LAS float*)(F.lds + 8 * 32 * LDV * 2);
    LAS unsigned char* bkt = (LAS unsigned char*)(F.lds + 8 * 32 * LDV * 2 + 1024);
    LAS unsigned char* bkey = (LAS unsigned char*)(F.lds + 8 * 32 * LDV * 2 + 1024 + 128 + w * 256);
    __syncthreads();
    if (F.tid < 256) rel[F.tid] = args.in[I_REL][F.tid];
    if (F.tid < 128) { const int n = F.tid; int bk = n; if (n >= 16) { int lg = 16 + (int)(__logf((float)n / 16.0f) / 2.0794415416798357f * 16.0f); bk = lg < 31 ? lg : 31; } bkt[n] = (unsigned char)bk; }
    __syncthreads();
    const bool g8 = (F.G & 7) == 0 && F.G >= 8;
    const int nwb = g8 ? (F.G / 8) * 2 * 8 : F.G * 8;
    const int wib = g8 ? ((F.bid >> 3) * 2 + (F.bid & 1)) * 8 + w : F.bid * 8 + w;
    const int bsel = g8 ? ((F.bid & 7) >> 1) : -1;
    const int nrows = g8 ? SEQ : T;
    const LAS bf16* tr_lo = KV + (4 * g4 + (r16 >> 2)) * LDV + 4 * (r16 & 3);
    const LAS bf16* tr_hi = tr_lo + 16 * LDV;
    for (int rr0 = wib; rr0 < nrows; rr0 += nwb) {
        const int b = g8 ? bsel : (rr0 >> 12); const int jj = rr0 & 4095; const int t = (jj & 1) ? 4095 - (jj >> 1) : (jj >> 1); const int row = b * SEQ + t;
        const int nsel = t < 255 ? t + 1 : 256;
        int myidx[4];
#pragma unroll
        for (int i = 0; i < 4; ++i) myidx[i] = idx[(size_t)row * 256 + 64 * i + lane];
#pragma unroll
        for (int i = 0; i < 4; ++i) { int dist = t - myidx[i]; dist = dist < 0 ? 0 : dist; bkey[64 * i + lane] = (dist < 128) ? bkt[dist] : (unsigned char)31; }
        bf16x8 qf[8];
#pragma unroll
        for (int ks = 0; ks < 8; ++ks) qf[ks] = *(const GAS bf16x8*)(qo + (size_t)row * D + (r16 & 7) * 256 + 32 * ks + 8 * g4);
        f32x4 o[16];
#pragma unroll
        for (int i = 0; i < 16; ++i) o[i] = (f32x4){0.f, 0.f, 0.f, 0.f};
        float mrun = -3.0e38f, lrun = 0.f;
        const int ntile = PROBE_ONETILE ? 1 : ((nsel + 31) >> 5);
        const bf16* kvb = ckvn + (size_t)(b * SEQ) * 256 + 8 * (lane & 31);
        u32x4 G[16];
        {
#pragma unroll
            for (int i = 0; i < 16; ++i) { const int kidx = __shfl(myidx[0], 2 * i + (lane >> 5)); G[i] = *(const GAS u32x4*)(kvb + (size_t)(PROBE_NOGATHER ? (kidx & 31) : kidx) * 256); } }
#pragma unroll 1
        for (int kt = 0; kt < ntile; ++kt) {
            const int src = (kt & 1) * 32;
            const int ireg = (kt >> 1) == 0 ? myidx[0] : (kt >> 1) == 1 ? myidx[1] : (kt >> 1) == 2 ? myidx[2] : myidx[3];
#pragma unroll
            for (int i = 0; i < 16; ++i) *(LAS u32x4*)(KV + (2 * i + (lane >> 5)) * LDV + 8 * (lane & 31)) = G[i];
            if (kt + 1 < ntile) {
                const int src2 = ((kt + 1) & 1) * 32;
                const int ireg2 = ((kt + 1) >> 1) == 0 ? myidx[0] : ((kt + 1) >> 1) == 1 ? myidx[1] : ((kt + 1) >> 1) == 2 ? myidx[2] : myidx[3];
#pragma unroll
                for (int i = 0; i < 16; ++i) { const int kidx = __shfl(ireg2, src2 + 2 * i + (lane >> 5)); G[i] = *(const GAS u32x4*)(kvb + (size_t)(PROBE_NOGATHER ? (kidx & 31) : kidx) * 256); }
            }
            f32x4 s0 = {0.f, 0.f, 0.f, 0.f}, s1 = {0.f, 0.f, 0.f, 0.f};
#pragma unroll
            for (int ks = 0; ks < 8; ++ks) { s0 = mfma16(lds_frag(KV, LDV, 0, 32 * ks, lane), qf[ks], s0); s1 = mfma16(lds_frag(KV, LDV, 16, 32 * ks, lane), qf[ks], s1); }
            float lg[8];
#pragma unroll
            for (int j = 0; j < 8; ++j) { const int kl = (j < 4 ? 4 * g4 + j : 16 + 4 * g4 + (j - 4)); const int kk = 32 * kt + kl; const int bk = (int)bkey[kk];
                const float v = (j < 4 ? s0[j] : s1[j - 4]) + rel[bk * 8 + (r16 & 7)];
                lg[j] = (kk < nsel) ? v : -3.0e38f; }
            float mx = lg[0];
#pragma unroll
            for (int j = 1; j < 8; ++j) mx = fmaxf(mx, lg[j]);
            mx = xmax16(mx); mx = xmax32(mx);
            const bool grow = mx > mrun;
            const float mnew = grow ? mx : mrun; const float corr = grow ? __expf(mrun - mnew) : 1.0f;
            float p[8], ps = 0.f;
#pragma unroll
            for (int j = 0; j < 8; ++j) { p[j] = (lg[j] > -1.0e38f) ? __expf(lg[j] - mnew) : 0.f; ps += p[j]; }
            ps = xadd16(ps); ps = xadd32(ps);
            lrun = lrun * corr + ps; mrun = mnew;
            bf16x8 pf; { u32x4 pw; pw.x = pk2(p[0], p[1]); pw.y = pk2(p[2], p[3]); pw.z = pk2(p[4], p[5]); pw.w = pk2(p[6], p[7]); pf = __builtin_bit_cast(bf16x8, pw); }
            if (__any(grow)) {
                float cr[4];
#pragma unroll
                for (int j = 0; j < 4; ++j) cr[j] = __shfl(corr, (4 * g4 + j) & 7);
#pragma unroll
                for (int nt = 0; nt < 16; ++nt)
#pragma unroll
                    for (int j = 0; j < 4; ++j) o[nt][j] *= cr[j];
            }
#pragma unroll
            for (int nt = 0; nt < 16; ++nt) {
                const s16x4 lo = lds_tr(tr_lo + 16 * nt), hi = lds_tr(tr_hi + 16 * nt);
                bf16x8 vf; vf[0] = lo[0]; vf[1] = lo[1]; vf[2] = lo[2]; vf[3] = lo[3]; vf[4] = hi[0]; vf[5] = hi[1]; vf[6] = hi[2]; vf[7] = hi[3];
                o[nt] = mfma16(pf, vf, o[nt]);
            }
        }
        float linv[4];
#pragma unroll
        for (int j = 0; j < 4; ++j) linv[j] = 1.0f / __shfl(lrun, (4 * g4 + j) & 7);
        if (g4 < 2 && !PROBE_NOSTORE) {
#pragma unroll
            for (int nt = 0; nt < 16; ++nt)
#pragma unroll
                for (int j = 0; j < 4; ++j) obuf[(size_t)row * D + (4 * g4 + j) * 256 + 16 * nt + r16] = (bf16)f2bf(o[nt][j] * linv[j]);
        }
    }
}
__device__ __forceinline__ float ml_wave_incl_scan_add(float v, int lane) {
#pragma unroll
    for (int o = 1; o < 64; o <<= 1) { const float u = __shfl_up(v, o); if (lane >= o) v += u; }
    return v;
}
__device__ __forceinline__ float ml_wave_incl_scan_max(float v, int lane) {
#pragma unroll
    for (int o = 1; o < 64; o <<= 1) { const float u = __shfl_up(v, o); if (lane >= o) v = fmaxf(v, u); }
    return v;
}
constexpr size_t ML_A = 0, ML_BL = 4096, ML_MP = 8192;

__device__ __forceinline__ void ml_conv16(const bf16* h1, int b, int s0, int col, const float (&w4)[4], float (&out)[16]) {
    float x[19];
#pragma unroll
    for (int i = 0; i < 19; ++i) { const int s = s0 - 3 + i; x[i] = (s >= 0) ? bf2f(h1[(size_t)(b * SEQ + s) * N_CD + col]) : 0.f; }
#pragma unroll
    for (int i = 0; i < 16; ++i) { const float c = w4[0] * x[i] + w4[1] * x[i + 1] + w4[2] * x[i + 2] + w4[3] * x[i + 3]; out[i] = siluf_(c); }
}

__device__ __forceinline__ void ml_a_unit(const Args& args, Frame& F, int b, int n, int h) {
    unsigned char* ws = args.ws; const bf16* h1 = (const bf16*)(ws + WS_R1); const float* small = (const float*)(ws + WS_SMALL);
    const int t0 = b * SEQ + n * 64, tid = F.tid, lane = F.lane, w = F.wave;
    LAS bf16* KT = (LAS bf16*)F.lds;
    LAS bf16* VT = (LAS bf16*)(F.lds + 18432);
    LAS float* part = (LAS float*)(F.lds + 55296);
    LAS float* uu = (LAS float*)(F.lds + 57344);
    const float* gb = args.in[I_GATEB];
    if (w == 0) {
        const float ig = small[(size_t)(t0 + lane) * 128 + SM_DI + h] + gb[h];
        const float lf = log_sigmoid_(small[(size_t)(t0 + lane) * 128 + SM_DF + h] + gb[4 + h]);
        const float bc = ml_wave_incl_scan_add(lf, lane); const float bl = __shfl(bc, 63);
        const float lu = bl - bc + ig; const float a = wave_max(lu);
        uu[lane] = __expf(lu - a);
        if (lane == 0) { float* sc = (float*)(ws + WS_MLSC); const int si = (b * NCH + n) * 4 + h; sc[ML_A / 4 + si] = a; sc[ML_BL / 4 + si] = bl; }
    }
    stage_vt<256>(VT, h1 + (size_t)t0 * N_CD + H1_DV + h * 256, N_CD, tid);
    __syncthreads();
    const int d = tid & 127, tq = tid >> 7;
    { const float* cw = args.in[I_CONVW]; const int ch = 512 + h * 128 + d; float w4[4];
#pragma unroll
        for (int j = 0; j < 4; ++j) w4[j] = cw[j * 1024 + ch];
        float kc[16]; ml_conv16(h1, b, n * 64 + 16 * tq, H1_DK + h * 128 + d, w4, kc);
        float loc = 0.f; unsigned wv[8];
#pragma unroll
        for (int i = 0; i < 16; i += 2) { const float k0 = kc[i] * 0.08838834764831845f * uu[16 * tq + i], k1 = kc[i + 1] * 0.08838834764831845f * uu[16 * tq + i + 1]; loc += k0 + k1; wv[i >> 1] = pk2(k0, k1); }
        u32x4 o0, o1; o0.x = wv[0]; o0.y = wv[1]; o0.z = wv[2]; o0.w = wv[3]; o1.x = wv[4]; o1.y = wv[5]; o1.z = wv[6]; o1.w = wv[7];
        *(LAS u32x4*)(KT + d * LDK + 16 * tq) = o0; *(LAS u32x4*)(KT + d * LDK + 16 * tq + 8) = o1;
        part[tq * 128 + d] = loc; }
    __syncthreads();
    if (tid < 128) { float* nl = (float*)(ws + WS_MLN); nl[(size_t)((b * NCH + n) * 4 + h) * 128 + tid] = part[tid] + part[128 + tid] + part[256 + tid] + part[384 + tid]; }
    bf16* U = (bf16*)(ws + WS_R2) + (size_t)((b * NCH + n) * 4 + h) * 256 * 128;
    const bf16x8 a0 = lds_frag(KT, LDK, 16 * w, 0, lane), a1 = lds_frag(KT, LDK, 16 * w, 32, lane);
#pragma unroll 4
    for (int et = 0; et < 16; ++et) {
        f32x4 acc = {0.f, 0.f, 0.f, 0.f};
        acc = mfma16(a0, lds_frag(VT, LDK, 16 * et, 0, lane), acc);
        acc = mfma16(a1, lds_frag(VT, LDK, 16 * et, 32, lane), acc);
        u32x2 o; o.x = pk2(acc[0], acc[1]); o.y = pk2(acc[2], acc[3]);
        *(GAS u32x2*)(U + (size_t)(16 * et + (lane & 15)) * 128 + 16 * w + 4 * (lane >> 4)) = o;
    }
    __syncthreads();
}

__device__ __forceinline__ void ml_scan(const Args& args, Frame& F) {
    unsigned char* ws = args.ws; float* sc = (float*)(ws + WS_MLSC);
    const int NTC = BATCH * 4 * 256 * 16, NTN = BATCH * 4 * 128;
    for (int gt = 64 * (F.wave * F.G + F.bid) + F.lane; gt < NTC + NTN; gt += F.G * 512) {
        if (gt < NTC) {
            const int d8 = gt & 15, e = (gt >> 4) & 255, h = (gt >> 12) & 3, b = gt >> 14;
            bf16* S = (bf16*)args.out + (size_t)33554432;
            float st[8]; float m = 0.f;
#pragma unroll
            for (int j = 0; j < 8; ++j) st[j] = 0.f;
#pragma unroll 4
            for (int n = 0; n < NCH; ++n) { const int si = (b * NCH + n) * 4 + h;
                GAS u32x4* p = (GAS u32x4*)(S + ((size_t)si * 256 + e) * 128 + 8 * d8);
                const u32x4 u = *p; const float a = sc[ML_A / 4 + si], bl = sc[ML_BL / 4 + si];
                u32x4 o; o.x = pk2(st[0], st[1]); o.y = pk2(st[2], st[3]); o.z = pk2(st[4], st[5]); o.w = pk2(st[6], st[7]);
                *p = o;
                const float mn = fmaxf(bl + m, a); const float dec = __expf(bl + m - mn), inw = __expf(a - mn); m = mn;
                st[0] = dec * st[0] + inw * bflo(u.x); st[1] = dec * st[1] + inw * bfhi(u.x); st[2] = dec * st[2] + inw * bflo(u.y); st[3] = dec * st[3] + inw * bfhi(u.y);
                st[4] = dec * st[4] + inw * bflo(u.z); st[5] = dec * st[5] + inw * bfhi(u.z); st[6] = dec * st[6] + inw * bflo(u.w); st[7] = dec * st[7] + inw * bfhi(u.w);
            }
        } else {
            const int r = gt - NTC; const int d = r & 127, h = (r >> 7) & 3, b = r >> 9;
            float* nl = (float*)(ws + WS_MLN); float st = 0.f, m = 0.f;
            for (int n = 0; n < NCH; ++n) { const int si = (b * NCH + n) * 4 + h;
                const float u = nl[(size_t)si * 128 + d]; const float a = sc[ML_A / 4 + si], bl = sc[ML_BL / 4 + si];
                nl[(size_t)si * 128 + d] = st; if (d == 0) sc[ML_MP / 4 + si] = m;
                const float mn = fmaxf(bl + m, a); st = __expf(bl + m - mn) * st + __expf(a - mn) * u; m = mn; }
        }
    }
}

__device__ __forceinline__ void ml_c_unit(const Args& args, Frame& F, int b, int n, int h) {
    unsigned char* ws = args.ws; const bf16* h1 = (const bf16*)(ws + WS_R1); const float* small = (const float*)(ws + WS_SMALL);
    const int t0 = b * SEQ + n * 64, tid = F.tid, lane = F.lane, w = F.wave, r16 = lane & 15, g4 = lane >> 4;
    LAS bf16* Qs = (LAS bf16*)F.lds;
    LAS bf16* Ks = (LAS bf16*)(F.lds + 17408);
    LAS bf16* P = (LAS bf16*)(F.lds + 34816);
    LAS bf16* VT = (LAS bf16*)(F.lds + 44032);
    LAS bf16* NT = (LAS bf16*)(F.lds + 80896);
    LAS float* red = (LAS float*)(F.lds + 85248);
    LAS float* bcs = (LAS float*)(F.lds + 85760);
    LAS float* igs = (LAS float*)(F.lds + 86016);
    LAS float* mts = (LAS float*)(F.lds + 86272);
    LAS float* psum = (LAS float*)(F.lds + 86528);
    const float* gb = args.in[I_GATEB];
    const int si = (b * NCH + n) * 4 + h;
    const float mprev = ((const float*)(ws + WS_MLSC))[ML_MP / 4 + si];
    if (w == 0) {
        const float ig = small[(size_t)(t0 + lane) * 128 + SM_DI + h] + gb[h];
        const float lf = log_sigmoid_(small[(size_t)(t0 + lane) * 128 + SM_DF + h] + gb[4 + h]);
        const float bc = ml_wave_incl_scan_add(lf, lane);
        const float gmb = ig - bc;
        const float pm = ml_wave_incl_scan_max(gmb, lane);
        bcs[lane] = bc; igs[lane] = gmb; mts[lane] = bc + fmaxf(pm, mprev);
    }
    if (w == 1) { const float* nl = (const float*)(ws + WS_MLN);
        for (int i = lane; i < 16 * LDQ; i += 64) { const int rr = i / LDQ, cc = i % LDQ; NT[i] = (bf16)((rr == 0 && cc < 128) ? f2bf(nl[(size_t)si * 128 + cc]) : 0u); } }
    stage_vt<256>(VT, h1 + (size_t)t0 * N_CD + H1_DV + h * 256, N_CD, tid);
    { const int d = tid & 127, tq = tid >> 7; const float* cw = args.in[I_CONVW]; float w4[4]; float qc[16];
#pragma unroll
        for (int j = 0; j < 4; ++j) w4[j] = cw[j * 1024 + h * 128 + d];
        ml_conv16(h1, b, n * 64 + 16 * tq, H1_DQ + h * 128 + d, w4, qc);
#pragma unroll
        for (int i = 0; i < 16; ++i) Qs[(16 * tq + i) * LDQ + d] = (bf16)f2bf(qc[i]);
#pragma unroll
        for (int j = 0; j < 4; ++j) w4[j] = cw[j * 1024 + 512 + h * 128 + d];
        ml_conv16(h1, b, n * 64 + 16 * tq, H1_DK + h * 128 + d, w4, qc);
#pragma unroll
        for (int i = 0; i < 16; ++i) Ks[(16 * tq + i) * LDQ + d] = (bf16)f2bf(qc[i] * 0.08838834764831845f); }
    __syncthreads();
    { const int mi = w >> 1; float rs[4] = {0.f, 0.f, 0.f, 0.f};
#pragma unroll
        for (int q = 0; q < 2; ++q) { const int ni = 2 * (w & 1) + q; f32x4 acc = {0.f, 0.f, 0.f, 0.f};
            if (ni <= mi) {
#pragma unroll
                for (int ks = 0; ks < 4; ++ks) acc = mfma16(lds_frag(Qs, LDQ, 16 * mi, 32 * ks, lane), lds_frag(Ks, LDQ, 16 * ni, 32 * ks, lane), acc); }
            const int s = 16 * ni + r16; const float gs = igs[s];
#pragma unroll
            for (int j = 0; j < 4; ++j) { const int t = 16 * mi + 4 * g4 + j; float v = 0.f;
                if (ni <= mi && s <= t) v = acc[j] * __expf(bcs[t] + gs - mts[t]);
                const unsigned vb = f2bf(v); P[t * LDK + s] = (bf16)vb; rs[j] += v; } }
#pragma unroll
        for (int j = 0; j < 4; ++j) { float s = rs[j]; s += __shfl_xor(s, 1); s += __shfl_xor(s, 2); s += __shfl_xor(s, 4); s += __shfl_xor(s, 8); if (r16 == 0) psum[(w & 1) * 64 + 16 * mi + 4 * g4 + j] = s; } }
    __syncthreads();
    const int mi = w & 3, e0 = (w >> 2) * 128;
    const bf16* C = (const bf16*)(ws + WS_R2) + (size_t)si * 256 * 128;
    f32x4 acc1[8], acc2[8]; f32x4 accn = {0.f, 0.f, 0.f, 0.f};
    { const bf16x8 p0 = lds_frag(P, LDK, 16 * mi, 0, lane), p1 = lds_frag(P, LDK, 16 * mi, 32, lane);
        bf16x8 qf[4];
#pragma unroll
        for (int ks = 0; ks < 4; ++ks) qf[ks] = lds_frag(Qs, LDQ, 16 * mi, 32 * ks, lane);
#pragma unroll
        for (int ks = 0; ks < 4; ++ks) accn = mfma16(qf[ks], lds_frag(NT, LDQ, 0, 32 * ks, lane), accn);
#pragma unroll
        for (int i = 0; i < 8; ++i) { const int et0 = e0 + 16 * i; f32x4 a = {0.f, 0.f, 0.f, 0.f}, c = {0.f, 0.f, 0.f, 0.f};
            a = mfma16(p0, lds_frag(VT, LDK, et0, 0, lane), a); a = mfma16(p1, lds_frag(VT, LDK, et0, 32, lane), a);
            if (n > 0) {
#pragma unroll
                for (int ks = 0; ks < 4; ++ks) { const bf16x8 sf = *(const GAS bf16x8*)(C + (size_t)(et0 + r16) * 128 + 32 * ks + 8 * g4); c = mfma16(qf[ks], sf, c); } }
            acc1[i] = a; acc2[i] = c; } }
    float hv[8][4]; float ss[4];
#pragma unroll
    for (int j = 0; j < 4; ++j) { const int t = 16 * mi + 4 * g4 + j;
        const float mt = mts[t]; const float wi = __expf(bcs[t] + mprev - mt);
        const float qn_inter = __shfl(accn[j], 16 * g4);
        const float qn = psum[t] + psum[64 + t] + wi * qn_inter;
        const float den = fmaxf(fabsf(qn), __expf(-mt)); const float inv = 1.0f / den; float s = 0.f;
#pragma unroll
        for (int i = 0; i < 8; ++i) { const float v = (acc1[i][j] + wi * acc2[i][j]) * inv; hv[i][j] = v; s += v * v; }
        s += __shfl_xor(s, 1); s += __shfl_xor(s, 2); s += __shfl_xor(s, 4); s += __shfl_xor(s, 8); ss[j] = s; }
    if (r16 == 0) {
#pragma unroll
        for (int j = 0; j < 4; ++j) red[w * 16 + 4 * g4 + j] = ss[j]; }
    __syncthreads();
    const float* gn = args.in[I_DNORM]; bf16* mixed = (bf16*)(ws + WS_MIX);
#pragma unroll
    for (int j = 0; j < 4; ++j) { const float tot = red[w * 16 + 4 * g4 + j] + red[(w ^ 4) * 16 + 4 * g4 + j]; const float rstd = 1.0f / sqrtf(tot * (1.0f / 256.f) + EPS);
        const size_t row = (size_t)(t0 + 16 * mi + 4 * g4 + j);
#pragma unroll
        for (int i = 0; i < 8; ++i) { const int e = e0 + 16 * i + r16; const float gate = bf2f(h1[row * N_CD + H1_DOG + h * 256 + e]);
            mixed[row * D + 1024 + h * 256 + e] = (bf16)f2bf(hv[i][j] * rstd * gn[e] * gate); } }
    __syncthreads();
}
__device__ __forceinline__ void ml_phase_a(const Args& args, Frame& F) { for (int u = F.bid; u < 1024; u += F.G) { const int h = u & 3, n = (u >> 2) & 63, b = u >> 8; ml_a_unit(args, F, b, n, h); } }
__device__ __forceinline__ void ml_phase_c(const Args& args, Frame& F) { for (int u = F.bid; u < 1024; u += F.G) { const int h = u & 3, n = (u >> 2) & 63, b = u >> 8; ml_c_unit(args, F, b, n, h); } }
__device__ __forceinline__ void ml_load_raw(const Args& args, int u, int tid, bool need_q, u32x4 (&R)[6]) {
    const int h = u & 3, n = (u >> 2) & 63, b = u >> 8;
    const bf16* h1 = (const bf16*)(args.ws + WS_R1); const size_t t0 = (size_t)(b * SEQ + n * 64);
#pragma unroll
    for (int i = 0; i < 2; ++i) { const int cid = tid + 512 * i, row = cid >> 4, ch = cid & 15; const bf16* hrow = h1 + (t0 + row) * N_CD + h * 128 + ch * 8;
        if (need_q) R[i] = *(const GAS u32x4*)(hrow + H1_DQ); R[2 + i] = *(const GAS u32x4*)(hrow + H1_DK); }
    R[4] = (u32x4){0u, 0u, 0u, 0u}; R[5] = (u32x4){0u, 0u, 0u, 0u};
    if (tid < 48 && n > 0) { const int row = tid >> 4, ch = tid & 15; const bf16* hrow = h1 + (t0 - 3 + row) * N_CD + h * 128 + ch * 8;
        if (need_q) R[4] = *(const GAS u32x4*)(hrow + H1_DQ); R[5] = *(const GAS u32x4*)(hrow + H1_DK); }
}
__device__ __forceinline__ void ml_store_raw(LAS unsigned char* Q, LAS unsigned char* K, LAS unsigned char* HQ, LAS unsigned char* HK, int tid, bool need_q, const u32x4 (&R)[6]) {
#pragma unroll
    for (int i = 0; i < 2; ++i) { const int cid = tid + 512 * i, row = cid >> 4, ch = cid & 15; const int off = row * 256 + (((ch ^ row) & 15) << 4);
        if (need_q) *(LAS u32x4*)(Q + off) = R[i]; *(LAS u32x4*)(K + off) = R[2 + i]; }
    if (tid < 48) { if (need_q) *(LAS u32x4*)(HQ + tid * 16) = R[4]; *(LAS u32x4*)(HK + tid * 16) = R[5]; }
}
__device__ __forceinline__ void ml_conv16_lds(const LAS unsigned char* X, const LAS unsigned char* HX, int tq, int d, const float (&w4)[4], float (&out)[16]) {
    float x[19];
#pragma unroll
    for (int i = 0; i < 19; ++i) { const int r = 16 * tq - 3 + i; x[i] = (r >= 0) ? bf2f(*(const LAS bf16*)(X + swz128(r, d))) : bf2f(*(const LAS bf16*)(HX + ((r + 3) * 128 + d) * 2)); }
#pragma unroll
    for (int i = 0; i < 16; ++i) { const float c = w4[0] * x[i] + w4[1] * x[i + 1] + w4[2] * x[i + 2] + w4[3] * x[i + 3]; out[i] = siluf_(c); }
}
constexpr int M2_Q = 0, M2_K = 16384, M2_P = 32768, M2_V0 = 41984, M2_V1 = 58368, M2_S0 = 74752, M2_S1 = 107520, M2_NT = 140288, M2_HQ = 140544, M2_HK = 141312,
              M2_BCS = 142080, M2_IGS = 142336, M2_MTS = 142592, M2_RED = 142848, M2_PSUM = 143360;
static_assert(M2_NT + 4096 <= LDS_BYTES - 1024 && M2_PSUM + 512 <= LDS_BYTES - 1024, "mlstm (c) LDS map");

__device__ __forceinline__ void ml_c_unit2(const Args& args, Frame& F, int b, int n, int h) {
    unsigned char* ws = args.ws; const bf16* h1 = (const bf16*)(ws + WS_R1); const float* small = (const float*)(ws + WS_SMALL);
    const int t0 = b * SEQ + n * 64, tid = F.tid, lane = F.lane, w = F.wave, r16 = lane & 15, g4 = lane >> 4;
    LAS unsigned char* Q = F.lds + M2_Q; LAS unsigned char* K = F.lds + M2_K; LAS bf16* P = (LAS bf16*)(F.lds + M2_P);
    LAS unsigned char* V0 = F.lds + M2_V0; LAS unsigned char* V1 = F.lds + M2_V1; LAS unsigned char* S0 = F.lds + M2_S0; LAS unsigned char* S1 = F.lds + M2_S1;
    LAS unsigned char* NT = F.lds + M2_NT; LAS unsigned char* HQ = F.lds + M2_HQ; LAS unsigned char* HK = F.lds + M2_HK;
    LAS float* bcs = (LAS float*)(F.lds + M2_BCS); LAS float* igs = (LAS float*)(F.lds + M2_IGS); LAS float* mts = (LAS float*)(F.lds + M2_MTS);
    LAS float* red = (LAS float*)(F.lds + M2_RED); LAS float* psum = (LAS float*)(F.lds + M2_PSUM);
    const float* gb = args.in[I_GATEB];
    const int si = (b * NCH + n) * 4 + h;
    const float mprev = ((const float*)(ws + WS_MLSC))[ML_MP / 4 + si];
    const bf16* Cg = (const bf16*)args.out + (size_t)33554432 + (size_t)si * 256 * 128;
    const bf16* Vg = h1 + (size_t)t0 * N_CD + H1_DV + h * 256;
    dma_tile128(V0, Vg, N_CD, 64, w, lane); dma_tile128(V1, Vg + 128, N_CD, 64, w, lane);
    if (n > 0) { dma_tile128(S0, Cg, 128, 128, w, lane); dma_tile128(S1, Cg + 128 * 128, 128, 128, w, lane); }
    if (w == 0) {
        const float ig = small[(size_t)(t0 + lane) * 128 + SM_DI + h] + gb[h];
        const float lf = log_sigmoid_(small[(size_t)(t0 + lane) * 128 + SM_DF + h] + gb[4 + h]);
        const float bc = ml_wave_incl_scan_add(lf, lane);
        const float gmb = ig - bc;
        const float pm = ml_wave_incl_scan_max(gmb, lane);
        bcs[lane] = bc; igs[lane] = gmb; mts[lane] = bc + fmaxf(pm, mprev);
    }
    if (w == 1) { const float* nl = (const float*)(ws + WS_MLN); const f32x2 nv = *(const f32x2*)(nl + (size_t)si * 128 + 2 * lane); *(LAS unsigned*)(NT + 4 * lane) = pk2(nv.x, nv.y); }
    { const int d = tid & 127, tq = tid >> 7; const float* cw = args.in[I_CONVW]; float w4[4]; float qc[16], kc[16];
#pragma unroll
        for (int j = 0; j < 4; ++j) w4[j] = cw[j * 1024 + h * 128 + d];
        ml_conv16_lds(Q, HQ, tq, d, w4, qc);
#pragma unroll
        for (int j = 0; j < 4; ++j) w4[j] = cw[j * 1024 + 512 + h * 128 + d];
        ml_conv16_lds(K, HK, tq, d, w4, kc);
        BAR_LDS();
#pragma unroll
        for (int i = 0; i < 16; ++i) { const int off = swz128(16 * tq + i, d); *(LAS bf16*)(Q + off) = (bf16)f2bf(qc[i]); *(LAS bf16*)(K + off) = (bf16)f2bf(kc[i] * 0.08838834764831845f); } }
    BAR_LDS();
    { const int mi = w >> 1; float rs = 0.f; const int t = 16 * mi + r16; const float bt = bcs[t] - mts[t];
#pragma unroll
        for (int q2 = 0; q2 < 2; ++q2) { const int ni = 2 * (w & 1) + q2; f32x4 acc = {0.f, 0.f, 0.f, 0.f};
            if (ni <= mi) {
#pragma unroll
                for (int ks = 0; ks < 4; ++ks) acc = mfma16(frag128(K, 16 * ni, 32 * ks, lane), frag128(Q, 16 * mi, 32 * ks, lane), acc); }
            const int s0 = 16 * ni + 4 * g4; float pv[4];
#pragma unroll
            for (int j = 0; j < 4; ++j) { float v = 0.f; if (ni <= mi && s0 + j <= t) v = acc[j] * __expf(bt + igs[s0 + j]); pv[j] = v; rs += v; }
            u32x2 o; o.x = pk2(pv[0], pv[1]); o.y = pk2(pv[2], pv[3]);
            *(LAS u32x2*)(P + t * LDK + s0) = o; }
        rs += __shfl_xor(rs, 16); rs += __shfl_xor(rs, 32);
        if (g4 == 0) psum[(w & 1) * 64 + t] = rs; }
    BAR_ALL();
    const int mi = w & 3, eh = w >> 2; const int t = 16 * mi + r16;
    f32x4 acc1[2][4], acc2[2][4]; f32x4 accn = {0.f, 0.f, 0.f, 0.f};
    { const bf16x8 p0 = lds_frag(P, LDK, 16 * mi, 0, lane), p1 = lds_frag(P, LDK, 16 * mi, 32, lane);
        bf16x8 qf[4];
#pragma unroll
        for (int ks = 0; ks < 4; ++ks) qf[ks] = frag128(Q, 16 * mi, 32 * ks, lane);
#pragma unroll
        for (int ks = 0; ks < 4; ++ks) accn = mfma16(frag128(NT, 0, 32 * ks, lane), qf[ks], accn);
#pragma unroll
        for (int hf = 0; hf < 2; ++hf) { const LAS unsigned char* Vt = hf ? V1 : V0; const LAS unsigned char* St = hf ? S1 : S0;
#pragma unroll
            for (int i = 0; i < 4; ++i) { const int e0 = 64 * eh + 16 * i; f32x4 a = {0.f, 0.f, 0.f, 0.f}, c = {0.f, 0.f, 0.f, 0.f};
                a = mfma16(tfrag128(Vt, 0, e0, lane), p0, a); a = mfma16(tfrag128(Vt, 32, e0, lane), p1, a);
                if (n > 0) {
#pragma unroll
                    for (int ks = 0; ks < 4; ++ks) c = mfma16(frag128(St, e0, 32 * ks, lane), qf[ks], c); }
                acc1[hf][i] = a; acc2[hf][i] = c; } } }
    const float mt = mts[t]; const float wi = __expf(bcs[t] + mprev - mt);
    const float qn_inter = __shfl(accn[0], r16);
    const float qn = psum[t] + psum[64 + t] + wi * qn_inter;
    const float inv = 1.0f / fmaxf(fabsf(qn), __expf(-mt));
    float ss = 0.f;
#pragma unroll
    for (int hf = 0; hf < 2; ++hf)
#pragma unroll
        for (int i = 0; i < 4; ++i)
#pragma unroll
            for (int j = 0; j < 4; ++j) { const float v = (acc1[hf][i][j] + wi * acc2[hf][i][j]) * inv; acc1[hf][i][j] = v; ss += v * v; }
    ss += __shfl_xor(ss, 16); ss += __shfl_xor(ss, 32);
    if (g4 == 0) red[eh * 64 + t] = ss;
    BAR_LDS();
    const float tot = red[t] + red[64 + t]; const float rstd = 1.0f / sqrtf(tot * (1.0f / 256.f) + EPS);
    const float* gn = args.in[I_DNORM]; bf16* mixed = (bf16*)(ws + WS_MIX);
    const size_t row = (size_t)(t0 + t);
#pragma unroll
    for (int hf = 0; hf < 2; ++hf)
#pragma unroll
        for (int i = 0; i < 4; ++i) { const int e = 128 * hf + 64 * eh + 16 * i + 4 * g4;
            const u32x2 gw = *(const GAS u32x2*)(h1 + row * N_CD + H1_DOG + h * 256 + e); const f32x4 gg = *(const f32x4*)(gn + e);
            u32x2 o; o.x = pk2(acc1[hf][i][0] * rstd * gg.x * bflo(gw.x), acc1[hf][i][1] * rstd * gg.y * bfhi(gw.x)); o.y = pk2(acc1[hf][i][2] * rstd * gg.z * bflo(gw.y), acc1[hf][i][3] * rstd * gg.w * bfhi(gw.y));
            *(GAS u32x2*)(mixed + row * D + 1024 + h * 256 + e) = o; }
}
__device__ __forceinline__ void ml_phase_c2(const Args& args, Frame& F) {
    u32x4 R[6];
    int u = F.bid;
    if (u < 1024) ml_load_raw(args, u, F.tid, true, R);
    for (; u < 1024; u += F.G) {
        const int h = u & 3, n = (u >> 2) & 63, b = u >> 8;
        BAR_ALL();
        ml_store_raw(F.lds + M2_Q, F.lds + M2_K, F.lds + M2_HQ, F.lds + M2_HK, F.tid, true, R);
        if (u + F.G < 1024) ml_load_raw(args, u + F.G, F.tid, true, R);
        BAR_LDS();
        ml_c_unit2(args, F, b, n, h);
    }
    BAR_ALL();
}

constexpr int MA_K = 0, MA_KT = 16384, MA_V0 = 34816, MA_V1 = 51200, MA_HK = 67584, MA_PART = 68352, MA_UU = 70400;
__device__ __forceinline__ void ml_a_unit2(const Args& args, Frame& F, int b, int n, int h) {
    unsigned char* ws = args.ws; const bf16* h1 = (const bf16*)(ws + WS_R1); const float* small = (const float*)(ws + WS_SMALL);
    const int t0 = b * SEQ + n * 64, tid = F.tid, lane = F.lane, w = F.wave;
    LAS unsigned char* K = F.lds + MA_K; LAS bf16* KT = (LAS bf16*)(F.lds + MA_KT); LAS unsigned char* V0 = F.lds + MA_V0; LAS unsigned char* V1 = F.lds + MA_V1;
    LAS unsigned char* HK = F.lds + MA_HK; LAS float* part = (LAS float*)(F.lds + MA_PART); LAS float* uu = (LAS float*)(F.lds + MA_UU);
    const float* gb = args.in[I_GATEB];
    const bf16* Vg = h1 + (size_t)t0 * N_CD + H1_DV + h * 256;
    dma_tile128(V0, Vg, N_CD, 64, w, lane); dma_tile128(V1, Vg + 128, N_CD, 64, w, lane);
    if (w == 0) {
        const float ig = small[(size_t)(t0 + lane) * 128 + SM_DI + h] + gb[h];
        const float lf = log_sigmoid_(small[(size_t)(t0 + lane) * 128 + SM_DF + h] + gb[4 + h]);
        const float bc = ml_wave_incl_scan_add(lf, lane); const float bl = __shfl(bc, 63);
        const float lu = bl - bc + ig; const float a = wave_max(lu);
        uu[lane] = __expf(lu - a);
        if (lane == 0) { float* sc = (float*)(ws + WS_MLSC); const int si = (b * NCH + n) * 4 + h; sc[ML_A / 4 + si] = a; sc[ML_BL / 4 + si] = bl; }
    }
    const int d = tid & 127, tq = tid >> 7;
    float kc[16];
    { const float* cw = args.in[I_CONVW]; float w4[4];
#pragma unroll
        for (int j = 0; j < 4; ++j) w4[j] = cw[j * 1024 + 512 + h * 128 + d];
        ml_conv16_lds(K, HK, tq, d, w4, kc); }
    BAR_LDS();
    { float loc = 0.f; unsigned wv[8];
#pragma unroll
        for (int i = 0; i < 16; i += 2) { const float k0 = kc[i] * 0.08838834764831845f * uu[16 * tq + i], k1 = kc[i + 1] * 0.08838834764831845f * uu[16 * tq + i + 1]; loc += k0 + k1; wv[i >> 1] = pk2(k0, k1); }
        u32x4 o0, o1; o0.x = wv[0]; o0.y = wv[1]; o0.z = wv[2]; o0.w = wv[3]; o1.x = wv[4]; o1.y = wv[5]; o1.z = wv[6]; o1.w = wv[7];
        *(LAS u32x4*)(KT + d * LDK + 16 * tq) = o0; *(LAS u32x4*)(KT + d * LDK + 16 * tq + 8) = o1;
        part[tq * 128 + d] = loc; }
    BAR_ALL();
    if (tid < 128) { float* nl = (float*)(ws + WS_MLN); nl[(size_t)((b * NCH + n) * 4 + h) * 128 + tid] = part[tid] + part[128 + tid] + part[256 + tid] + part[384 + tid]; }
    bf16* U = (bf16*)args.out + (size_t)33554432 + (size_t)((b * NCH + n) * 4 + h) * 256 * 128;
    const bf16x8 a0 = lds_frag(KT, LDK, 16 * w, 0, lane), a1 = lds_frag(KT, LDK, 16 * w, 32, lane);
#pragma unroll 4
    for (int et = 0; et < 16; ++et) { const LAS unsigned char* Vt = (et < 8) ? V0 : V1; const int c0 = (et & 7) * 16;
        f32x4 acc = {0.f, 0.f, 0.f, 0.f};
        acc = mfma16(a0, tfrag128(Vt, 0, c0, lane), acc);
        acc = mfma16(a1, tfrag128(Vt, 32, c0, lane), acc);
        u32x2 o; o.x = pk2(acc[0], acc[1]); o.y = pk2(acc[2], acc[3]);
        *(GAS u32x2*)(U + (size_t)(16 * et + (lane & 15)) * 128 + 16 * w + 4 * (lane >> 4)) = o; }
}
__device__ __forceinline__ void ml_phase_a2(const Args& args, Frame& F) {
    u32x4 R[6];
    int u = F.bid;
    if (u < 1024) ml_load_raw(args, u, F.tid, false, R);
    for (; u < 1024; u += F.G) {
        const int h = u & 3, n = (u >> 2) & 63, b = u >> 8;
        BAR_ALL();
        ml_store_raw(F.lds + MA_K, F.lds + MA_K, F.lds + MA_HK, F.lds + MA_HK, F.tid, false, R);
        if (u + F.G < 1024) ml_load_raw(args, u + F.G, F.tid, false, R);
        BAR_LDS();
        ml_a_unit2(args, F, b, n, h);
    }
    BAR_ALL();
}
constexpr int MLPAIRS = BATCH * NPR * 4;
constexpr int MA_UU2 = MA_UU + 256;
__device__ __forceinline__ int mlp_chunk_unit(int up, int sub) { const int h = up & 3, p = (up >> 2) & 31, b = up >> 7; return (b << 8) | ((2 * p + sub) << 2) | h; }

__device__ __forceinline__ void ml_a_pair(const Args& args, Frame& F, int up, u32x4 (&R)[6]) {
    const int h = up & 3, p = (up >> 2) & 31, b = up >> 7, pi = (b * NPR + p) * 4 + h;
    unsigned char* ws = args.ws; const bf16* h1 = (const bf16*)(ws + WS_R1); const float* small = (const float*)(ws + WS_SMALL);
    const int tid = F.tid, lane = F.lane, w = F.wave;
    LAS unsigned char* K = F.lds + MA_K; LAS bf16* KT = (LAS bf16*)(F.lds + MA_KT); LAS unsigned char* V0 = F.lds + MA_V0; LAS unsigned char* V1 = F.lds + MA_V1;
    LAS unsigned char* HK = F.lds + MA_HK; LAS float* part = (LAS float*)(F.lds + MA_PART); LAS float* uu = (LAS float*)(F.lds + MA_UU);
    const float* gb = args.in[I_GATEB];
    const int d = tid & 127, tq = tid >> 7;
    f32x4 acc[16];
#pragma unroll
    for (int et = 0; et < 16; ++et) acc[et] = (f32x4){0.f, 0.f, 0.f, 0.f};
    float a_lo = 0.f, bl_lo = 0.f, n_lo = 0.f;
#pragma unroll
    for (int sub = 0; sub < 2; ++sub) {
        const int n = 2 * p + sub, t0 = b * SEQ + n * 64;
        BAR_ALL();
        ml_store_raw(K, K, HK, HK, tid, false, R);
        if (sub == 0) ml_load_raw(args, mlp_chunk_unit(up, 1), tid, false, R);
        else if (up + F.G < MLPAIRS) ml_load_raw(args, mlp_chunk_unit(up + F.G, 0), tid, false, R);
        BAR_LDS();
        const bf16* Vg = h1 + (size_t)t0 * N_CD + H1_DV + h * 256;
        dma_tile128(V0, Vg, N_CD, 64, w, lane); dma_tile128(V1, Vg + 128, N_CD, 64, w, lane);
        if (w == 0) {
            const float ig = small[(size_t)(t0 + lane) * 128 + SM_DI + h] + gb[h];
            const float lf = log_sigmoid_(small[(size_t)(t0 + lane) * 128 + SM_DF + h] + gb[4 + h]);
            const float bc = ml_wave_incl_scan_add(lf, lane); const float bl = __shfl(bc, 63);
            const float lu = bl - bc + ig; const float a = wave_max(lu);
            if (sub == 0) { uu[lane] = __expf(lu - a); a_lo = a; bl_lo = bl; }
            else { const float ap = fmaxf(bl + a_lo, a); uu[lane] = __expf(lu - ap);
                if (lane == 0) { uu[64] = __expf(bl + a_lo - ap); float* sc = (float*)(ws + WS_MLSC); sc[ML_A / 4 + pi] = ap; sc[ML_BL / 4 + pi] = bl_lo + bl; } }
        }
        float kc[16];
        { const float* cw = args.in[I_CONVW]; float w4[4];
#pragma unroll
            for (int j = 0; j < 4; ++j) w4[j] = cw[j * 1024 + 512 + h * 128 + d];
            ml_conv16_lds(K, HK, tq, d, w4, kc); }
        BAR_LDS();
        { float loc = 0.f; unsigned wv[8];
#pragma unroll
            for (int i = 0; i < 16; i += 2) { const float k0 = kc[i] * 0.08838834764831845f * uu[16 * tq + i], k1 = kc[i + 1] * 0.08838834764831845f * uu[16 * tq + i + 1]; loc += k0 + k1; wv[i >> 1] = pk2(k0, k1); }
            u32x4 o0, o1; o0.x = wv[0]; o0.y = wv[1]; o0.z = wv[2]; o0.w = wv[3]; o1.x = wv[4]; o1.y = wv[5]; o1.z = wv[6]; o1.w = wv[7];
            *(LAS u32x4*)(KT + d * LDK + 16 * tq) = o0; *(LAS u32x4*)(KT + d * LDK + 16 * tq + 8) = o1;
            part[tq * 128 + d] = loc; }
        BAR_ALL();
        if (sub == 0) { if (tid < 128) n_lo = (part[tid] + part[128 + tid]) + (part[256 + tid] + part[384 + tid]); }
        else { const float f_lo = uu[64];
            if (tid < 128) { float* nl = (float*)(ws + WS_MLN); nl[(size_t)pi * 128 + tid] = f_lo * n_lo + ((part[tid] + part[128 + tid]) + (part[256 + tid] + part[384 + tid])); }
#pragma unroll
            for (int et = 0; et < 16; ++et) acc[et] = acc[et] * f_lo; }
        int ll = lane; asm volatile("" : "+v"(ll));
        const bf16x8 a0 = lds_frag(KT, LDK, 16 * w, 0, ll), a1 = lds_frag(KT, LDK, 16 * w, 32, ll);
#pragma unroll
        for (int et = 0; et < 16; ++et) { const LAS unsigned char* Vt = (et < 8) ? V0 : V1; const int c0 = (et & 7) * 16;
            acc[et] = mfma16(a0, tfrag128(Vt, 0, c0, ll), acc[et]);
            acc[et] = mfma16(a1, tfrag128(Vt, 32, c0, ll), acc[et]); if (et & 1) __builtin_amdgcn_sched_barrier(0); }
    }
    bf16* U = (bf16*)args.out + (size_t)33554432 + (size_t)pi * 256 * 128;
#pragma unroll
    for (int et = 0; et < 16; ++et) { u32x2 o; o.x = pk2(acc[et][0], acc[et][1]); o.y = pk2(acc[et][2], acc[et][3]);
        *(GAS u32x2*)(U + (size_t)(16 * et + (lane & 15)) * 128 + 16 * w + 4 * (lane >> 4)) = o; }
}
__device__ __forceinline__ void ml_phase_a3(const Args& args, Frame& F) {
    u32x4 R[6];
    int up = F.bid;
    if (up < MLPAIRS) ml_load_raw(args, mlp_chunk_unit(up, 0), F.tid, false, R);
    for (; up < MLPAIRS; up += F.G) ml_a_pair(args, F, up, R);
    BAR_ALL();
}

__device__ __forceinline__ void ml_scan_p(const Args& args, Frame& F) {
    unsigned char* ws = args.ws; float* sc = (float*)(ws + WS_MLSC);
    const int NTC = BATCH * 4 * 256 * 16, NTN = BATCH * 4 * 128;
    for (int gt = 64 * (F.wave * F.G + F.bid) + F.lane; gt < NTC + NTN; gt += F.G * 512) {
        if (gt < NTC) {
            const int d8 = gt & 15, e = (gt >> 4) & 255, h = (gt >> 12) & 3, b = gt >> 14;
            bf16* S = (bf16*)args.out + (size_t)33554432;
            float st[8]; float m = 0.f;
#pragma unroll
            for (int j = 0; j < 8; ++j) st[j] = 0.f;
#pragma unroll 4
            for (int p = 0; p < NPR; ++p) { const int si = (b * NPR + p) * 4 + h;
                GAS u32x4* q = (GAS u32x4*)(S + ((size_t)si * 256 + e) * 128 + 8 * d8);
                const u32x4 u = *q; const float a = sc[ML_A / 4 + si], bl = sc[ML_BL / 4 + si];
                u32x4 o; o.x = pk2(st[0], st[1]); o.y = pk2(st[2], st[3]); o.z = pk2(st[4], st[5]); o.w = pk2(st[6], st[7]);
                *q = o;
                const float mn = fmaxf(bl + m, a); const float dec = __expf(bl + m - mn), inw = __expf(a - mn); m = mn;
                st[0] = dec * st[0] + inw * bflo(u.x); st[1] = dec * st[1] + inw * bfhi(u.x); st[2] = dec * st[2] + inw * bflo(u.y); st[3] = dec * st[3] + inw * bfhi(u.y);
                st[4] = dec * st[4] + inw * bflo(u.z); st[5] = dec * st[5] + inw * bfhi(u.z); st[6] = dec * st[6] + inw * bflo(u.w); st[7] = dec * st[7] + inw * bfhi(u.w);
            }
        } else {
            const int r = gt - NTC; const int d = r & 127, h = (r >> 7) & 3, b = r >> 9;
            float* nl = (float*)(ws + WS_MLN); float st = 0.f, m = 0.f;
            for (int p = 0; p < NPR; ++p) { const int si = (b * NPR + p) * 4 + h;
                const float u = nl[(size_t)si * 128 + d]; const float a = sc[ML_A / 4 + si], bl = sc[ML_BL / 4 + si];
                nl[(size_t)si * 128 + d] = st; if (d == 0) sc[ML_MP / 4 + si] = m;
                const float mn = fmaxf(bl + m, a); st = __expf(bl + m - mn) * st + __expf(a - mn) * u; m = mn; }
        }
    }
}

constexpr int M3_WSA = M2_PSUM + 512, M3_SCAL = M3_WSA + 256;
static_assert(M3_SCAL + 16 <= LDS_BYTES - 1024, "mlstm (c) pair LDS map");
__device__ __forceinline__ void ml_c_step(const Args& args, Frame& F, int b, int p, int h, const int sub) {
    unsigned char* ws = args.ws; const bf16* h1 = (const bf16*)(ws + WS_R1); const float* small = (const float*)(ws + WS_SMALL);
    const int n = 2 * p + sub, pi = (b * NPR + p) * 4 + h;
    int lane = F.lane; asm volatile("" : "+v"(lane));
    int tid = F.tid; asm volatile("" : "+v"(tid));
    const int t0 = b * SEQ + n * 64, w = F.wave, r16 = lane & 15, g4 = lane >> 4;
    LAS unsigned char* Q = F.lds + M2_Q; LAS unsigned char* K = F.lds + M2_K; LAS bf16* P = (LAS bf16*)(F.lds + M2_P);
    LAS unsigned char* V0 = F.lds + M2_V0; LAS unsigned char* V1 = F.lds + M2_V1; LAS unsigned char* S0 = F.lds + M2_S0; LAS unsigned char* S1 = F.lds + M2_S1;
    LAS unsigned char* NT = F.lds + M2_NT; LAS unsigned char* HQ = F.lds + M2_HQ; LAS unsigned char* HK = F.lds + M2_HK;
    LAS float* bcs = (LAS float*)(F.lds + M2_BCS); LAS float* igs = (LAS float*)(F.lds + M2_IGS); LAS float* mts = (LAS float*)(F.lds + M2_MTS);
    LAS float* red = (LAS float*)(F.lds + M2_RED); LAS float* psum = (LAS float*)(F.lds + M2_PSUM);
    LAS float* wsa = (LAS float*)(F.lds + M3_WSA); LAS float* scal = (LAS float*)(F.lds + M3_SCAL);
    const float* gb = args.in[I_GATEB];
    const float mprev = (sub == 0) ? ((const float*)(ws + WS_MLSC))[ML_MP / 4 + pi] : scal[0];
    const bf16* Cg = (const bf16*)args.out + (size_t)33554432 + (size_t)pi * 256 * 128;
    const bf16* Vg = h1 + (size_t)t0 * N_CD + H1_DV + h * 256;
    dma_tile128(V0, Vg, N_CD, 64, w, lane); dma_tile128(V1, Vg + 128, N_CD, 64, w, lane);
    if (sub == 0 && p > 0) { dma_tile128(S0, Cg, 128, 128, w, lane); dma_tile128(S1, Cg + 128 * 128, 128, 128, w, lane); }
    if (w == 0) {
        const float ig = small[(size_t)(t0 + lane) * 128 + SM_DI + h] + gb[h];
        const float lf = log_sigmoid_(small[(size_t)(t0 + lane) * 128 + SM_DF + h] + gb[4 + h]);
        const float bc = ml_wave_incl_scan_add(lf, lane);
        const float gmb = ig - bc;
        const float pm = ml_wave_incl_scan_max(gmb, lane);
        bcs[lane] = bc; igs[lane] = gmb; mts[lane] = bc + fmaxf(pm, mprev);
        if (sub == 0) {
            const float bl = __shfl(bc, 63); const float a = bl + __shfl(pm, 63); const float mm = fmaxf(bl + mprev, a);
            wsa[lane] = __expf(bl + gmb - mm);
            if (lane == 0) { scal[1] = mm; scal[2] = __expf(bl + mprev - mm); }
        }
    }
    if (w == 1 && sub == 0) { const float* nl = (const float*)(ws + WS_MLN); const f32x2 nv = *(const f32x2*)(nl + (size_t)pi * 128 + 2 * lane); *(LAS unsigned*)(NT + 4 * lane) = pk2(nv.x, nv.y); }
    { const int d = tid & 127, tq = tid >> 7; const float* cw = args.in[I_CONVW]; float w4[4]; float qc[16], kc[16];
#pragma unroll
        for (int j = 0; j < 4; ++j) w4[j] = cw[j * 1024 + h * 128 + d];
        ml_conv16_lds(Q, HQ, tq, d, w4, qc);
#pragma unroll
        for (int j = 0; j < 4; ++j) w4[j] = cw[j * 1024 + 512 + h * 128 + d];
        ml_conv16_lds(K, HK, tq, d, w4, kc);
        BAR_LDS();
#pragma unroll
        for (int i = 0; i < 16; ++i) { const int off = swz128(16 * tq + i, d); *(LAS bf16*)(Q + off) = (bf16)f2bf(qc[i]); *(LAS bf16*)(K + off) = (bf16)f2bf(kc[i] * 0.08838834764831845f); } }
    BAR_LDS();
    { const int mi = w >> 1; float rs = 0.f; const int t = 16 * mi + r16; const float bt = bcs[t] - mts[t];
#pragma unroll
        for (int q2 = 0; q2 < 2; ++q2) { const int ni = 2 * (w & 1) + q2; f32x4 acc = {0.f, 0.f, 0.f, 0.f};
            if (ni <= mi) {
#pragma unroll
                for (int ks = 0; ks < 4; ++ks) acc = mfma16(frag128(K, 16 * ni, 32 * ks, lane), frag128(Q, 16 * mi, 32 * ks, lane), acc); }
            const int s0 = 16 * ni + 4 * g4; float pv[4];
#pragma unroll
            for (int j = 0; j < 4; ++j) { float v = 0.f; if (ni <= mi && s0 + j <= t) v = acc[j] * __expf(bt + igs[s0 + j]); pv[j] = v; rs += v; }
            u32x2 o; o.x = pk2(pv[0], pv[1]); o.y = pk2(pv[2], pv[3]);
            *(LAS u32x2*)(P + t * LDK + s0) = o; }
        rs += __shfl_xor(rs, 16); rs += __shfl_xor(rs, 32);
        if (g4 == 0) psum[(w & 1) * 64 + t] = rs; }
    BAR_ALL();
    const int mi = w & 3, eh = w >> 2; const int t = 16 * mi + r16;
    f32x4 acc1[2][4], acc2[2][4]; f32x4 accn = {0.f, 0.f, 0.f, 0.f};
    { const bf16x8 p0 = lds_frag(P, LDK, 16 * mi, 0, lane), p1 = lds_frag(P, LDK, 16 * mi, 32, lane);
        bf16x8 qf[4];
#pragma unroll
        for (int ks = 0; ks < 4; ++ks) qf[ks] = frag128(Q, 16 * mi, 32 * ks, lane);
#pragma unroll
        for (int ks = 0; ks < 4; ++ks) accn = mfma16(frag128(NT, 0, 32 * ks, lane), qf[ks], accn);
#pragma unroll
        for (int hf = 0; hf < 2; ++hf) { const LAS unsigned char* Vt = hf ? V1 : V0; const LAS unsigned char* St = hf ? S1 : S0;
#pragma unroll
            for (int i = 0; i < 4; ++i) { const int e0 = 64 * eh + 16 * i; f32x4 a = {0.f, 0.f, 0.f, 0.f}, c = {0.f, 0.f, 0.f, 0.f};
                a = mfma16(tfrag128(Vt, 0, e0, lane), p0, a); a = mfma16(tfrag128(Vt, 32, e0, lane), p1, a);
                if (n > 0) {
#pragma unroll
                    for (int ks = 0; ks < 4; ++ks) c = mfma16(frag128(St, e0, 32 * ks, lane), qf[ks], c); }
                acc1[hf][i] = a; acc2[hf][i] = c; } } }
    const float mt = mts[t]; const float wi = __expf(bcs[t] + mprev - mt);
    const float qn_inter = (n > 0) ? __shfl(accn[0], r16) : 0.f;
    const float qn = psum[t] + psum[64 + t] + wi * qn_inter;
    const float inv = 1.0f / fmaxf(fabsf(qn), __expf(-mt));
    float ss = 0.f;
#pragma unroll
    for (int hf = 0; hf < 2; ++hf)
#pragma unroll
        for (int i = 0; i < 4; ++i)
#pragma unroll
            for (int j = 0; j < 4; ++j) { const float v = (acc1[hf][i][j] + wi * acc2[hf][i][j]) * inv; acc1[hf][i][j] = v; ss += v * v; }
    ss += __shfl_xor(ss, 16); ss += __shfl_xor(ss, 32);
    if (g4 == 0) red[eh * 64 + t] = ss;
    BAR_LDS();
    const float tot = red[t] + red[64 + t]; const float rstd = 1.0f / sqrtf(tot * (1.0f / 256.f) + EPS);
    const float* gn = args.in[I_DNORM]; bf16* mixed = (bf16*)(ws + WS_MIX);
    const size_t row = (size_t)(t0 + t);
#pragma unroll
    for (int hf = 0; hf < 2; ++hf)
#pragma unroll
        for (int i = 0; i < 4; ++i) { const int e = 128 * hf + 64 * eh + 16 * i + 4 * g4;
            const u32x2 gw = *(const GAS u32x2*)(h1 + row * N_CD + H1_DOG + h * 256 + e); const f32x4 gg = *(const f32x4*)(gn + e);
            u32x2 o; o.x = pk2(acc1[hf][i][0] * rstd * gg.x * bflo(gw.x), acc1[hf][i][1] * rstd * gg.y * bfhi(gw.x)); o.y = pk2(acc1[hf][i][2] * rstd * gg.z * bflo(gw.y), acc1[hf][i][3] * rstd * gg.w * bfhi(gw.y));
            *(GAS u32x2*)(mixed + row * D + 1024 + h * 256 + e) = o; }
    if (sub == 0) {
        const float dec = scal[2];
        const int d0 = 16 * w;
        bf16x8 k0 = tfrag128(K, 0, d0, lane), k1 = tfrag128(K, 32, d0, lane);
#pragma unroll
        for (int i = 0; i < 8; ++i) { k0[i] = (short)f2bf(bf2f((bf16)k0[i]) * wsa[8 * g4 + i]); k1[i] = (short)f2bf(bf2f((bf16)k1[i]) * wsa[32 + 8 * g4 + i]); }
        if (tid < 128) {
            float ns = 0.f;
            for (int s = 0; s < 64; ++s) ns += wsa[s] * bf2f(*(const LAS bf16*)(K + swz128(s, tid)));
            const float nold = (n > 0) ? bf2f(*(const LAS bf16*)(NT + 2 * tid)) : 0.f;
            *(LAS bf16*)(NT + 2 * tid) = (bf16)f2bf(dec * nold + ns); }
#pragma unroll
        for (int et = 0; et < 16; ++et) { LAS unsigned char* St = (et < 8) ? S0 : S1; const LAS unsigned char* Vt = (et < 8) ? V0 : V1; const int e0 = (et & 7) * 16;
            f32x4 a = {0.f, 0.f, 0.f, 0.f};
            if (n > 0) {
#pragma unroll
                for (int j = 0; j < 4; ++j) a[j] = dec * bf2f(*(const LAS bf16*)(St + swz128(e0 + 4 * g4 + j, d0 + r16))); }
            a = mfma16(tfrag128(Vt, 0, e0, lane), k0, a); a = mfma16(tfrag128(Vt, 32, e0, lane), k1, a);
#pragma unroll
            for (int j = 0; j < 4; ++j) *(LAS bf16*)(St + swz128(e0 + 4 * g4 + j, d0 + r16)) = (bf16)f2bf(a[j]);
            __builtin_amdgcn_sched_barrier(0); }
        if (tid == 0) scal[0] = scal[1];
    }
}
__device__ __forceinline__ void ml_phase_c3(const Args& args, Frame& F) {
    u32x4 R[6];
    int up = F.bid;
    if (up < MLPAIRS) ml_load_raw(args, mlp_chunk_unit(up, 0), F.tid, true, R);
    for (; up < MLPAIRS; up += F.G) {
        const int h = up & 3, p = (up >> 2) & 31, b = up >> 7;
#pragma unroll
        for (int sub = 0; sub < 2; ++sub) {
            BAR_ALL();
            ml_store_raw(F.lds + M2_Q, F.lds + M2_K, F.lds + M2_HQ, F.lds + M2_HK, F.tid, true, R);
            if (sub == 0) ml_load_raw(args, mlp_chunk_unit(up, 1), F.tid, true, R);
            else if (up + F.G < MLPAIRS) ml_load_raw(args, mlp_chunk_unit(up + F.G, 0), F.tid, true, R);
            BAR_LDS();
            ml_c_step(args, F, b, p, h, sub);
        }
    }
    BAR_ALL();
}
constexpr int N_PHASES = 20;
constexpr int LDS_TAB_OFF = LDS_BYTES - 1024, LDS_BARW_OFF = LDS_BYTES - 512;

__device__ __forceinline__ void moe_table(Frame& F, int layer) {
    volatile LAS int* tab = (volatile LAS int*)(F.lds + LDS_TAB_OFF);
    __syncthreads();
    if (F.tid == 0) { int acc = 0;
        for (int e = 0; e < 16; ++e) { const int c = (int)__hip_atomic_load((unsigned*)(F.ctl + CW_CNT) + (layer * 16 + e) * 64, RLX_AGENT); tab[e] = acc; tab[32 + e] = c; acc += (c + 255) >> 8; }
        tab[16] = acc; }
    __syncthreads();
}

__global__ void __launch_bounds__(512, 2) hybrid_fwd(Args args) {
    extern __shared__ __attribute__((aligned(16))) unsigned char lds_raw[];
    Frame F;
    F.lds = (LAS unsigned char*)lds_raw;
    F.tid = threadIdx.x; F.lane = F.tid & 63; F.wave = __builtin_amdgcn_readfirstlane(F.tid >> 6);
    F.G = gridDim.x; F.bid = blockIdx.x;
    unsigned char* ws = args.ws;
    F.ctl = (gu32*)(ws + WS_CTL);
    if (F.tid < 256) ((LAS unsigned*)(F.lds + LDS_TAB_OFF))[F.tid] = 0u;
    __syncthreads();
    XcdBarrier bar; bar.bar = (unsigned*)(F.ctl + CW_BAR); bar.x = 0; bar.st = nullptr;
    if (args.use_bar) bar = xcd_barrier_post((unsigned*)(F.ctl + CW_BAR), (volatile LAS unsigned*)(F.lds + LDS_BARW_OFF));
    const int lo = args.ph_lo, hi = args.ph_hi;
#ifndef PH_MASK
#define PH_MASK 0xffffffu
#endif
#define IN(k) (((PH_MASK >> (k)) & 1u) && lo <= (k) && (k) < hi)
#define SEAM(k) do { if (IN(k) && IN((k) + 1)) xcd_barrier(bar); } while (0)
#ifndef DIAG_OC_MODE
#define DIAG_OC_MODE 0
#endif
#ifndef DIAG_OC_SCALE
#define DIAG_OC_SCALE 0.f
#endif
#ifndef PROBE_SKIP
#define PROBE_SKIP 0
#endif
#ifndef PROBE_DUP
#define PROBE_DUP -1
#endif
#define REP(k) for (int _r = 0; _r < ((PROBE_DUP == (k)) ? 2 : 1); ++_r)
#define REPBAR(k) do { if (PROBE_DUP == (k) && _r == 0) xcd_barrier(bar); } while (0)
    const volatile LAS int* tab = (const volatile LAS int*)(F.lds + LDS_TAB_OFF);

    if (IN(0)) REP(0) { p0_prologue(args, F); REPBAR(0); } SEAM(0);
    if (IN(1)) REP(1) { pg8::StaticOrder S; S.init((const bf16*)(ws + WS_XB), D, (const bf16*)(ws + WS_WINAB), D, T, N_AB, F.G, F.bid);
        pg8::EpiAB E{(bf16*)(ws + WS_R1), (const float*)(ws + WS_LB)};
        pg8::gemm_phase<pg8::EpiAB, pg8::StaticOrder, false>(F.lds, D, S, E); REPBAR(1); } SEAM(1);
    if (IN(2)) REP(2) { ab_phase_a3(args, F); REPBAR(2); } SEAM(2);
    if (IN(3)) REP(3) { ab_scan_p(args, F); REPBAR(3); } SEAM(3);
    if (IN(4)) REP(4) { ab_phase_c3(args, F); REPBAR(4); } SEAM(4);
    if (IN(5)) REP(5) { pg8::StaticOrder S; S.init((const bf16*)(ws + WS_MIX), D, (const bf16*)(ws + WS_WOUTAB), D, T, D, F.G, F.bid);
        pg8::EpiBf16 E{(bf16*)(ws + WS_TMP), D};
        pg8::gemm_phase<pg8::EpiBf16, pg8::StaticOrder, false>(F.lds, D, S, E); REPBAR(5); } SEAM(5);
    if (IN(6)) REP(6) { ln_phase<0, true, false>(args, F, 0, args.in[I_X]); REPBAR(6); } SEAM(6);
    if (IN(7)) REP(7) { moe_table(F, 0);
        pg8::MoeOrder S{(const char*)(ws + WS_XB), (const char*)(ws + WS_W13), D, D, 4, F.G, F.bid, 1024, tab, (const int*)(ws + WS_LIST), true};
        pg8::EpiMoe1 E{(bf16*)(ws + WS_MIX), (const float*)(ws + WS_WL), tab};
        pg8::gemm_phase<pg8::EpiMoe1, pg8::MoeOrder, true>(F.lds, D, S, E); REPBAR(7); } SEAM(7);
    if (IN(8)) REP(8) { moe_table(F, 0);
        pg8::MoeOrder S{(const char*)(ws + WS_MIX), (const char*)(ws + WS_W2T), DEXP, DEXP, 8, F.G, F.bid, 2048, tab, (const int*)(ws + WS_LIST), false};
        pg8::EpiMoe2 E{(bf16*)(ws + WS_R2), (const int*)(ws + WS_LIST), tab};
        pg8::gemm_phase<pg8::EpiMoe2, pg8::MoeOrder, false>(F.lds, DEXP, S, E); REPBAR(8); } SEAM(8);
    if (IN(9)) REP(9) { ln_phase<1, false, false>(args, F, 0, nullptr); REPBAR(9); } SEAM(9);
    if (IN(10)) REP(10) { pg8::StaticOrder S; S.init((const bf16*)(ws + WS_XB), D, (const bf16*)(ws + WS_WINCD), D, T, N_CD, F.G, F.bid);
        pg8::EpiCD E{(bf16*)(ws + WS_R1), (float*)(ws + WS_SMALL)};
        pg8::gemm_phase<pg8::EpiCD, pg8::StaticOrder, false>(F.lds, D, S, E); REPBAR(10); } SEAM(10);
    if (IN(11)) REP(11) {
        { pg8::HeadOrder S{(const char*)(ws + WS_R1), (const char*)(ws + WS_WUK), N_CD, 256, 128, F.G, F.bid};
          pg8::EpiHead E{(bf16*)args.out, D, 256, 2, 0, 0.f};
          pg8::gemm_phase<pg8::EpiHead, pg8::HeadOrder, false>(F.lds, 256 + args.pad, S, E); }
        if (!(PROBE_SKIP & 1)) dsa_indexer(args, F);
        ml_phase_a3(args, F); REPBAR(11); } SEAM(11);
    if (IN(12)) REP(12) { dsa_prep_rows(args, F); if (!(PROBE_SKIP & 2)) dsa_topk(args, F); ml_scan_p(args, F); REPBAR(12); } SEAM(12);
    if (IN(13)) REP(13) { if (!(PROBE_SKIP & 4)) dsa_attention(args, F, _r == 0 ? (bf16*)args.out : (bf16*)(ws + WS_MIX)); ml_phase_c3(args, F); REPBAR(13); } SEAM(13);
    if (IN(14)) REP(14) { pg8::HeadOrder S{(const char*)args.out, (const char*)(ws + WS_WUV), D, 256, 256, F.G, F.bid};
        pg8::EpiHead E{(bf16*)(ws + WS_MIX), D, 128, 1, DIAG_OC_MODE, DIAG_OC_SCALE};
        pg8::gemm_phase<pg8::EpiHead, pg8::HeadOrder, false>(F.lds, 256 + args.pad, S, E); REPBAR(14); } SEAM(14);
    if (IN(15)) REP(15) { pg8::StaticOrder S; S.init((const bf16*)(ws + WS_MIX), D, (const bf16*)(ws + WS_WOUTCD), D, T, D, F.G, F.bid);
        pg8::EpiBf16 E{(bf16*)(ws + WS_TMP), D};
        pg8::gemm_phase<pg8::EpiBf16, pg8::StaticOrder, false>(F.lds, D, S, E); REPBAR(15); } SEAM(15);
    if (IN(16)) REP(16) { ln_phase<0, false, false>(args, F, 1, nullptr); REPBAR(16); } SEAM(16);
    if (IN(17)) REP(17) { moe_table(F, 1);
        pg8::MoeOrder S{(const char*)(ws + WS_XB), (const char*)(ws + WS_W13), D, D, 4, F.G, F.bid, 1024, tab, (const int*)(ws + WS_LIST), true};
        pg8::EpiMoe1 E{(bf16*)(ws + WS_MIX), (const float*)(ws + WS_WL), tab};
        pg8::gemm_phase<pg8::EpiMoe1, pg8::MoeOrder, true>(F.lds, D, S, E); REPBAR(17); } SEAM(17);
    if (IN(18)) REP(18) { moe_table(F, 1);
        pg8::MoeOrder S{(const char*)(ws + WS_MIX), (const char*)(ws + WS_W2T), DEXP, DEXP, 8, F.G, F.bid, 2048, tab, (const int*)(ws + WS_LIST), false};
        pg8::EpiMoe2 E{(bf16*)(ws + WS_R2), (const int*)(ws + WS_LIST), tab};
        pg8::gemm_phase<pg8::EpiMoe2, pg8::MoeOrder, false>(F.lds, DEXP, S, E); REPBAR(18); } SEAM(18);
    if (IN(19)) { ln_phase<1, false, true>(args, F, 1, nullptr); }
#undef IN
#undef SEAM
}

#ifndef MK_ONE_LAUNCH
#define MK_ONE_LAUNCH 1
#endif
extern "C" void kernel_launch(void* const* d_in, const int* in_sizes, int n_in, void* d_out, int out_size, void* d_ws, size_t ws_size, hipStream_t stream) {
    static int grid = 0;
    if (grid == 0) {
        if (n_in != 24 || in_sizes[0] != T * D || out_size != T * D || ws_size < WS_END) { fprintf(stderr, "kernel_launch: unexpected shapes (n_in %d, in0 %d, out %d, ws %zu < %zu); nothing launched\n", n_in, n_in > 0 ? in_sizes[0] : -1, out_size, ws_size, (size_t)WS_END); grid = -1; return; }
        int dev = 0, cus = 0, per_cu = 0;
        if (hipGetDevice(&dev) != hipSuccess || hipDeviceGetAttribute(&cus, hipDeviceAttributeMultiprocessorCount, dev) != hipSuccess) { grid = -1; return; }
        if (hipFuncSetAttribute((const void*)hybrid_fwd, hipFuncAttributeMaxDynamicSharedMemorySize, LDS_BYTES) != hipSuccess) { fprintf(stderr, "kernel_launch: hipFuncSetAttribute failed\n"); grid = -1; return; }
        if (hipOccupancyMaxActiveBlocksPerMultiprocessor(&per_cu, (const void*)hybrid_fwd, 512, LDS_BYTES) != hipSuccess || per_cu < 1) fprintf(stderr, "kernel_launch: occupancy query reports %d\n", per_cu);
        (void)hipGetLastError();
        grid = cus;
    }
    if (grid < 0) return;
    if (hipMemsetAsync((char*)d_ws + WS_CTL, 0, CTL_ZERO_BYTES, stream) != hipSuccess) return;
    Args a{};
    for (int i = 0; i < 24; ++i) a.in[i] = (const float*)d_in[i];
    a.out = (float*)d_out; a.ws = (unsigned char*)d_ws; a.pad = 0;
#if MK_ONE_LAUNCH
    a.ph_lo = 0; a.ph_hi = N_PHASES; a.use_bar = 1;
    hipLaunchKernelGGL(hybrid_fwd, dim3(grid), dim3(512), LDS_BYTES, stream, a);
#else
    a.use_bar = 0;
    for (int p = 0; p < N_PHASES; ++p) { a.ph_lo = p; a.ph_hi = p + 1; hipLaunchKernelGGL(hybrid_fwd, dim3(grid), dim3(512), LDS_BYTES, stream, a); }
#endif
}
```
